# Optimizing an MI355X kernel written in HIP

```python
import jax, jax.numpy as jnp
from jax import lax
import numpy as np

D_MODEL = 1024
BATCH = 32
SEQ = 2048
DEPTH = 1

CHUNK = 64
GMLP_BLOCK = 128
GMLP_WIDTH = D_MODEL
GMLP_GROUPS = 8
GMLP_GROUP_DIM = GMLP_WIDTH // GMLP_GROUPS
CONV_WIDTH = D_MODEL
CONV_K = 3
PEER_HEADS = 8
PEER_KEY_DIM = 256
PEER_HALF = PEER_KEY_DIM // 2
PEER_N_KEYS = 128
PEER_N_EXPERTS = PEER_N_KEYS * PEER_N_KEYS
PEER_TOPK = 16
PEER_TOKEN_BLOCK = 128
IN_COLS = 2 * GMLP_WIDTH + 3 * CONV_WIDTH + 2 * D_MODEL
DEEPNORM_ALPHA = (2.0 * DEPTH) ** 0.25
DEEPNORM_BETA = (8.0 * DEPTH) ** -0.25
LN_EPS = 1e-5

kernel_name = "hybrid_gmlp_shortconv_peer_deepnorm_adaln"


def _layer_norm(x, g=None, b=None):
    xf = x.astype(jnp.float32)
    mu = jnp.mean(xf, axis=-1, keepdims=True)
    var = jnp.mean(jnp.square(xf - mu), axis=-1, keepdims=True)
    y = (xf - mu) * lax.rsqrt(var + LN_EPS)
    if g is not None:
        y = y * g.astype(jnp.float32) + b.astype(jnp.float32)
    return y.astype(x.dtype)


def _adaln(x, shift, scale):
    return _layer_norm(x) * (1 + scale[:, None, :]) + shift[:, None, :]


def _gmlp_mixer(u, v, ln_g, ln_b, w_s, b_s):
    bsz, seq, _ = v.shape
    u = jax.nn.gelu(u)
    v = _layer_norm(jax.nn.gelu(v), ln_g, ln_b)
    pos = jnp.arange(GMLP_BLOCK)
    mask = (pos[None, :] // CHUNK) <= (pos[:, None] // CHUNK)
    w = jnp.where(mask[None], w_s, 0)
    vb = v.reshape(bsz, seq // GMLP_BLOCK, GMLP_BLOCK, GMLP_GROUPS, GMLP_GROUP_DIM)
    mixed = jnp.einsum('gij,bnjgc->bnigc', w, vb) + b_s.T[None, None, :, :, None]
    return u * mixed.reshape(bsz, seq, GMLP_WIDTH)


def _short_conv_mixer(g_b, g_c, z, conv_w):
    seq = z.shape[1]
    zc = jnp.pad(g_c * z, ((0, 0), (CONV_K - 1, 0), (0, 0)))
    y = sum(zc[:, k:k + seq] * conv_w[k] for k in range(CONV_K))
    return g_b * y


def _peer(h, w_q, sub_keys, expert_u, expert_v):
    bsz, seq, d = h.shape
    xt = h.reshape((bsz * seq) // PEER_TOKEN_BLOCK, PEER_TOKEN_BLOCK, d)

    def block(xb):
        t = xb.shape[0]
        q = (xb @ w_q).reshape(t, PEER_HEADS, 2, PEER_HALF)
        s = jnp.einsum('thpd,hpkd->thpk', q, sub_keys).astype(jnp.float32)
        s1, i1 = lax.top_k(s[:, :, 0], PEER_TOPK)
        s2, i2 = lax.top_k(s[:, :, 1], PEER_TOPK)
        cand_s = (s1[..., :, None] + s2[..., None, :]).reshape(t, PEER_HEADS, PEER_TOPK * PEER_TOPK)
        cand_i = (i1[..., :, None] * PEER_N_KEYS + i2[..., None, :]).reshape(t, PEER_HEADS, PEER_TOPK * PEER_TOPK)
        top_s, sel = lax.top_k(cand_s, PEER_TOPK)
        idx = jnp.take_along_axis(cand_i, sel, axis=-1)
        gate = jax.nn.softmax(top_s, axis=-1).astype(xb.dtype)
        u = jnp.take(expert_u, idx, axis=0)
        act = jax.nn.gelu(jnp.einsum('thkd,td->thk', u, xb))
        v = jnp.take(expert_v, idx, axis=0)
        return jnp.einsum('thk,thkd->td', gate * act, v)

    return lax.map(block, xt).reshape(bsz, seq, d)


def setup_inputs(seed: int = 0) -> dict:
    key = jax.random.key(seed)
    ks = jax.random.split(key, 24)
    nrm = lambda k, shape, s: jax.random.normal(k, shape, jnp.float32) * s
    L, D = DEPTH, D_MODEL
    gate_bias = jnp.concatenate([jnp.zeros((2 * D,)), jnp.ones((D,))] * 2)
    return {
        "x": nrm(ks[0], (BATCH, SEQ, D), 1.0),
        "c": nrm(ks[1], (BATCH, D), 1.0),
        "w_cond": nrm(ks[2], (L, D, 6 * D), 0.5 * D ** -0.5),
        "b_cond": gate_bias[None] + nrm(ks[3], (L, 6 * D), 0.02),
        "w_in": nrm(ks[4], (L, D, IN_COLS), D ** -0.5),
        "gmlp_ln_g": 1.0 + nrm(ks[5], (L, GMLP_WIDTH), 0.05),
        "gmlp_ln_b": nrm(ks[6], (L, GMLP_WIDTH), 0.02),
        "w_spatial": nrm(ks[7], (L, GMLP_GROUPS, GMLP_BLOCK, GMLP_BLOCK), GMLP_BLOCK ** -0.5),
        "b_spatial": 1.0 + nrm(ks[8], (L, GMLP_GROUPS, GMLP_BLOCK), 0.1),
        "conv_w": nrm(ks[9], (L, CONV_K, CONV_WIDTH), CONV_K ** -0.5),
        "p_a": nrm(ks[10], (L, GMLP_WIDTH, D), DEEPNORM_BETA * GMLP_WIDTH ** -0.5),
        "p_b": nrm(ks[11], (L, CONV_WIDTH, D), DEEPNORM_BETA * CONV_WIDTH ** -0.5),
        "w_o": nrm(ks[12], (L, D, D), DEEPNORM_BETA * D ** -0.5),
        "ln1_g": 1.0 + nrm(ks[13], (L, D), 0.05),
        "ln1_b": nrm(ks[14], (L, D), 0.02),
        "w_q_peer": nrm(ks[15], (L, D, PEER_HEADS * PEER_KEY_DIM), D ** -0.5),
        "sub_keys": nrm(ks[16], (L, PEER_HEADS, 2, PEER_N_KEYS, PEER_HALF), PEER_HALF ** -0.5),
        "expert_u": nrm(ks[17], (L, PEER_N_EXPERTS, D), D ** -0.5),
        "expert_v": nrm(ks[18], (L, PEER_N_EXPERTS, D), DEEPNORM_BETA),
        "ln2_g": 1.0 + nrm(ks[19], (L, D), 0.05),
        "ln2_b": nrm(ks[20], (L, D), 0.02),
    }


def reference(x, c, w_cond, b_cond, w_in, gmlp_ln_g, gmlp_ln_b, w_spatial, b_spatial,
              conv_w, p_a, p_b, w_o, ln1_g, ln1_b, w_q_peer, sub_keys, expert_u,
              expert_v, ln2_g, ln2_b):
    o_v = GMLP_WIDTH
    o_b = 2 * GMLP_WIDTH
    o_c = o_b + CONV_WIDTH
    o_z = o_c + CONV_WIDTH
    o_ga = o_z + CONV_WIDTH
    o_gb = o_ga + D_MODEL
    for l in range(DEPTH):
        mod = jax.nn.silu(c) @ w_cond[l] + b_cond[l]
        sh1, sc1, g1, sh2, sc2, g2 = jnp.split(mod, 6, axis=-1)

        h = _adaln(x, sh1, sc1)
        proj = h @ w_in[l]
        y_a = _gmlp_mixer(proj[..., :o_v], proj[..., o_v:o_b], gmlp_ln_g[l], gmlp_ln_b[l],
                          w_spatial[l], b_spatial[l])
        y_b = _short_conv_mixer(proj[..., o_b:o_c], proj[..., o_c:o_z], proj[..., o_z:o_ga],
                                conv_w[l])
        merged = (jax.nn.sigmoid(proj[..., o_ga:o_gb]) * (y_a @ p_a[l])
                  + jax.nn.sigmoid(proj[..., o_gb:]) * (y_b @ p_b[l]))
        mix = merged @ w_o[l]
        x = _layer_norm(DEEPNORM_ALPHA * x + g1[:, None, :] * mix, ln1_g[l], ln1_b[l])

        h2 = _adaln(x, sh2, sc2)
        ffn = _peer(h2, w_q_peer[l], sub_keys[l], expert_u[l], expert_v[l])
        x = _layer_norm(DEEPNORM_ALPHA * x + g2[:, None, :] * ffn, ln2_g[l], ln2_b[l])
    return x
```

```cpp
#include <hip/hip_runtime.h>
#include <cstdio>
#include <cstdint>

#ifndef MK_N_LAUNCHES
#define MK_N_LAUNCHES 10
#endif

#define GAS __attribute__((address_space(1)))
#define LAS __attribute__((address_space(3)))
#define PG8_LAS __attribute__((address_space(3)))
typedef unsigned short bf16;
typedef unsigned v4u __attribute__((ext_vector_type(4)));
typedef unsigned v2u __attribute__((ext_vector_type(2)));
typedef float f32x4 __attribute__((ext_vector_type(4)));
typedef float f32x2 __attribute__((ext_vector_type(2)));
typedef short bf16x8 __attribute__((ext_vector_type(8)));
typedef short s16x4 __attribute__((ext_vector_type(4)));
typedef __bf16 bf16x2 __attribute__((ext_vector_type(2)));
typedef GAS unsigned gu32;

constexpr int D = 1024, BATCH = 32, SEQ = 2048, M = BATCH * SEQ;
constexpr int NIN = 7168, NQ = 2048, NE = 16384, NMOD = 6144;
constexpr float LN_EPS = 1e-5f, ALPHA = 1.189207115002721f;
constexpr int NPHASE = 10;

constexpr size_t MiB = 1u << 20;
constexpr size_t WS_CTL = 0, CTL_ZERO_BYTES = 1 * MiB;
constexpr size_t WS_MOD = 1 * MiB;
constexpr size_t WS_WIN = 2 * MiB, WS_PA = 16 * MiB, WS_PB = 18 * MiB, WS_WO = 20 * MiB, WS_WQ = 22 * MiB, WS_KEYS = 26 * MiB, WS_WSP = 26 * MiB + 512 * 1024;
constexpr size_t WS_EU = 32 * MiB, WS_EV = 64 * MiB, WS_SEL = 96 * MiB;
constexpr size_t WS_U = 128 * MiB;
constexpr size_t WS_END = 1024 * MiB;
constexpr size_t SEG = (size_t)M * D;
constexpr int CW_TMO = 0, CW_BAR = 4096;

constexpr int RING_BYTES = 131072;
constexpr int LDSCTL_OFF = 155648, MISC_OFF = LDSCTL_OFF + 320;
constexpr int LDS_BYTES = 156672;

__device__ __forceinline__ float bf_lo(unsigned w) { return __uint_as_float(w << 16); }
__device__ __forceinline__ float bf_hi(unsigned w) { return __uint_as_float(w & 0xffff0000u); }
__device__ __forceinline__ unsigned pk_bf16(float lo, float hi) { unsigned r; asm("v_cvt_pk_bf16_f32 %0, %1, %2" : "=v"(r) : "v"(lo), "v"(hi)); return r; }
__device__ __forceinline__ float vmaxf(float a, float b) { float r; asm("v_max_f32 %0, %1, %2" : "=v"(r) : "v"(a), "v"(b)); return r; }
__device__ __forceinline__ float vminf(float a, float b) { float r; asm("v_min_f32 %0, %1, %2" : "=v"(r) : "v"(a), "v"(b)); return r; }
__device__ __forceinline__ float gelu_tanh(float x) {
    const float u = x * (1.5957691216057308f + 0.07135481627260025f * x * x);
    return x * __builtin_amdgcn_rcpf(1.0f + __builtin_amdgcn_exp2f(-1.4426950408889634f * u));
}
__device__ __forceinline__ float sigmoidf_(float x) { return __builtin_amdgcn_rcpf(1.0f + __builtin_amdgcn_exp2f(-1.4426950408889634f * x)); }
__device__ __forceinline__ float wave_sum(float v) {
#pragma unroll
    for (int o = 1; o < 64; o <<= 1) v += __shfl_xor(v, o);
    return v;
}
__device__ __forceinline__ float dot2_bf16(unsigned w, unsigned x, float acc) { return __builtin_amdgcn_fdot2_f32_bf16(__builtin_bit_cast(bf16x2, w), __builtin_bit_cast(bf16x2, x), acc, false); }
#define LDS_WAIT() asm volatile("s_waitcnt lgkmcnt(0)" ::: "memory")

namespace pg8 {
typedef unsigned short bf16_t;
typedef unsigned u32x4 __attribute__((ext_vector_type(4)));
constexpr int BM = 256, BK = 64, HALF = 128, HTB = HALF * BK * 2, STAGE_BYTES = 8 * HTB, NXCD = 8, WGM = 8;
__host__ __device__ __forceinline__ int lds_byte(int r, int c) { const int st = (r >> 4) * 2 + (c >> 5), rr = r & 15, cc = c & 31, ob = rr * 64 + cc * 2; return st * 1024 + (ob ^ (((ob >> 9) & 1) << 5)); }
__host__ __device__ __forceinline__ void stage_rc(int b, int& R, int& C) { const int st = b / 1024, sb = b % 1024, swz = sb ^ (((sb >> 9) & 1) << 5); R = (st >> 1) * 16 + swz / 64; C = (st & 1) * 32 + (swz % 64) / 2; }
__host__ __device__ __forceinline__ int perm32(int rho) { const int n = rho >> 4, i = rho & 15; return 8 * (i >> 2) + 4 * n + (i & 3); }

struct Unit { int pm, pn, z; };
struct Gemm { const bf16_t* A; const bf16_t* Bt; const bf16_t* A2; const bf16_t* Bt2; int M, N, K; };

__host__ __device__ __forceinline__ void tile_of(int wgid, int nwg, int nM, int nN, Unit& u) {
    { const int q = nwg / NXCD, r = nwg % NXCD, xcd = wgid % NXCD, off = wgid / NXCD; wgid = (xcd < r ? xcd * (q + 1) : r * (q + 1) + (xcd - r) * q) + off; }
    const int nig = WGM * nN, gid = wgid / nig, fm = gid * WGM, gsz = (nM - fm) < WGM ? (nM - fm) : WGM;
    u.pm = fm + ((wgid % nig) % gsz); u.pn = (wgid % nig) / gsz;
}
struct StaticOrder {
    int nM, nN, nwg, G, c;
    __host__ __device__ void init(int M_, int N_, int G_, int c_) { nM = M_ / BM; nN = N_ / BM; nwg = nM * nN; G = G_; c = c_; }
    __host__ __device__ bool next(int i, Unit& u) const {
        const long L = (long)i * G + c; if (L >= nwg) return false;
        tile_of((int)L, nwg, nM, nN, u); u.z = 0; return true;
    }
    __device__ __forceinline__ void a_ready(const Unit&) const {}
    __device__ __forceinline__ void done(const Unit&) const {}
};
struct DualOrder {
    int nM, nN, nwg, G, c;
    __host__ __device__ void init(int M_, int N_, int G_, int c_) { nM = M_ / BM; nN = N_ / BM; nwg = nM * nN; G = G_; c = c_; }
    __host__ __device__ bool next(int i, Unit& u) const {
        const long L = (long)(i >> 1) * G + c; if (L >= nwg) return false;
        tile_of((int)L, nwg, nM, nN, u); u.z = i & 1; return true;
    }
    __device__ __forceinline__ void a_ready(const Unit&) const {}
    __device__ __forceinline__ void done(const Unit&) const {}
};

template <class Epi, class Sched, bool ALIGN_EPI = false, bool SP2 = false>
__device__ __forceinline__ void gemm_phase(PG8_LAS unsigned char* lds, const Gemm g, const Sched& S, const Epi& E) {
    const int tid = threadIdx.x, wid = __builtin_amdgcn_readfirstlane(tid >> 6), lane = tid & 63, wr = wid >> 2, wc = wid & 3, fr = lane & 15, fq = lane >> 4;
    const int K = g.K, nt = K / BK;
    unsigned voffA[2], voffB[2];
#pragma unroll
    for (int i = 0; i < 2; ++i) { int R, C; stage_rc(tid * 16 + i * 8192, R, C); const int Rb = Epi::PERM ? ((R & ~31) + perm32(R & 31)) : R;
        voffA[i] = (unsigned)(R * K + C) * 2u; voffB[i] = (unsigned)(Rb * K + C) * 2u; }
    const size_t kstep = (size_t)(BK * 2);
    const size_t hstep = (size_t)HALF * K * 2;
    const size_t tstep = 2 * hstep;
    const unsigned ldsw = (unsigned)wid * 1024u;
    const int aoff = lds_byte(wr * 64 + fr, fq * 8), boff = lds_byte(wc * 32 + fr, fq * 8);
#define PG8_SA(b, h) (((b) * 2 + (h)) * HTB)
#define PG8_SB(b, h) ((4 + (b) * 2 + (h)) * HTB)
#define PG8_STAGE(bufoff, gbase, voff) do { _Pragma("unroll") for (int _i = 0; _i < 2; ++_i) \
        __builtin_amdgcn_global_load_lds((const unsigned*)((const char*)(gbase) + (voff)[_i]), (PG8_LAS unsigned*)(lds + (bufoff) + ldsw + _i * 8192), 16, 0, 0); } while (0)
#define PG8_LDA(dst, b, h) do { _Pragma("unroll") for (int m = 0; m < 4; ++m) _Pragma("unroll") for (int k = 0; k < 2; ++k) dst[m][k] = *(const PG8_LAS bf16x8*)(lds + PG8_SA(b, h) + aoff + m * 2048 + k * 1024); } while (0)
#define PG8_LDB(dst, b, h) do { _Pragma("unroll") for (int n = 0; n < 2; ++n) _Pragma("unroll") for (int k = 0; k < 2; ++k) dst[n][k] = *(const PG8_LAS bf16x8*)(lds + PG8_SB(b, h) + boff + n * 2048 + k * 1024); } while (0)
#define PG8_MMA(ai, bj, At, Bt) do { __builtin_amdgcn_s_setprio(1); _Pragma("unroll") for (int m = 0; m < 4; ++m) _Pragma("unroll") for (int n = 0; n < 2; ++n) _Pragma("unroll") for (int k = 0; k < 2; ++k) \
        acc[ai][bj][m][n] = __builtin_amdgcn_mfma_f32_16x16x32_bf16(Bt[n][k], At[m][k], acc[ai][bj][m][n], 0, 0, 0); __builtin_amdgcn_s_setprio(0); } while (0)
#define PG8_WAIT_V(n) asm volatile("s_waitcnt vmcnt(" #n ")" ::: "memory")
#define PG8_WAIT_L(n) asm volatile("s_waitcnt lgkmcnt(" #n ")" ::: "memory")
#define PG8_BAR __builtin_amdgcn_s_barrier()
#define PG8_SCHED __builtin_amdgcn_sched_barrier(0)
#define PG8_ABASE(u) ((const char*)((u).z ? g.A2 : g.A) + (size_t)(u).pm * tstep)
#define PG8_BBASE(u) ((const char*)((u).z ? g.Bt2 : g.Bt) + (size_t)(u).pn * tstep)
    Unit cur, nxt; int ui = 0;
    if (!S.next(0, cur)) return;
    f32x4 acc[2][2][4][2];
#pragma unroll
    for (int a = 0; a < 2; ++a)
#pragma unroll
        for (int b = 0; b < 2; ++b)
#pragma unroll
            for (int m = 0; m < 4; ++m)
#pragma unroll
                for (int n = 0; n < 2; ++n) acc[a][b][m][n] = (f32x4){0.f, 0.f, 0.f, 0.f};
    bf16x8 At[4][2], B0[2][2], B1[2][2];
    const char* cA = PG8_ABASE(cur); const char* cB = PG8_BBASE(cur);
    S.a_ready(cur);
    if constexpr (SP2) {
        PG8_STAGE(PG8_SB(0, 0), cB, voffB); PG8_STAGE(PG8_SB(0, 1), cB + hstep, voffB); PG8_STAGE(PG8_SA(0, 0), cA, voffA); PG8_STAGE(PG8_SA(0, 1), cA + hstep, voffA);
        if (wr == 1) PG8_BAR;
        PG8_WAIT_V(2); PG8_BAR;
        PG8_STAGE(PG8_SB(1, 0), cB + kstep, voffB); PG8_STAGE(PG8_SA(1, 0), cA + kstep, voffA); PG8_STAGE(PG8_SB(1, 1), cB + hstep + kstep, voffB);
        PG8_WAIT_V(6); PG8_BAR;
    } else {
        PG8_STAGE(PG8_SB(0, 0), cB, voffB); PG8_STAGE(PG8_SA(0, 0), cA, voffA); PG8_STAGE(PG8_SB(0, 1), cB + hstep, voffB); PG8_STAGE(PG8_SA(0, 1), cA + hstep, voffA);
        if (wr == 1) PG8_BAR;
        PG8_WAIT_V(4); PG8_BAR;
        PG8_STAGE(PG8_SB(1, 0), cB + kstep, voffB); PG8_STAGE(PG8_SA(1, 0), cA + kstep, voffA); PG8_STAGE(PG8_SB(1, 1), cB + hstep + kstep, voffB);
        PG8_WAIT_V(6); PG8_BAR;
    }
    for (;;) {
        const bool has_next = S.next(ui + 1, nxt);
        const char* nA = has_next ? PG8_ABASE(nxt) : cA; const char* nB = has_next ? PG8_BBASE(nxt) : cB;
        for (int t = 0; t < nt; t += 2) {
            const bool last = (t == nt - 2);
            const char* a1 = cA + (size_t)(t + 1) * kstep;
            const char* a2 = last ? nA : cA + (size_t)(t + 2) * kstep; const char* b2 = last ? nB : cB + (size_t)(t + 2) * kstep;
            const char* a3 = a2 + kstep; const char* b3 = b2 + kstep;
            if (last && has_next) S.a_ready(nxt);
            if constexpr (SP2) {
            PG8_LDB(B0, 0, 0); PG8_LDB(B1, 0, 1); PG8_SCHED; PG8_LDA(At, 0, 0); PG8_STAGE(PG8_SA(1, 1), a1 + hstep, voffA);
            PG8_WAIT_V(8); PG8_WAIT_L(0); PG8_BAR; PG8_MMA(0, 0, At, B0); PG8_MMA(0, 1, At, B1); PG8_BAR; PG8_SCHED;
            PG8_LDA(At, 0, 1); PG8_STAGE(PG8_SB(0, 0), b2, voffB); PG8_STAGE(PG8_SB(0, 1), b2 + hstep, voffB); PG8_STAGE(PG8_SA(0, 0), a2, voffA);
            PG8_WAIT_V(8); PG8_WAIT_L(0); PG8_BAR; PG8_MMA(1, 0, At, B0); PG8_MMA(1, 1, At, B1); PG8_BAR; PG8_SCHED;
            PG8_LDB(B0, 1, 0); PG8_LDB(B1, 1, 1); PG8_SCHED; PG8_LDA(At, 1, 0); PG8_STAGE(PG8_SA(0, 1), a2 + hstep, voffA);
            PG8_WAIT_V(8); PG8_WAIT_L(0); PG8_BAR; PG8_MMA(0, 0, At, B0); PG8_MMA(0, 1, At, B1); PG8_BAR; PG8_SCHED;
            PG8_LDA(At, 1, 1); PG8_STAGE(PG8_SB(1, 0), b3, voffB); PG8_STAGE(PG8_SB(1, 1), b3 + hstep, voffB); PG8_STAGE(PG8_SA(1, 0), a3, voffA);
            PG8_WAIT_V(8); PG8_WAIT_L(0); PG8_BAR; PG8_MMA(1, 0, At, B0); PG8_MMA(1, 1, At, B1); PG8_BAR; PG8_SCHED;
            } else {
            PG8_LDB(B0, 0, 0); PG8_SCHED; PG8_LDA(At, 0, 0); PG8_STAGE(PG8_SA(1, 1), a1 + hstep, voffA);
            PG8_WAIT_L(8); PG8_BAR; PG8_WAIT_L(0); PG8_MMA(0, 0, At, B0); PG8_BAR; PG8_SCHED;
            PG8_LDB(B1, 0, 1); PG8_STAGE(PG8_SB(0, 0), b2, voffB);
            PG8_BAR; PG8_WAIT_L(0); PG8_MMA(0, 1, At, B1); PG8_BAR;
            PG8_LDA(At, 0, 1); PG8_STAGE(PG8_SA(0, 0), a2, voffA);
            PG8_BAR; PG8_WAIT_L(0); PG8_MMA(1, 0, At, B0); PG8_BAR; PG8_SCHED;
            PG8_STAGE(PG8_SB(0, 1), b2 + hstep, voffB);
            PG8_WAIT_V(6); PG8_BAR; PG8_MMA(1, 1, At, B1); PG8_BAR;
            PG8_LDB(B0, 1, 0); PG8_SCHED; PG8_LDA(At, 1, 0); PG8_STAGE(PG8_SA(0, 1), a2 + hstep, voffA);
            PG8_WAIT_L(8); PG8_BAR; PG8_WAIT_L(0); PG8_MMA(0, 0, At, B0); PG8_BAR; PG8_SCHED;
            PG8_LDB(B1, 1, 1); PG8_STAGE(PG8_SB(1, 0), b3, voffB);
            PG8_BAR; PG8_WAIT_L(0); PG8_MMA(0, 1, At, B1); PG8_BAR;
            PG8_LDA(At, 1, 1); PG8_STAGE(PG8_SA(1, 0), a3, voffA);
            PG8_BAR; PG8_WAIT_L(0); PG8_MMA(1, 0, At, B0); PG8_BAR; PG8_SCHED;
            PG8_STAGE(PG8_SB(1, 1), b3 + hstep, voffB);
            PG8_WAIT_V(6); PG8_BAR; PG8_MMA(1, 1, At, B1); PG8_BAR;
            }
        }
        if constexpr (ALIGN_EPI) { if (wr == 0) PG8_BAR; }
        E(acc, cur, wr, wc, fr, fq);
        if (!has_next) break;
#pragma unroll
        for (int a = 0; a < 2; ++a)
#pragma unroll
            for (int b = 0; b < 2; ++b)
#pragma unroll
                for (int m = 0; m < 4; ++m)
#pragma unroll
                    for (int n = 0; n < 2; ++n) acc[a][b][m][n] = (f32x4){0.f, 0.f, 0.f, 0.f};
        cur = nxt; cA = nA; cB = nB; ++ui;
        if constexpr (ALIGN_EPI) { if (wr == 1) PG8_BAR; }
    }
    PG8_WAIT_V(0);
    if constexpr (!ALIGN_EPI) { if (wr == 0) PG8_BAR; }
    PG8_BAR;
#undef PG8_SA
#undef PG8_SB
#undef PG8_STAGE
#undef PG8_LDA
#undef PG8_LDB
#undef PG8_MMA
#undef PG8_WAIT_V
#undef PG8_WAIT_L
#undef PG8_BAR
#undef PG8_SCHED
#undef PG8_ABASE
#undef PG8_BBASE
}

struct EpiProj {
    static constexpr bool PERM = true;
    bf16_t* O;
    __device__ __forceinline__ void operator()(const f32x4 (&acc)[2][2][4][2], const Unit& u, int wr, int wc, int fr, int fq) const {
        const int s = u.pn >> 2, act = (s < 2) ? 1 : (s >= 5 ? 2 : 0);
        const int row0 = u.pm * BM + wr * 64 + fr, col0 = (u.pn & 3) * BM + wc * 32 + 8 * fq;
        bf16_t* base = O + (size_t)s * SEG;
#pragma unroll
        for (int ai = 0; ai < 2; ++ai)
#pragma unroll
            for (int m = 0; m < 4; ++m) { bf16_t* rowp = base + (size_t)(row0 + ai * HALF + m * 16) * D + col0;
#pragma unroll
                for (int bj = 0; bj < 2; ++bj) { f32x4 v0 = acc[ai][bj][m][0], v1 = acc[ai][bj][m][1];
                    if (act == 1) {
#pragma unroll
                        for (int j = 0; j < 4; ++j) { v0[j] = gelu_tanh(v0[j]); v1[j] = gelu_tanh(v1[j]); } }
                    else if (act == 2) {
#pragma unroll
                        for (int j = 0; j < 4; ++j) { v0[j] = sigmoidf_(v0[j]); v1[j] = sigmoidf_(v1[j]); } }
                    u32x4 w; w.x = pk_bf16(v0[0], v0[1]); w.y = pk_bf16(v0[2], v0[3]); w.z = pk_bf16(v1[0], v1[1]); w.w = pk_bf16(v1[2], v1[3]);
                    *(u32x4*)(rowp + bj * HALF) = w; } }
    }
};
struct EpiDual {
    static constexpr bool PERM = true;
    bf16_t* Mo; const bf16_t* SA; const bf16_t* SB;
    __device__ __forceinline__ void operator()(const f32x4 (&acc)[2][2][4][2], const Unit& u, int wr, int wc, int fr, int fq) const {
        const int row0 = u.pm * BM + wr * 64 + fr, col0 = u.pn * BM + wc * 32 + 8 * fq;
        const bf16_t* G = u.z ? SB : SA;
#pragma unroll
        for (int ai = 0; ai < 2; ++ai)
#pragma unroll
            for (int m = 0; m < 4; ++m) { const size_t ro = (size_t)(row0 + ai * HALF + m * 16) * D + col0;
#pragma unroll
                for (int bj = 0; bj < 2; ++bj) { const u32x4 gw = *(const u32x4*)(G + ro + bj * HALF);
                    f32x4 v0 = acc[ai][bj][m][0], v1 = acc[ai][bj][m][1];
                    v0[0] *= bf_lo(gw.x); v0[1] *= bf_hi(gw.x); v0[2] *= bf_lo(gw.y); v0[3] *= bf_hi(gw.y);
                    v1[0] *= bf_lo(gw.z); v1[1] *= bf_hi(gw.z); v1[2] *= bf_lo(gw.w); v1[3] *= bf_hi(gw.w);
                    if (u.z) { const u32x4 pw = *(const u32x4*)(Mo + ro + bj * HALF);
                        v0[0] += bf_lo(pw.x); v0[1] += bf_hi(pw.x); v0[2] += bf_lo(pw.y); v0[3] += bf_hi(pw.y);
                        v1[0] += bf_lo(pw.z); v1[1] += bf_hi(pw.z); v1[2] += bf_lo(pw.w); v1[3] += bf_hi(pw.w); }
                    u32x4 w; w.x = pk_bf16(v0[0], v0[1]); w.y = pk_bf16(v0[2], v0[3]); w.z = pk_bf16(v1[0], v1[1]); w.w = pk_bf16(v1[2], v1[3]);
                    *(u32x4*)(Mo + ro + bj * HALF) = w; } }
    }
};
struct EpiRes {
    static constexpr bool PERM = true;
    bf16_t* R; const float* X; const float* mod;
    __device__ __forceinline__ void operator()(const f32x4 (&acc)[2][2][4][2], const Unit& u, int wr, int wc, int fr, int fq) const {
        const int row0 = u.pm * BM + wr * 64 + fr, col0 = u.pn * BM + wc * 32 + 8 * fq;
        const int b = (u.pm * BM) >> 11;
        f32x4 g1[2][2];
#pragma unroll
        for (int bj = 0; bj < 2; ++bj)
#pragma unroll
            for (int n = 0; n < 2; ++n) g1[bj][n] = *(const f32x4*)(mod + (size_t)b * NMOD + 2048 + col0 + bj * HALF + 4 * n);
#pragma unroll
        for (int ai = 0; ai < 2; ++ai)
#pragma unroll
            for (int m = 0; m < 4; ++m) { const size_t ro = (size_t)(row0 + ai * HALF + m * 16) * D + col0;
#pragma unroll
                for (int bj = 0; bj < 2; ++bj) { const f32x4 x0 = *(const f32x4*)(X + ro + bj * HALF), x1 = *(const f32x4*)(X + ro + bj * HALF + 4);
                    const f32x4 v0 = x0 * ALPHA + g1[bj][0] * acc[ai][bj][m][0], v1 = x1 * ALPHA + g1[bj][1] * acc[ai][bj][m][1];
                    u32x4 w; w.x = pk_bf16(v0[0], v0[1]); w.y = pk_bf16(v0[2], v0[3]); w.z = pk_bf16(v1[0], v1[1]); w.w = pk_bf16(v1[2], v1[3]);
                    *(u32x4*)(R + ro + bj * HALF) = w; } }
    }
};
struct EpiPlain {
    static constexpr bool PERM = true;
    bf16_t* O; int ldc;
    __device__ __forceinline__ void operator()(const f32x4 (&acc)[2][2][4][2], const Unit& u, int wr, int wc, int fr, int fq) const {
        const int row0 = u.pm * BM + wr * 64 + fr, col0 = u.pn * BM + wc * 32 + 8 * fq;
#pragma unroll
        for (int ai = 0; ai < 2; ++ai)
#pragma unroll
            for (int m = 0; m < 4; ++m) { bf16_t* rowp = O + (size_t)(row0 + ai * HALF + m * 16) * ldc + col0;
#pragma unroll
                for (int bj = 0; bj < 2; ++bj) { const f32x4 v0 = acc[ai][bj][m][0], v1 = acc[ai][bj][m][1];
                    u32x4 w; w.x = pk_bf16(v0[0], v0[1]); w.y = pk_bf16(v0[2], v0[3]); w.z = pk_bf16(v1[0], v1[1]); w.w = pk_bf16(v1[2], v1[3]);
                    *(u32x4*)(rowp + bj * HALF) = w; } }
    }
};
}

#define XB_TMO      128
#define XB_XCNT(j)  (256  + 64 * (j))
#define XB_XSUB(j)  (1280 + 64 * (j))
#define XB_XGEN(j)  (2304 + 64 * (j))
#define XB_TOP      3328
#define XB_TOPGEN   3392
#define XCD_BAR_WORDS 3456
#define XB_SPIN_CAP (1u << 18)
__device__ __forceinline__ unsigned xb_ld(unsigned* p)              { return __hip_atomic_load(p, __ATOMIC_RELAXED, __HIP_MEMORY_SCOPE_AGENT); }
__device__ __forceinline__ unsigned xb_add(unsigned* p, unsigned v) { return __hip_atomic_fetch_add(p, v, __ATOMIC_RELAXED, __HIP_MEMORY_SCOPE_AGENT); }
__device__ __forceinline__ unsigned xb_xcc_id() { return (unsigned)__builtin_amdgcn_s_getreg((3 << 11) | 20) & 0xFu; }
#define XB_SPIN(cond, bar) do { unsigned _sp = 0; while (cond) { __builtin_amdgcn_s_sleep(1); \
    if ((++_sp & 255u) == 0u) { if (xb_ld(&(bar)[XB_TMO])) break; if (_sp > XB_SPIN_CAP) { atomicAdd(&(bar)[XB_TMO], 1u); break; } } } } while (0)
struct XcdBarrier { unsigned* bar; unsigned x; volatile LAS unsigned* st; };
__device__ __forceinline__ XcdBarrier xcd_barrier_post(unsigned* bar, volatile LAS unsigned* st) {
    XcdBarrier b; b.bar = bar; b.x = xb_xcc_id(); b.st = st;
    if (threadIdx.x == 0) (void)xb_add(&bar[XB_XCNT(b.x)], 1u);
    return b;
}
__device__ __forceinline__ void xcd_barrier_complete(unsigned* bar, unsigned x, unsigned& nloc, unsigned& nx) {
    const unsigned G = gridDim.x * gridDim.y * gridDim.z;
    unsigned sum, cnt, mine, sp = 0u;
    for (;;) {
        sum = 0u; cnt = 0u; mine = 0u;
#pragma unroll
        for (unsigned j = 0; j < 16; ++j) { const unsigned c = xb_ld(&bar[XB_XCNT(j)]); sum += c; cnt += (c > 0u) ? 1u : 0u; mine = (j == x) ? c : mine; }
        if (sum == G) break;
        __builtin_amdgcn_s_sleep(1);
        if ((++sp & 255u) == 0u) { if (xb_ld(&bar[XB_TMO])) break; if (sp > XB_SPIN_CAP) { atomicAdd(&bar[XB_TMO], 1u); break; } }
    }
    nloc = mine > 0u ? mine : 1u; nx = cnt > 0u ? cnt : 1u;
}
__device__ __forceinline__ void xcd_barrier(const XcdBarrier& b) {
    asm volatile("s_waitcnt vmcnt(0)" ::: "memory");
    __syncthreads();
    if (threadIdx.x == 0) {
        unsigned* bar = b.bar;
        __builtin_amdgcn_s_waitcnt(0);
        unsigned nloc = b.st[0], nx = b.st[1];
        if (nloc == 0u) { xcd_barrier_complete(bar, b.x, nloc, nx); b.st[0] = nloc; b.st[1] = nx; }
        const unsigned old = xb_add(&bar[XB_XSUB(b.x)], 1u);
        const unsigned gen = old / nloc;
        if (old + 1u == (gen + 1u) * nloc) {
            __builtin_amdgcn_fence(__ATOMIC_RELEASE, "agent");
            asm volatile("s_waitcnt vmcnt(0)" ::: "memory");
            const unsigned og = xb_add(&bar[XB_TOP], 1u);
            const unsigned tg = og / nx;
            if (og + 1u == (tg + 1u) * nx) xb_add(&bar[XB_TOPGEN], 1u);
            else XB_SPIN(xb_ld(&bar[XB_TOPGEN]) == tg, bar);
            __builtin_amdgcn_fence(__ATOMIC_ACQUIRE, "agent");
            xb_add(&bar[XB_XGEN(b.x)], 1u);
            asm volatile("s_waitcnt vmcnt(0)" ::: "memory");
        } else {
            XB_SPIN(xb_ld(&bar[XB_XGEN(b.x)]) == gen, bar);
            __builtin_amdgcn_fence(__ATOMIC_ACQUIRE, "agent");
            asm volatile("s_waitcnt vmcnt(0)" ::: "memory");
        }
    }
    __syncthreads();
}

struct Frame {
    LAS unsigned char* lds;
    int tid, lane, wave, G, gw, NGW;
    const float *x, *c, *w_cond, *b_cond, *w_in, *gln_g, *gln_b, *w_sp, *b_sp, *conv_w, *p_a, *p_b, *w_o, *ln1_g, *ln1_b, *w_q, *keys, *eu, *ev, *ln2_g, *ln2_b;
    float* out; float* mod;
    bf16 *Win_t, *Pa_t, *Pb_t, *Wo_t, *Wq_t, *Keys, *Wsp, *EU, *EV;
    unsigned* sel;
    bf16 *H, *B1, *B2, *B3, *B4, *B5, *B6;
};

__device__ __forceinline__ void p0_transpose_item(const float* W, int K, int N, bf16* WT, LAS float* scr, int item, int lane) {
    const int nblk = N / 32, kb = item / nblk, nb = item % nblk, k0 = 64 * kb, n0 = 32 * nb;
#pragma unroll 8
    for (int i = 0; i < 32; ++i) { const int kk = 2 * i + (lane >> 5); scr[kk * 33 + (lane & 31)] = W[(size_t)(k0 + kk) * N + n0 + (lane & 31)]; }
    LDS_WAIT(); asm volatile("" ::: "memory");
    const int c = lane & 7;
#pragma unroll
    for (int j = 0; j < 4; ++j) { const int n = (lane >> 3) + 8 * j; const LAS float* s = scr + (8 * c) * 33 + n;
        v4u o; o.x = pk_bf16(s[0 * 33], s[1 * 33]); o.y = pk_bf16(s[2 * 33], s[3 * 33]); o.z = pk_bf16(s[4 * 33], s[5 * 33]); o.w = pk_bf16(s[6 * 33], s[7 * 33]);
        *(GAS v4u*)(WT + (size_t)(n0 + n) * K + k0 + 8 * c) = o; }
    LDS_WAIT(); asm volatile("" ::: "memory");
}
__device__ __forceinline__ void p0_cond_item(Frame& F, int it) {
    LAS float* sc = (LAS float*)F.lds;
    for (int e = F.tid; e < 32768; e += 512) { const int b = e & 31, k = e >> 5; const float v = F.c[b * D + k]; sc[k * 32 + b] = v / (1.0f + __expf(-v)); }
    __syncthreads();
    float acc[32];
#pragma unroll
    for (int b = 0; b < 32; ++b) acc[b] = 0.f;
    const float* W = F.w_cond + it * 64 + F.lane;
    for (int k0 = F.wave * 128; k0 < F.wave * 128 + 128; k0 += 16) {
        float wv[16];
#pragma unroll
        for (int i = 0; i < 16; ++i) wv[i] = W[(size_t)(k0 + i) * NMOD];
#pragma unroll
        for (int i = 0; i < 16; ++i) { const LAS f32x4* s4 = (const LAS f32x4*)(sc + (k0 + i) * 32);
#pragma unroll
            for (int q = 0; q < 8; ++q) { const f32x4 s = s4[q]; acc[4 * q + 0] += s.x * wv[i]; acc[4 * q + 1] += s.y * wv[i]; acc[4 * q + 2] += s.z * wv[i]; acc[4 * q + 3] += s.w * wv[i]; } }
    }
    __syncthreads();
    LAS float* red = (LAS float*)F.lds;
#pragma unroll
    for (int b = 0; b < 32; ++b) red[(F.wave * 32 + b) * 64 + F.lane] = acc[b];
    __syncthreads();
#pragma unroll
    for (int i = 0; i < 4; ++i) { const int e = F.tid + 512 * i, b = e >> 6, ln = e & 63; float s = F.b_cond[it * 64 + ln];
#pragma unroll
        for (int w = 0; w < 8; ++w) s += red[(w * 32 + b) * 64 + ln];
        F.mod[b * NMOD + it * 64 + ln] = s; }
    __syncthreads();
}
__device__ __forceinline__ void cvt8(const float* src, bf16* dst, size_t i8) {
    const f32x4 a = *(const GAS f32x4*)(src + i8 * 8), b = *(const GAS f32x4*)(src + i8 * 8 + 4);
    v4u o; o.x = pk_bf16(a.x, a.y); o.y = pk_bf16(a.z, a.w); o.z = pk_bf16(b.x, b.y); o.w = pk_bf16(b.z, b.w);
    *(GAS v4u*)(dst + i8 * 8) = o;
}
__device__ __forceinline__ void phase0(Frame& F) {
    for (int it = blockIdx.x; it < NMOD / 64; it += F.G) p0_cond_item(F, it);
    LAS float* scr = (LAS float*)(F.lds + F.wave * 16384);
    constexpr int I_IN = (D / 64) * (NIN / 32), I_SQ = (D / 64) * (D / 32), I_Q = (D / 64) * (NQ / 32);
    constexpr int NITEMS = I_IN + 3 * I_SQ + I_Q;
    for (int it = F.gw; it < NITEMS; it += F.NGW) {
        int r = it;
        if (r < I_IN) { p0_transpose_item(F.w_in, D, NIN, F.Win_t, scr, r, F.lane); continue; } r -= I_IN;
        if (r < I_SQ) { p0_transpose_item(F.p_a, D, D, F.Pa_t, scr, r, F.lane); continue; } r -= I_SQ;
        if (r < I_SQ) { p0_transpose_item(F.p_b, D, D, F.Pb_t, scr, r, F.lane); continue; } r -= I_SQ;
        if (r < I_SQ) { p0_transpose_item(F.w_o, D, D, F.Wo_t, scr, r, F.lane); continue; } r -= I_SQ;
        p0_transpose_item(F.w_q, D, NQ, F.Wq_t, scr, r, F.lane);
    }
    const size_t gt = (size_t)blockIdx.x * 512 + F.tid, NT = (size_t)F.G * 512;
    for (size_t i = gt; i < (size_t)NE * D / 8; i += NT) { cvt8(F.eu, F.EU, i); cvt8(F.ev, F.EV, i); }
    for (size_t i = gt; i < (size_t)8 * 2 * 128 * 128 / 8; i += NT) cvt8(F.keys, F.Keys, i);
    for (size_t i = gt; i < (size_t)8 * 128 * 128 / 8; i += NT) {
        const int e = (int)i * 8, j = e & 127, ii = (e >> 7) & 127;
        if ((j >> 6) <= (ii >> 6)) cvt8(F.w_sp, F.Wsp, i); else *(GAS v4u*)(F.Wsp + i * 8) = (v4u){0u, 0u, 0u, 0u};
    }
}

__device__ __forceinline__ void phase1(Frame& F) {
    for (int blk = F.gw; blk < M / 32; blk += F.NGW) {
        const int r0 = blk * 32, b = r0 >> 11;
        const GAS f32x4* mp = (const GAS f32x4*)(F.mod + (size_t)b * NMOD) + F.lane;
        f32x4 sh[4], sc[4];
#pragma unroll
        for (int j = 0; j < 4; ++j) { sh[j] = mp[64 * j]; sc[j] = mp[256 + 64 * j] + 1.0f; }
#pragma unroll 2
        for (int r = 0; r < 32; ++r) {
            const GAS f32x4* xr = (const GAS f32x4*)(F.x + (size_t)(r0 + r) * D) + F.lane;
            f32x4 v[4]; float s = 0.f;
#pragma unroll
            for (int j = 0; j < 4; ++j) { v[j] = xr[64 * j]; s += (v[j].x + v[j].y) + (v[j].z + v[j].w); }
            const float mean = wave_sum(s) * (1.f / D); float s2 = 0.f;
#pragma unroll
            for (int j = 0; j < 4; ++j) { v[j] = v[j] - mean; s2 += (v[j].x * v[j].x + v[j].y * v[j].y) + (v[j].z * v[j].z + v[j].w * v[j].w); }
            const float rstd = 1.f / sqrtf(wave_sum(s2) * (1.f / D) + LN_EPS);
            GAS v2u* o8 = (GAS v2u*)(F.H + (size_t)(r0 + r) * D) + F.lane;
#pragma unroll
            for (int j = 0; j < 4; ++j) { const f32x4 y = v[j] * rstd * sc[j] + sh[j]; v2u o; o.x = pk_bf16(y.x, y.y); o.y = pk_bf16(y.z, y.w); o8[64 * j] = o; }
        }
    }
}

__device__ __forceinline__ unsigned off_b(unsigned row, unsigned ch) { return 256u * row + 16u * (ch ^ (((row & 3) << 2) | ((row >> 2) & 3))); }
__device__ __forceinline__ unsigned tr_read_addr_16(unsigned lane, unsigned c, unsigned ks, unsigned t) {
    const unsigned g = lane >> 4, q = (lane & 15) >> 2, p = lane & 3;
    return off_b(32 * ks + 8 * g + 4 * t + q, 2 * c + (p >> 1)) + 8 * (p & 1);
}
typedef short v4i16_t __attribute__((ext_vector_type(4)));
__device__ __forceinline__ s16x4 lds_tr(LAS unsigned char* p) { return __builtin_bit_cast(s16x4, __builtin_amdgcn_ds_read_tr16_b64_v4i16((LAS v4i16_t*)p)); }

__device__ __forceinline__ void phase3(Frame& F) {
    LAS f32x2* stat = (LAS f32x2*)(F.lds + 65536);
    const int fr = F.lane & 15, fq = F.lane >> 4;
    for (int blk = blockIdx.x; blk < M / 128; blk += F.G) {
        const size_t T0 = (size_t)blk * 128;
        for (int r = 0; r < 16; ++r) {
            const int j = 16 * F.wave + r;
            const GAS v4u* row = (const GAS v4u*)(F.B2 + (T0 + j) * D);
            const v4u a = row[F.lane], b = row[F.lane + 64];
            float v[16] = {bf_lo(a.x), bf_hi(a.x), bf_lo(a.y), bf_hi(a.y), bf_lo(a.z), bf_hi(a.z), bf_lo(a.w), bf_hi(a.w),
                           bf_lo(b.x), bf_hi(b.x), bf_lo(b.y), bf_hi(b.y), bf_lo(b.z), bf_hi(b.z), bf_lo(b.w), bf_hi(b.w)};
            float s = 0.f;
#pragma unroll
            for (int e = 0; e < 16; ++e) s += v[e];
            const float mean = wave_sum(s) * (1.f / D); float s2 = 0.f;
#pragma unroll
            for (int e = 0; e < 16; ++e) { const float d = v[e] - mean; s2 += d * d; }
            const float rstd = 1.f / sqrtf(wave_sum(s2) * (1.f / D) + LN_EPS);
            if (F.lane == 0) stat[j] = (f32x2){mean, rstd};
        }
        __syncthreads();
        for (int g = 0; g < 8; ++g) {
            LAS unsigned char* img = F.lds + (g & 1) * 32768;
            {
                const int ch = F.tid & 15;
                const GAS f32x4* lg = (const GAS f32x4*)(F.gln_g + g * 128 + 8 * ch); const GAS f32x4* lb = (const GAS f32x4*)(F.gln_b + g * 128 + 8 * ch);
                const f32x4 g0 = lg[0], g1 = lg[1], b0 = lb[0], b1 = lb[1];
#pragma unroll
                for (int i = 0; i < 4; ++i) { const int q = F.tid + 512 * i, j = q >> 4;
                    const v4u w = *(const GAS v4u*)(F.B2 + (T0 + j) * D + g * 128 + 8 * ch);
                    const f32x2 st = stat[j];
                    v4u o;
                    o.x = pk_bf16((bf_lo(w.x) - st.x) * st.y * g0.x + b0.x, (bf_hi(w.x) - st.x) * st.y * g0.y + b0.y);
                    o.y = pk_bf16((bf_lo(w.y) - st.x) * st.y * g0.z + b0.z, (bf_hi(w.y) - st.x) * st.y * g0.w + b0.w);
                    o.z = pk_bf16((bf_lo(w.z) - st.x) * st.y * g1.x + b1.x, (bf_hi(w.z) - st.x) * st.y * g1.y + b1.y);
                    o.w = pk_bf16((bf_lo(w.w) - st.x) * st.y * g1.z + b1.z, (bf_hi(w.w) - st.x) * st.y * g1.w + b1.w);
                    *(LAS v4u*)(img + off_b(j, ch)) = o; }
            }
            __syncthreads();
            f32x4 acc[8];
#pragma unroll
            for (int ct = 0; ct < 8; ++ct) acc[ct] = (f32x4){0.f, 0.f, 0.f, 0.f};
#pragma unroll
            for (int ks = 0; ks < 4; ++ks) {
                const bf16x8 wf = *(const GAS bf16x8*)(F.Wsp + ((size_t)(g * 128 + 16 * F.wave + fr)) * 128 + 32 * ks + 8 * fq);
#pragma unroll
                for (int ct = 0; ct < 8; ++ct) {
                    const s16x4 t0 = lds_tr(img + tr_read_addr_16(F.lane, ct, ks, 0)), t1 = lds_tr(img + tr_read_addr_16(F.lane, ct, ks, 1));
                    const bf16x8 vf = {t0[0], t0[1], t0[2], t0[3], t1[0], t1[1], t1[2], t1[3]};
                    acc[ct] = __builtin_amdgcn_mfma_f32_16x16x32_bf16(vf, wf, acc[ct], 0, 0, 0);
                }
            }
            const int i = 16 * F.wave + fr;
            const float bias = F.b_sp[g * 128 + i];
            GAS v2u* up = (GAS v2u*)(F.B1 + (T0 + i) * D + g * 128 + 4 * fq);
#pragma unroll
            for (int ct = 0; ct < 8; ++ct) { const v2u uu = up[4 * ct];
                v2u o; o.x = pk_bf16(bf_lo(uu.x) * (acc[ct][0] + bias), bf_hi(uu.x) * (acc[ct][1] + bias)); o.y = pk_bf16(bf_lo(uu.y) * (acc[ct][2] + bias), bf_hi(uu.y) * (acc[ct][3] + bias));
                up[4 * ct] = o; }
        }
        __syncthreads();
    }
    for (int it = F.gw; it < (M / 64) * 2; it += F.NGW) {
        const int t0 = (it >> 1) * 64, col = (it & 1) * 512 + F.lane * 8;
        float w0[8], w1[8], w2[8], p1[8], p2[8];
#pragma unroll
        for (int e = 0; e < 8; ++e) { w0[e] = F.conv_w[col + e]; w1[e] = F.conv_w[D + col + e]; w2[e] = F.conv_w[2 * D + col + e]; p1[e] = 0.f; p2[e] = 0.f; }
        if ((t0 & (SEQ - 1)) != 0) {
            const v4u c1 = *(const GAS v4u*)(F.B4 + (size_t)(t0 - 1) * D + col), z1 = *(const GAS v4u*)(F.B5 + (size_t)(t0 - 1) * D + col);
            const v4u c2 = *(const GAS v4u*)(F.B4 + (size_t)(t0 - 2) * D + col), z2 = *(const GAS v4u*)(F.B5 + (size_t)(t0 - 2) * D + col);
            p1[0] = bf_lo(c1.x) * bf_lo(z1.x); p1[1] = bf_hi(c1.x) * bf_hi(z1.x); p1[2] = bf_lo(c1.y) * bf_lo(z1.y); p1[3] = bf_hi(c1.y) * bf_hi(z1.y);
            p1[4] = bf_lo(c1.z) * bf_lo(z1.z); p1[5] = bf_hi(c1.z) * bf_hi(z1.z); p1[6] = bf_lo(c1.w) * bf_lo(z1.w); p1[7] = bf_hi(c1.w) * bf_hi(z1.w);
            p2[0] = bf_lo(c2.x) * bf_lo(z2.x); p2[1] = bf_hi(c2.x) * bf_hi(z2.x); p2[2] = bf_lo(c2.y) * bf_lo(z2.y); p2[3] = bf_hi(c2.y) * bf_hi(z2.y);
            p2[4] = bf_lo(c2.z) * bf_lo(z2.z); p2[5] = bf_hi(c2.z) * bf_hi(z2.z); p2[6] = bf_lo(c2.w) * bf_lo(z2.w); p2[7] = bf_hi(c2.w) * bf_hi(z2.w);
        }
#pragma unroll 4
        for (int t = t0; t < t0 + 64; ++t) {
            const size_t o = (size_t)t * D + col;
            const v4u gb = *(const GAS v4u*)(F.B3 + o), gc = *(const GAS v4u*)(F.B4 + o), zz = *(const GAS v4u*)(F.B5 + o);
            float p[8], gbv[8], y[8];
            p[0] = bf_lo(gc.x) * bf_lo(zz.x); p[1] = bf_hi(gc.x) * bf_hi(zz.x); p[2] = bf_lo(gc.y) * bf_lo(zz.y); p[3] = bf_hi(gc.y) * bf_hi(zz.y);
            p[4] = bf_lo(gc.z) * bf_lo(zz.z); p[5] = bf_hi(gc.z) * bf_hi(zz.z); p[6] = bf_lo(gc.w) * bf_lo(zz.w); p[7] = bf_hi(gc.w) * bf_hi(zz.w);
            gbv[0] = bf_lo(gb.x); gbv[1] = bf_hi(gb.x); gbv[2] = bf_lo(gb.y); gbv[3] = bf_hi(gb.y); gbv[4] = bf_lo(gb.z); gbv[5] = bf_hi(gb.z); gbv[6] = bf_lo(gb.w); gbv[7] = bf_hi(gb.w);
#pragma unroll
            for (int e = 0; e < 8; ++e) { y[e] = gbv[e] * (w0[e] * p2[e] + w1[e] * p1[e] + w2[e] * p[e]); p2[e] = p1[e]; p1[e] = p[e]; }
            v4u ov; ov.x = pk_bf16(y[0], y[1]); ov.y = pk_bf16(y[2], y[3]); ov.z = pk_bf16(y[4], y[5]); ov.w = pk_bf16(y[6], y[7]);
            *(GAS v4u*)(F.B3 + o) = ov;
        }
    }
}

__device__ __forceinline__ void unpack16(const v4u a, const v4u b, float (&v)[16]) {
    v[0] = bf_lo(a.x); v[1] = bf_hi(a.x); v[2] = bf_lo(a.y); v[3] = bf_hi(a.y); v[4] = bf_lo(a.z); v[5] = bf_hi(a.z); v[6] = bf_lo(a.w); v[7] = bf_hi(a.w);
    v[8] = bf_lo(b.x); v[9] = bf_hi(b.x); v[10] = bf_lo(b.y); v[11] = bf_hi(b.y); v[12] = bf_lo(b.z); v[13] = bf_hi(b.z); v[14] = bf_lo(b.w); v[15] = bf_hi(b.w);
}
__device__ __forceinline__ void load16f(const float* p, int lane, float (&v)[16]) {
    const f32x4 a = *(const GAS f32x4*)(p + 8 * lane), b = *(const GAS f32x4*)(p + 8 * lane + 4), c = *(const GAS f32x4*)(p + 512 + 8 * lane), d = *(const GAS f32x4*)(p + 512 + 8 * lane + 4);
    v[0] = a.x; v[1] = a.y; v[2] = a.z; v[3] = a.w; v[4] = b.x; v[5] = b.y; v[6] = b.z; v[7] = b.w; v[8] = c.x; v[9] = c.y; v[10] = c.z; v[11] = c.w; v[12] = d.x; v[13] = d.y; v[14] = d.z; v[15] = d.w;
}
__device__ __forceinline__ void ln16(float (&v)[16]) {
    float s = 0.f;
#pragma unroll
    for (int e = 0; e < 16; ++e) s += v[e];
    const float mean = wave_sum(s) * (1.f / D); float s2 = 0.f;
#pragma unroll
    for (int e = 0; e < 16; ++e) { v[e] -= mean; s2 += v[e] * v[e]; }
    const float rstd = 1.f / sqrtf(wave_sum(s2) * (1.f / D) + LN_EPS);
#pragma unroll
    for (int e = 0; e < 16; ++e) v[e] *= rstd;
}
__device__ __forceinline__ void store16bf(bf16* p, int lane, const float (&v)[16]) {
    v4u a, b; a.x = pk_bf16(v[0], v[1]); a.y = pk_bf16(v[2], v[3]); a.z = pk_bf16(v[4], v[5]); a.w = pk_bf16(v[6], v[7]);
    b.x = pk_bf16(v[8], v[9]); b.y = pk_bf16(v[10], v[11]); b.z = pk_bf16(v[12], v[13]); b.w = pk_bf16(v[14], v[15]);
    ((GAS v4u*)p)[lane] = a; ((GAS v4u*)p)[lane + 64] = b;
}
__device__ __forceinline__ void phase6(Frame& F) {
    float g1[16], b1[16];
    load16f(F.ln1_g, F.lane, g1); load16f(F.ln1_b, F.lane, b1);
    for (int blk = F.gw; blk < M / 32; blk += F.NGW) {
        const int r0 = blk * 32, b = r0 >> 11;
        float sh[16], sc[16];
        load16f(F.mod + (size_t)b * NMOD + 3072, F.lane, sh); load16f(F.mod + (size_t)b * NMOD + 4096, F.lane, sc);
#pragma unroll 2
        for (int r = 0; r < 32; ++r) {
            const GAS v4u* rr = (const GAS v4u*)(F.B4 + (size_t)(r0 + r) * D);
            float v[16]; unpack16(rr[F.lane], rr[F.lane + 64], v);
            ln16(v);
#pragma unroll
            for (int e = 0; e < 16; ++e) v[e] = v[e] * g1[e] + b1[e];
            store16bf(F.B5 + (size_t)(r0 + r) * D, F.lane, v);
            ln16(v);
#pragma unroll
            for (int e = 0; e < 16; ++e) v[e] = v[e] * (1.0f + sc[e]) + sh[e];
            store16bf(F.B1 + (size_t)(r0 + r) * D, F.lane, v);
        }
    }
}

#define TOP_INSERT(top, v) do { float _v = (v); _Pragma("unroll") for (int _i = 0; _i < 16; ++_i) { const float _hi = vmaxf(top[_i], _v); _v = vminf(top[_i], _v); top[_i] = _hi; } } while (0)
#define TOP_MERGE(top, mask) do { float _p[16]; _Pragma("unroll") for (int _i = 0; _i < 16; ++_i) _p[_i] = __shfl_xor(top[_i], mask); \
    _Pragma("unroll") for (int _i = 0; _i < 16; ++_i) top[_i] = vmaxf(top[_i], _p[15 - _i]); \
    _Pragma("unroll") for (int _d = 8; _d >= 1; _d >>= 1) { _Pragma("unroll") for (int _i = 0; _i < 16; ++_i) if ((_i & _d) == 0) { const float _a = top[_i], _b = top[_i + _d]; top[_i] = vmaxf(_a, _b); top[_i + _d] = vminf(_a, _b); } } } while (0)
constexpr int S_PITCH = 144, T_PITCH = 20;
__device__ __forceinline__ void phase8(Frame& F) {
    LAS float* S = (LAS float*)F.lds;
    LAS float* tops = (LAS float*)(F.lds + 73728);
    const int fr = F.lane & 15, fq = F.lane >> 4;
    const bf16* Q = F.B6;
    for (int it = blockIdx.x; it < M / 64; it += F.G) {
        const size_t T0 = (size_t)it * 64;
        for (int h = 0; h < 8; ++h) {
            {
                const int p = F.wave >> 2, tq = F.wave & 3;
                bf16x8 a[4];
#pragma unroll
                for (int ks = 0; ks < 4; ++ks) a[ks] = *(const GAS bf16x8*)(Q + (T0 + 16 * tq + fr) * NQ + h * 256 + p * 128 + 32 * ks + 8 * fq);
                const bf16* kb = F.Keys + ((size_t)(h * 2 + p) * 128 + fr) * 128 + 8 * fq;
#pragma unroll
                for (int nt = 0; nt < 8; ++nt) {
                    f32x4 acc = (f32x4){0.f, 0.f, 0.f, 0.f};
#pragma unroll
                    for (int ks = 0; ks < 4; ++ks) { const bf16x8 bfr = *(const GAS bf16x8*)(kb + (size_t)nt * 16 * 128 + 32 * ks); acc = __builtin_amdgcn_mfma_f32_16x16x32_bf16(a[ks], bfr, acc, 0, 0, 0); }
#pragma unroll
                    for (int e = 0; e < 4; ++e) S[(p * 64 + 16 * tq + 4 * fq + e) * S_PITCH + 16 * nt + fr] = acc[e];
                }
            }
            __syncthreads();
            {
                const int prob = F.tid >> 2, sub = F.tid & 3;
                float top[16];
#pragma unroll
                for (int i = 0; i < 16; ++i) top[i] = -__builtin_inff();
#pragma unroll
                for (int i = 0; i < 8; ++i) { const int c = 4 * i + sub; const f32x4 v = *(const LAS f32x4*)(S + prob * S_PITCH + 4 * c);
#pragma unroll
                    for (int e = 0; e < 4; ++e) { const unsigned bits = (__float_as_uint(v[e]) & ~0x7Fu) | (unsigned)(127 - (4 * c + e)); TOP_INSERT(top, __uint_as_float(bits)); } }
                TOP_MERGE(top, 1); TOP_MERGE(top, 2);
                if (sub == 0) { LAS f32x4* tp = (LAS f32x4*)(tops + ((size_t)(h * 128 + prob)) * T_PITCH);
#pragma unroll
                    for (int i = 0; i < 4; ++i) tp[i] = (f32x4){top[4 * i], top[4 * i + 1], top[4 * i + 2], top[4 * i + 3]}; }
            }
            __syncthreads();
        }
        {
            const int h = F.wave, tok = F.lane;
            const LAS float* t1 = tops + ((size_t)(h * 128 + tok)) * T_PITCH; const LAS float* t2 = tops + ((size_t)(h * 128 + 64 + tok)) * T_PITCH;
            float L1[16], L2[16];
#pragma unroll
            for (int i = 0; i < 4; ++i) { const f32x4 x = ((const LAS f32x4*)t1)[i], y = ((const LAS f32x4*)t2)[i];
                L1[4 * i] = x.x; L1[4 * i + 1] = x.y; L1[4 * i + 2] = x.z; L1[4 * i + 3] = x.w; L2[4 * i] = y.x; L2[4 * i + 1] = y.y; L2[4 * i + 2] = y.z; L2[4 * i + 3] = y.w; }
            float top[16];
#pragma unroll
            for (int i = 0; i < 16; ++i) top[i] = -__builtin_inff();
#pragma unroll
            for (int a = 0; a < 16; ++a)
#pragma unroll
                for (int b = 0; b < 16; ++b) if ((a + 1) * (b + 1) <= 16) {
                    const unsigned bits = (__float_as_uint(L1[a] + L2[b]) & ~0xFFu) | (unsigned)(255 - (a * 16 + b)); TOP_INSERT(top, __uint_as_float(bits)); }
            float sv[16]; unsigned ex[16]; float mx = -__builtin_inff();
#pragma unroll
            for (int k = 0; k < 16; ++k) { const unsigned code = 255u - (__float_as_uint(top[k]) & 0xFFu); const float f1 = t1[code >> 4], f2 = t2[code & 15];
                const unsigned i1 = 127u - (__float_as_uint(f1) & 0x7Fu), i2 = 127u - (__float_as_uint(f2) & 0x7Fu);
                sv[k] = f1 + f2; ex[k] = i1 * 128u + i2; mx = fmaxf(mx, sv[k]); }
            float den = 0.f;
#pragma unroll
            for (int k = 0; k < 16; ++k) { sv[k] = __builtin_amdgcn_exp2f((sv[k] - mx) * 1.4426950408889634f); den += sv[k]; }
            const float inv = 1.0f / den;
            GAS v4u* sp = (GAS v4u*)(F.sel + (T0 + tok) * 128 + h * 16);
#pragma unroll
            for (int i = 0; i < 4; ++i) { v4u o;
                o.x = (ex[4 * i + 0] << 18) | (__float_as_uint(sv[4 * i + 0] * inv) >> 13); o.y = (ex[4 * i + 1] << 18) | (__float_as_uint(sv[4 * i + 1] * inv) >> 13);
                o.z = (ex[4 * i + 2] << 18) | (__float_as_uint(sv[4 * i + 2] * inv) >> 13); o.w = (ex[4 * i + 3] << 18) | (__float_as_uint(sv[4 * i + 3] * inv) >> 13);
                sp[i] = o; }
        }
        __syncthreads();
    }
}

__device__ __forceinline__ void phase9(Frame& F) {
    float l2g[16], l2b[16];
    load16f(F.ln2_g, F.lane, l2g); load16f(F.ln2_b, F.lane, l2b);
    for (int blk = F.gw; blk < M / 32; blk += F.NGW) {
        const int r0 = blk * 32, b = r0 >> 11;
        float g2[16]; load16f(F.mod + (size_t)b * NMOD + 5120, F.lane, g2);
        for (int r = 0; r < 32; ++r) {
            const size_t tok = (size_t)(r0 + r);
            const GAS v4u* hr = (const GAS v4u*)(F.B1 + tok * D);
            const v4u xa = hr[F.lane], xb = hr[F.lane + 64];
            float acc[16];
#pragma unroll
            for (int e = 0; e < 16; ++e) acc[e] = 0.f;
#pragma unroll
            for (int jj = 0; jj < 2; ++jj) {
                const unsigned selw = F.sel[tok * 128 + 64 * jj + F.lane];
#pragma unroll 4
                for (int e = 0; e < 64; ++e) {
                    const unsigned w = (unsigned)__builtin_amdgcn_readlane((int)selw, e);
                    const unsigned idx = w >> 18; const float gate = __uint_as_float((w & 0x3FFFFu) << 13);
                    const GAS v4u* ur = (const GAS v4u*)(F.EU + (size_t)idx * D); const GAS v4u* vr = (const GAS v4u*)(F.EV + (size_t)idx * D);
                    const v4u ua = ur[F.lane], ub = ur[F.lane + 64];
                    const v4u va = vr[F.lane], vb = vr[F.lane + 64];
                    float d0 = dot2_bf16(ua.x, xa.x, 0.f), d1 = dot2_bf16(ua.y, xa.y, 0.f);
                    d0 = dot2_bf16(ua.z, xa.z, d0); d1 = dot2_bf16(ua.w, xa.w, d1);
                    d0 = dot2_bf16(ub.x, xb.x, d0); d1 = dot2_bf16(ub.y, xb.y, d1);
                    d0 = dot2_bf16(ub.z, xb.z, d0); d1 = dot2_bf16(ub.w, xb.w, d1);
                    const float tot = wave_sum(d0 + d1);
                    const float coef = gate * gelu_tanh(tot);
                    float vv[16]; unpack16(va, vb, vv);
#pragma unroll
                    for (int q = 0; q < 16; ++q) acc[q] += coef * vv[q];
                }
            }
            const GAS v4u* xr = (const GAS v4u*)(F.B5 + tok * D);
            float y[16]; unpack16(xr[F.lane], xr[F.lane + 64], y);
#pragma unroll
            for (int e = 0; e < 16; ++e) y[e] = ALPHA * y[e] + g2[e] * acc[e];
            ln16(y);
#pragma unroll
            for (int e = 0; e < 16; ++e) y[e] = y[e] * l2g[e] + l2b[e];
            float* op = F.out + tok * D;
            *(GAS f32x4*)(op + 8 * F.lane) = (f32x4){y[0], y[1], y[2], y[3]}; *(GAS f32x4*)(op + 8 * F.lane + 4) = (f32x4){y[4], y[5], y[6], y[7]};
            *(GAS f32x4*)(op + 512 + 8 * F.lane) = (f32x4){y[8], y[9], y[10], y[11]}; *(GAS f32x4*)(op + 512 + 8 * F.lane + 4) = (f32x4){y[12], y[13], y[14], y[15]};
        }
    }
}

struct Args { const float* in[21]; float* out; unsigned char* ws; int ph_lo, ph_hi, li, pad; };
__global__ void __launch_bounds__(512, 2) fwd(Args args) {
    extern __shared__ __attribute__((aligned(16))) unsigned char lds[];
    Frame F;
    F.lds = (LAS unsigned char*)lds;
    volatile LAS unsigned* MISC = (volatile LAS unsigned*)(F.lds + MISC_OFF);
    F.tid = threadIdx.x; F.lane = F.tid & 63; F.wave = __builtin_amdgcn_readfirstlane(F.tid >> 6);
    F.G = gridDim.x; F.gw = blockIdx.x * 8 + F.wave; F.NGW = F.G * 8;
    unsigned char* ws = args.ws;
    gu32* ctl = (gu32*)(ws + WS_CTL);
    F.x = args.in[0]; F.c = args.in[1]; F.w_cond = args.in[2]; F.b_cond = args.in[3]; F.w_in = args.in[4]; F.gln_g = args.in[5]; F.gln_b = args.in[6];
    F.w_sp = args.in[7]; F.b_sp = args.in[8]; F.conv_w = args.in[9]; F.p_a = args.in[10]; F.p_b = args.in[11]; F.w_o = args.in[12]; F.ln1_g = args.in[13]; F.ln1_b = args.in[14];
    F.w_q = args.in[15]; F.keys = args.in[16]; F.eu = args.in[17]; F.ev = args.in[18]; F.ln2_g = args.in[19]; F.ln2_b = args.in[20];
    F.out = args.out; F.mod = (float*)(ws + WS_MOD);
    F.Win_t = (bf16*)(ws + WS_WIN); F.Pa_t = (bf16*)(ws + WS_PA); F.Pb_t = (bf16*)(ws + WS_PB); F.Wo_t = (bf16*)(ws + WS_WO); F.Wq_t = (bf16*)(ws + WS_WQ);
    F.Keys = (bf16*)(ws + WS_KEYS); F.Wsp = (bf16*)(ws + WS_WSP); F.EU = (bf16*)(ws + WS_EU); F.EV = (bf16*)(ws + WS_EV); F.sel = (unsigned*)(ws + WS_SEL);
    F.H = (bf16*)args.out;
    F.B1 = (bf16*)(ws + 1 * WS_U); F.B2 = (bf16*)(ws + 2 * WS_U); F.B3 = (bf16*)(ws + 3 * WS_U); F.B4 = (bf16*)(ws + 4 * WS_U); F.B5 = (bf16*)(ws + 5 * WS_U); F.B6 = (bf16*)(ws + 6 * WS_U);
    for (int u = F.tid; u < (LDS_BYTES - LDSCTL_OFF) / 4; u += 512) ((LAS unsigned*)(F.lds + LDSCTL_OFF))[u] = 0u;
    __syncthreads();
    XcdBarrier bar; bar.bar = (unsigned*)(ctl + CW_BAR); bar.x = 0; bar.st = nullptr;
    if (MK_N_LAUNCHES == 1) bar = xcd_barrier_post((unsigned*)(ctl + CW_BAR), MISC + 8);
    const int lo = args.ph_lo, hi = args.ph_hi;
#define IN(k) (lo <= (k) && (k) < hi)
#define SEAM(k) do { if (IN(k) && IN((k) + 1)) xcd_barrier(bar); } while (0)

    if (IN(0)) { phase0(F); SEAM(0); }
    if (IN(1)) { phase1(F); SEAM(1); }
    if (IN(2)) {
        pg8::Gemm g{F.H, F.Win_t, nullptr, nullptr, M, NIN, D}; pg8::StaticOrder S; S.init(M, NIN, F.G, (int)blockIdx.x);
        pg8::EpiProj E{F.B1};
        pg8::gemm_phase<pg8::EpiProj, pg8::StaticOrder, true, true>(F.lds, g, S, E);
        SEAM(2);
    }
    if (IN(3)) { phase3(F); SEAM(3); }
    if (IN(4)) {
        pg8::Gemm g{F.B1, F.Pa_t, F.B3, F.Pb_t, M, D, D}; pg8::DualOrder S; S.init(M, D, F.G, (int)blockIdx.x);
        pg8::EpiDual E{F.B2, F.B6, F.B6 + SEG};
        pg8::gemm_phase<pg8::EpiDual, pg8::DualOrder, true, true>(F.lds, g, S, E);
        SEAM(4);
    }
    if (IN(5)) {
        pg8::Gemm g{F.B2, F.Wo_t, nullptr, nullptr, M, D, D}; pg8::StaticOrder S; S.init(M, D, F.G, (int)blockIdx.x);
        pg8::EpiRes E{F.B4, F.x, F.mod};
        pg8::gemm_phase<pg8::EpiRes, pg8::StaticOrder, true, true>(F.lds, g, S, E);
        SEAM(5);
    }
    if (IN(6)) { phase6(F); SEAM(6); }
    if (IN(7)) {
        pg8::Gemm g{F.B1, F.Wq_t, nullptr, nullptr, M, NQ, D}; pg8::StaticOrder S; S.init(M, NQ, F.G, (int)blockIdx.x);
        pg8::EpiPlain E{F.B6, NQ};
        pg8::gemm_phase<pg8::EpiPlain, pg8::StaticOrder, true, true>(F.lds, g, S, E);
        SEAM(7);
    }
    if (IN(8)) { phase8(F); SEAM(8); }
    if (IN(9)) { phase9(F); }
#undef IN
#undef SEAM
}

extern "C" void kernel_launch(void* const* d_in, const int* in_sizes, int n_in, void* d_out, int out_size, void* d_ws, size_t ws_size, hipStream_t stream) {
    static int grid = 0;
    if (grid == 0) {
        if (n_in != 21 || in_sizes[0] != M * D || out_size != M * D || ws_size < WS_END) { fprintf(stderr, "kernel_launch: unexpected shapes (n_in %d, in0 %d, out %d, ws %zu); nothing launched\n", n_in, n_in > 0 ? in_sizes[0] : -1, out_size, ws_size); grid = -1; return; }
        int dev = 0, cus = 0, per_cu = 0;
        if (hipGetDevice(&dev) != hipSuccess || hipDeviceGetAttribute(&cus, hipDeviceAttributeMultiprocessorCount, dev) != hipSuccess) { grid = -1; return; }
        if (hipFuncSetAttribute((const void*)fwd, hipFuncAttributeMaxDynamicSharedMemorySize, LDS_BYTES) != hipSuccess) { fprintf(stderr, "kernel_launch: hipFuncSetAttribute failed\n"); grid = -1; return; }
        if (hipOccupancyMaxActiveBlocksPerMultiprocessor(&per_cu, (const void*)fwd, 512, LDS_BYTES) != hipSuccess || per_cu < 1) { fprintf(stderr, "kernel_launch: occupancy query reports %d workgroups per CU\n", per_cu); }
        (void)hipGetLastError();
        grid = cus;
    }
    if (grid < 0) return;
    if (hipMemsetAsync((char*)d_ws + WS_CTL, 0, CTL_ZERO_BYTES, stream) != hipSuccess) return;
    Args a{};
    for (int i = 0; i < 21; ++i) a.in[i] = (const float*)d_in[i];
    a.out = (float*)d_out; a.ws = (unsigned char*)d_ws;
    for (int li = 0; li < MK_N_LAUNCHES; ++li) {
        a.ph_lo = (MK_N_LAUNCHES == 1) ? 0 : li; a.ph_hi = (MK_N_LAUNCHES == 1) ? NPHASE : li + 1; a.li = li;
        hipLaunchKernelGGL(fwd, dim3(grid), dim3(512), LDS_BYTES, stream, a);
    }
}
```

```cpp
#include <hip/hip_runtime.h>
#include <cstdio>
#include <cstdint>

#ifndef MK_N_LAUNCHES
#define MK_N_LAUNCHES 1
#endif

#define GAS __attribute__((address_space(1)))
#define LAS __attribute__((address_space(3)))
#define PG8_LAS __attribute__((address_space(3)))
typedef unsigned short bf16;
typedef unsigned v4u __attribute__((ext_vector_type(4)));
typedef unsigned v2u __attribute__((ext_vector_type(2)));
typedef float f32x4 __attribute__((ext_vector_type(4)));
typedef float f32x2 __attribute__((ext_vector_type(2)));
typedef short bf16x8 __attribute__((ext_vector_type(8)));
typedef short s16x4 __attribute__((ext_vector_type(4)));
typedef __bf16 bf16x2 __attribute__((ext_vector_type(2)));
typedef GAS unsigned gu32;

constexpr int D = 1024, BATCH = 32, SEQ = 2048, M = BATCH * SEQ;
constexpr int NIN = 7168, NQ = 2048, NE = 16384, NMOD = 6144;
constexpr float LN_EPS = 1e-5f, ALPHA = 1.189207115002721f;
constexpr int NPHASE = 10;

constexpr size_t MiB = 1u << 20;
constexpr size_t WS_CTL = 0, CTL_ZERO_BYTES = 1 * MiB;
constexpr size_t WS_MOD = 1 * MiB;
constexpr size_t WS_WIN = 2 * MiB, WS_PA = 16 * MiB, WS_PB = 18 * MiB, WS_WO = 20 * MiB, WS_WQ = 22 * MiB, WS_KEYS = 26 * MiB, WS_WSP = 26 * MiB + 512 * 1024;
constexpr size_t WS_EU = 32 * MiB, WS_EV = 64 * MiB, WS_SEL = 96 * MiB;
constexpr size_t WS_U = 128 * MiB;
constexpr size_t WS_END = 1024 * MiB;
constexpr size_t SEG = (size_t)M * D;
constexpr int CW_TMO = 0, CW_BAR = 4096;

constexpr int RING_BYTES = 131072;
constexpr int LDSCTL_OFF = 155648, MISC_OFF = LDSCTL_OFF + 320;
constexpr int LDS_BYTES = 156672;

__device__ __forceinline__ float bf_lo(unsigned w) { return __uint_as_float(w << 16); }
__device__ __forceinline__ float bf_hi(unsigned w) { return __uint_as_float(w & 0xffff0000u); }
__device__ __forceinline__ unsigned pk_bf16(float lo, float hi) { unsigned r; asm("v_cvt_pk_bf16_f32 %0, %1, %2" : "=v"(r) : "v"(lo), "v"(hi)); return r; }
__device__ __forceinline__ float vmaxf(float a, float b) { float r; asm("v_max_f32 %0, %1, %2" : "=v"(r) : "v"(a), "v"(b)); return r; }
__device__ __forceinline__ float vminf(float a, float b) { float r; asm("v_min_f32 %0, %1, %2" : "=v"(r) : "v"(a), "v"(b)); return r; }
__device__ __forceinline__ float gelu_tanh(float x) {
    const float u = x * (1.5957691216057308f + 0.07135481627260025f * x * x);
    return x * __builtin_amdgcn_rcpf(1.0f + __builtin_amdgcn_exp2f(-1.4426950408889634f * u));
}
__device__ __forceinline__ float sigmoidf_(float x) { return __builtin_amdgcn_rcpf(1.0f + __builtin_amdgcn_exp2f(-1.4426950408889634f * x)); }
__device__ __forceinline__ float wave_sum(float v) {
#pragma unroll
    for (int o = 1; o < 64; o <<= 1) v += __shfl_xor(v, o);
    return v;
}
__device__ __forceinline__ float dot2_bf16(unsigned w, unsigned x, float acc) { return __builtin_amdgcn_fdot2_f32_bf16(__builtin_bit_cast(bf16x2, w), __builtin_bit_cast(bf16x2, x), acc, false); }
#define LDS_WAIT() asm volatile("s_waitcnt lgkmcnt(0)" ::: "memory")

namespace pg8 {
typedef unsigned short bf16_t;
typedef unsigned u32x4 __attribute__((ext_vector_type(4)));
constexpr int BM = 256, BK = 64, HALF = 128, HTB = HALF * BK * 2, STAGE_BYTES = 8 * HTB, NXCD = 8, WGM = 8;
__host__ __device__ __forceinline__ int lds_byte(int r, int c) { const int st = (r >> 4) * 2 + (c >> 5), rr = r & 15, cc = c & 31, ob = rr * 64 + cc * 2; return st * 1024 + (ob ^ (((ob >> 9) & 1) << 5)); }
__host__ __device__ __forceinline__ void stage_rc(int b, int& R, int& C) { const int st = b / 1024, sb = b % 1024, swz = sb ^ (((sb >> 9) & 1) << 5); R = (st >> 1) * 16 + swz / 64; C = (st & 1) * 32 + (swz % 64) / 2; }
__host__ __device__ __forceinline__ int perm32(int rho) { const int n = rho >> 4, i = rho & 15; return 8 * (i >> 2) + 4 * n + (i & 3); }

struct Unit { int pm, pn, z; };
struct Gemm { const bf16_t* A; const bf16_t* Bt; const bf16_t* A2; const bf16_t* Bt2; int M, N, K; };

__host__ __device__ __forceinline__ void tile_of(int wgid, int nwg, int nM, int nN, Unit& u) {
    { const int q = nwg / NXCD, r = nwg % NXCD, xcd = wgid % NXCD, off = wgid / NXCD; wgid = (xcd < r ? xcd * (q + 1) : r * (q + 1) + (xcd - r) * q) + off; }
    const int nig = WGM * nN, gid = wgid / nig, fm = gid * WGM, gsz = (nM - fm) < WGM ? (nM - fm) : WGM;
    u.pm = fm + ((wgid % nig) % gsz); u.pn = (wgid % nig) / gsz;
}
struct StaticOrder {
    int nM, nN, nwg, G, c;
    __host__ __device__ void init(int M_, int N_, int G_, int c_) { nM = M_ / BM; nN = N_ / BM; nwg = nM * nN; G = G_; c = c_; }
    __host__ __device__ bool next(int i, Unit& u) const {
        const long L = (long)i * G + c; if (L >= nwg) return false;
        tile_of((int)L, nwg, nM, nN, u); u.z = 0; return true;
    }
    __device__ __forceinline__ void a_ready(const Unit&) const {}
    __device__ __forceinline__ void done(const Unit&) const {}
};
struct DualOrder {
    int nM, nN, nwg, G, c;
    __host__ __device__ void init(int M_, int N_, int G_, int c_) { nM = M_ / BM; nN = N_ / BM; nwg = nM * nN; G = G_; c = c_; }
    __host__ __device__ bool next(int i, Unit& u) const {
        const long L = (long)(i >> 1) * G + c; if (L >= nwg) return false;
        tile_of((int)L, nwg, nM, nN, u); u.z = i & 1; return true;
    }
    __device__ __forceinline__ void a_ready(const Unit&) const {}
    __device__ __forceinline__ void done(const Unit&) const {}
};

template <class Epi, class Sched, bool ALIGN_EPI = false, bool SP2 = false>
__device__ __forceinline__ void gemm_phase(PG8_LAS unsigned char* lds, const Gemm g, const Sched& S, const Epi& E) {
    const int tid = threadIdx.x, wid = __builtin_amdgcn_readfirstlane(tid >> 6), lane = tid & 63, wr = wid >> 2, wc = wid & 3, fr = lane & 15, fq = lane >> 4;
    const int K = g.K, nt = K / BK;
    unsigned voffA[2], voffB[2];
#pragma unroll
    for (int i = 0; i < 2; ++i) { int R, C; stage_rc(tid * 16 + i * 8192, R, C); const int Rb = Epi::PERM ? ((R & ~31) + perm32(R & 31)) : R;
        voffA[i] = (unsigned)(R * K + C) * 2u; voffB[i] = (unsigned)(Rb * K + C) * 2u; }
    const size_t kstep = (size_t)(BK * 2);
    const size_t hstep = (size_t)HALF * K * 2;
    const size_t tstep = 2 * hstep;
    const unsigned ldsw = (unsigned)wid * 1024u;
    const int aoff = lds_byte(wr * 64 + fr, fq * 8), boff = lds_byte(wc * 32 + fr, fq * 8);
#define PG8_SA(b, h) (((b) * 2 + (h)) * HTB)
#define PG8_SB(b, h) ((4 + (b) * 2 + (h)) * HTB)
#define PG8_STAGE(bufoff, gbase, voff) do { _Pragma("unroll") for (int _i = 0; _i < 2; ++_i) \
        __builtin_amdgcn_global_load_lds((const unsigned*)((const char*)(gbase) + (voff)[_i]), (PG8_LAS unsigned*)(lds + (bufoff) + ldsw + _i * 8192), 16, 0, 0); } while (0)
#define PG8_LDA(dst, b, h) do { _Pragma("unroll") for (int m = 0; m < 4; ++m) _Pragma("unroll") for (int k = 0; k < 2; ++k) dst[m][k] = *(const PG8_LAS bf16x8*)(lds + PG8_SA(b, h) + aoff + m * 2048 + k * 1024); } while (0)
#define PG8_LDB(dst, b, h) do { _Pragma("unroll") for (int n = 0; n < 2; ++n) _Pragma("unroll") for (int k = 0; k < 2; ++k) dst[n][k] = *(const PG8_LAS bf16x8*)(lds + PG8_SB(b, h) + boff + n * 2048 + k * 1024); } while (0)
#define PG8_MMA(ai, bj, At, Bt) do { __builtin_amdgcn_s_setprio(1); _Pragma("unroll") for (int m = 0; m < 4; ++m) _Pragma("unroll") for (int n = 0; n < 2; ++n) _Pragma("unroll") for (int k = 0; k < 2; ++k) \
        acc[ai][bj][m][n] = __builtin_amdgcn_mfma_f32_16x16x32_bf16(Bt[n][k], At[m][k], acc[ai][bj][m][n], 0, 0, 0); __builtin_amdgcn_s_setprio(0); } while (0)
#define PG8_WAIT_V(n) asm volatile("s_waitcnt vmcnt(" #n ")" ::: "memory")
#define PG8_WAIT_L(n) asm volatile("s_waitcnt lgkmcnt(" #n ")" ::: "memory")
#define PG8_BAR __builtin_amdgcn_s_barrier()
#define PG8_SCHED __builtin_amdgcn_sched_barrier(0)
#define PG8_ABASE(u) ((const char*)((u).z ? g.A2 : g.A) + (size_t)(u).pm * tstep)
#define PG8_BBASE(u) ((const char*)((u).z ? g.Bt2 : g.Bt) + (size_t)(u).pn * tstep)
    Unit cur, nxt; int ui = 0;
    if (!S.next(0, cur)) return;
    f32x4 acc[2][2][4][2];
#pragma unroll
    for (int a = 0; a < 2; ++a)
#pragma unroll
        for (int b = 0; b < 2; ++b)
#pragma unroll
            for (int m = 0; m < 4; ++m)
#pragma unroll
                for (int n = 0; n < 2; ++n) acc[a][b][m][n] = (f32x4){0.f, 0.f, 0.f, 0.f};
    bf16x8 At[4][2], B0[2][2], B1[2][2];
    const char* cA = PG8_ABASE(cur); const char* cB = PG8_BBASE(cur);
    S.a_ready(cur);
    if constexpr (SP2) {
        PG8_STAGE(PG8_SB(0, 0), cB, voffB); PG8_STAGE(PG8_SB(0, 1), cB + hstep, voffB); PG8_STAGE(PG8_SA(0, 0), cA, voffA); PG8_STAGE(PG8_SA(0, 1), cA + hstep, voffA);
        if (wr == 1) PG8_BAR;
        PG8_WAIT_V(2); PG8_BAR;
        PG8_STAGE(PG8_SB(1, 0), cB + kstep, voffB); PG8_STAGE(PG8_SA(1, 0), cA + kstep, voffA); PG8_STAGE(PG8_SB(1, 1), cB + hstep + kstep, voffB);
        PG8_WAIT_V(6); PG8_BAR;
    } else {
        PG8_STAGE(PG8_SB(0, 0), cB, voffB); PG8_STAGE(PG8_SA(0, 0), cA, voffA); PG8_STAGE(PG8_SB(0, 1), cB + hstep, voffB); PG8_STAGE(PG8_SA(0, 1), cA + hstep, voffA);
        if (wr == 1) PG8_BAR;
        PG8_WAIT_V(4); PG8_BAR;
        PG8_STAGE(PG8_SB(1, 0), cB + kstep, voffB); PG8_STAGE(PG8_SA(1, 0), cA + kstep, voffA); PG8_STAGE(PG8_SB(1, 1), cB + hstep + kstep, voffB);
        PG8_WAIT_V(6); PG8_BAR;
    }
    for (;;) {
        const bool has_next = S.next(ui + 1, nxt);
        const char* nA = has_next ? PG8_ABASE(nxt) : cA; const char* nB = has_next ? PG8_BBASE(nxt) : cB;
        for (int t = 0; t < nt; t += 2) {
            const bool last = (t == nt - 2);
            const char* a1 = cA + (size_t)(t + 1) * kstep;
            const char* a2 = last ? nA : cA + (size_t)(t + 2) * kstep; const char* b2 = last ? nB : cB + (size_t)(t + 2) * kstep;
            const char* a3 = a2 + kstep; const char* b3 = b2 + kstep;
            if (last && has_next) S.a_ready(nxt);
            if constexpr (SP2) {
            PG8_LDB(B0, 0, 0); PG8_LDB(B1, 0, 1); PG8_SCHED; PG8_LDA(At, 0, 0); PG8_STAGE(PG8_SA(1, 1), a1 + hstep, voffA);
            PG8_WAIT_V(8); PG8_WAIT_L(0); PG8_BAR; PG8_MMA(0, 0, At, B0); PG8_MMA(0, 1, At, B1); PG8_BAR; PG8_SCHED;
            PG8_LDA(At, 0, 1); PG8_STAGE(PG8_SB(0, 0), b2, voffB); PG8_STAGE(PG8_SB(0, 1), b2 + hstep, voffB); PG8_STAGE(PG8_SA(0, 0), a2, voffA);
            PG8_WAIT_V(8); PG8_WAIT_L(0); PG8_BAR; PG8_MMA(1, 0, At, B0); PG8_MMA(1, 1, At, B1); PG8_BAR; PG8_SCHED;
            PG8_LDB(B0, 1, 0); PG8_LDB(B1, 1, 1); PG8_SCHED; PG8_LDA(At, 1, 0); PG8_STAGE(PG8_SA(0, 1), a2 + hstep, voffA);
            PG8_WAIT_V(8); PG8_WAIT_L(0); PG8_BAR; PG8_MMA(0, 0, At, B0); PG8_MMA(0, 1, At, B1); PG8_BAR; PG8_SCHED;
            PG8_LDA(At, 1, 1); PG8_STAGE(PG8_SB(1, 0), b3, voffB); PG8_STAGE(PG8_SB(1, 1), b3 + hstep, voffB); PG8_STAGE(PG8_SA(1, 0), a3, voffA);
            PG8_WAIT_V(8); PG8_WAIT_L(0); PG8_BAR; PG8_MMA(1, 0, At, B0); PG8_MMA(1, 1, At, B1); PG8_BAR; PG8_SCHED;
            } else {
            PG8_LDB(B0, 0, 0); PG8_SCHED; PG8_LDA(At, 0, 0); PG8_STAGE(PG8_SA(1, 1), a1 + hstep, voffA);
            PG8_WAIT_L(8); PG8_BAR; PG8_WAIT_L(0); PG8_MMA(0, 0, At, B0); PG8_BAR; PG8_SCHED;
            PG8_LDB(B1, 0, 1); PG8_STAGE(PG8_SB(0, 0), b2, voffB);
            PG8_BAR; PG8_WAIT_L(0); PG8_MMA(0, 1, At, B1); PG8_BAR;
            PG8_LDA(At, 0, 1); PG8_STAGE(PG8_SA(0, 0), a2, voffA);
            PG8_BAR; PG8_WAIT_L(0); PG8_MMA(1, 0, At, B0); PG8_BAR; PG8_SCHED;
            PG8_STAGE(PG8_SB(0, 1), b2 + hstep, voffB);
            PG8_WAIT_V(6); PG8_BAR; PG8_MMA(1, 1, At, B1); PG8_BAR;
            PG8_LDB(B0, 1, 0); PG8_SCHED; PG8_LDA(At, 1, 0); PG8_STAGE(PG8_SA(0, 1), a2 + hstep, voffA);
            PG8_WAIT_L(8); PG8_BAR; PG8_WAIT_L(0); PG8_MMA(0, 0, At, B0); PG8_BAR; PG8_SCHED;
            PG8_LDB(B1, 1, 1); PG8_STAGE(PG8_SB(1, 0), b3, voffB);
            PG8_BAR; PG8_WAIT_L(0); PG8_MMA(0, 1, At, B1); PG8_BAR;
            PG8_LDA(At, 1, 1); PG8_STAGE(PG8_SA(1, 0), a3, voffA);
            PG8_BAR; PG8_WAIT_L(0); PG8_MMA(1, 0, At, B0); PG8_BAR; PG8_SCHED;
            PG8_STAGE(PG8_SB(1, 1), b3 + hstep, voffB);
            PG8_WAIT_V(6); PG8_BAR; PG8_MMA(1, 1, At, B1); PG8_BAR;
            }
        }
        if constexpr (ALIGN_EPI) { if (wr == 0) PG8_BAR; }
        E(acc, cur, wr, wc, fr, fq);
        if (!has_next) break;
#pragma unroll
        for (int a = 0; a < 2; ++a)
#pragma unroll
            for (int b = 0; b < 2; ++b)
#pragma unroll
                for (int m = 0; m < 4; ++m)
#pragma unroll
                    for (int n = 0; n < 2; ++n) acc[a][b][m][n] = (f32x4){0.f, 0.f, 0.f, 0.f};
        cur = nxt; cA = nA; cB = nB; ++ui;
        if constexpr (ALIGN_EPI) { if (wr == 1) PG8_BAR; }
    }
    PG8_WAIT_V(0);
    if constexpr (!ALIGN_EPI) { if (wr == 0) PG8_BAR; }
    PG8_BAR;
#undef PG8_SA
#undef PG8_SB
#undef PG8_STAGE
#undef PG8_LDA
#undef PG8_LDB
#undef PG8_MMA
#undef PG8_WAIT_V
#undef PG8_WAIT_L
#undef PG8_BAR
#undef PG8_SCHED
#undef PG8_ABASE
#undef PG8_BBASE
}

struct EpiProj {
    static constexpr bool PERM = true;
    bf16_t* O;
    __device__ __forceinline__ void operator()(const f32x4 (&acc)[2][2][4][2], const Unit& u, int wr, int wc, int fr, int fq) const {
        const int s = u.pn >> 2, act = (s < 2) ? 1 : (s >= 5 ? 2 : 0);
        const int row0 = u.pm * BM + wr * 64 + fr, col0 = (u.pn & 3) * BM + wc * 32 + 8 * fq;
        bf16_t* base = O + (size_t)s * SEG;
#pragma unroll
        for (int ai = 0; ai < 2; ++ai)
#pragma unroll
            for (int m = 0; m < 4; ++m) { bf16_t* rowp = base + (size_t)(row0 + ai * HALF + m * 16) * D + col0;
#pragma unroll
                for (int bj = 0; bj < 2; ++bj) { f32x4 v0 = acc[ai][bj][m][0], v1 = acc[ai][bj][m][1];
                    if (act == 1) {
#pragma unroll
                        for (int j = 0; j < 4; ++j) { v0[j] = gelu_tanh(v0[j]); v1[j] = gelu_tanh(v1[j]); } }
                    else if (act == 2) {
#pragma unroll
                        for (int j = 0; j < 4; ++j) { v0[j] = sigmoidf_(v0[j]); v1[j] = sigmoidf_(v1[j]); } }
                    u32x4 w; w.x = pk_bf16(v0[0], v0[1]); w.y = pk_bf16(v0[2], v0[3]); w.z = pk_bf16(v1[0], v1[1]); w.w = pk_bf16(v1[2], v1[3]);
                    *(u32x4*)(rowp + bj * HALF) = w; } }
    }
};
struct EpiDual {
    static constexpr bool PERM = true;
    bf16_t* Mo; const bf16_t* SA; const bf16_t* SB;
    __device__ __forceinline__ void operator()(const f32x4 (&acc)[2][2][4][2], const Unit& u, int wr, int wc, int fr, int fq) const {
        const int row0 = u.pm * BM + wr * 64 + fr, col0 = u.pn * BM + wc * 32 + 8 * fq;
        const bf16_t* G = u.z ? SB : SA;
#pragma unroll
        for (int ai = 0; ai < 2; ++ai)
#pragma unroll
            for (int m = 0; m < 4; ++m) { const size_t ro = (size_t)(row0 + ai * HALF + m * 16) * D + col0;
#pragma unroll
                for (int bj = 0; bj < 2; ++bj) { const u32x4 gw = *(const u32x4*)(G + ro + bj * HALF);
                    f32x4 v0 = acc[ai][bj][m][0], v1 = acc[ai][bj][m][1];
                    v0[0] *= bf_lo(gw.x); v0[1] *= bf_hi(gw.x); v0[2] *= bf_lo(gw.y); v0[3] *= bf_hi(gw.y);
                    v1[0] *= bf_lo(gw.z); v1[1] *= bf_hi(gw.z); v1[2] *= bf_lo(gw.w); v1[3] *= bf_hi(gw.w);
                    if (u.z) { const u32x4 pw = *(const u32x4*)(Mo + ro + bj * HALF);
                        v0[0] += bf_lo(pw.x); v0[1] += bf_hi(pw.x); v0[2] += bf_lo(pw.y); v0[3] += bf_hi(pw.y);
                        v1[0] += bf_lo(pw.z); v1[1] += bf_hi(pw.z); v1[2] += bf_lo(pw.w); v1[3] += bf_hi(pw.w); }
                    u32x4 w; w.x = pk_bf16(v0[0], v0[1]); w.y = pk_bf16(v0[2], v0[3]); w.z = pk_bf16(v1[0], v1[1]); w.w = pk_bf16(v1[2], v1[3]);
                    *(u32x4*)(Mo + ro + bj * HALF) = w; } }
    }
};
struct EpiRes {
    static constexpr bool PERM = true;
    bf16_t* R; const float* X; const float* mod;
    __device__ __forceinline__ void operator()(const f32x4 (&acc)[2][2][4][2], const Unit& u, int wr, int wc, int fr, int fq) const {
        const int row0 = u.pm * BM + wr * 64 + fr, col0 = u.pn * BM + wc * 32 + 8 * fq;
        const int b = (u.pm * BM) >> 11;
        f32x4 g1[2][2];
#pragma unroll
        for (int bj = 0; bj < 2; ++bj)
#pragma unroll
            for (int n = 0; n < 2; ++n) g1[bj][n] = *(const f32x4*)(mod + (size_t)b * NMOD + 2048 + col0 + bj * HALF + 4 * n);
#pragma unroll
        for (int ai = 0; ai < 2; ++ai)
#pragma unroll
            for (int m = 0; m < 4; ++m) { const size_t ro = (size_t)(row0 + ai * HALF + m * 16) * D + col0;
#pragma unroll
                for (int bj = 0; bj < 2; ++bj) { const f32x4 x0 = *(const f32x4*)(X + ro + bj * HALF), x1 = *(const f32x4*)(X + ro + bj * HALF + 4);
                    const f32x4 v0 = x0 * ALPHA + g1[bj][0] * acc[ai][bj][m][0], v1 = x1 * ALPHA + g1[bj][1] * acc[ai][bj][m][1];
                    u32x4 w; w.x = pk_bf16(v0[0], v0[1]); w.y = pk_bf16(v0[2], v0[3]); w.z = pk_bf16(v1[0], v1[1]); w.w = pk_bf16(v1[2], v1[3]);
                    *(u32x4*)(R + ro + bj * HALF) = w; } }
    }
};
struct EpiPlain {
    static constexpr bool PERM = true;
    bf16_t* O; int ldc;
    __device__ __forceinline__ void operator()(const f32x4 (&acc)[2][2][4][2], const Unit& u, int wr, int wc, int fr, int fq) const {
        const int row0 = u.pm * BM + wr * 64 + fr, col0 = u.pn * BM + wc * 32 + 8 * fq;
#pragma unroll
        for (int ai = 0; ai < 2; ++ai)
#pragma unroll
            for (int m = 0; m < 4; ++m) { bf16_t* rowp = O + (size_t)(row0 + ai * HALF + m * 16) * ldc + col0;
#pragma unroll
                for (int bj = 0; bj < 2; ++bj) { const f32x4 v0 = acc[ai][bj][m][0], v1 = acc[ai][bj][m][1];
                    u32x4 w; w.x = pk_bf16(v0[0], v0[1]); w.y = pk_bf16(v0[2], v0[3]); w.z = pk_bf16(v1[0], v1[1]); w.w = pk_bf16(v1[2], v1[3]);
                    *(u32x4*)(rowp + bj * HALF) = w; } }
    }
};
}

#define XB_TMO      128
#define XB_XCNT(j)  (256  + 64 * (j))
#define XB_XSUB(j)  (1280 + 64 * (j))
#define XB_XGEN(j)  (2304 + 64 * (j))
#define XB_TOP      3328
#define XB_TOPGEN   3392
#define XCD_BAR_WORDS 3456
#define XB_SPIN_CAP (1u << 18)
__device__ __forceinline__ unsigned xb_ld(unsigned* p)              { return __hip_atomic_load(p, __ATOMIC_RELAXED, __HIP_MEMORY_SCOPE_AGENT); }
__device__ __forceinline__ unsigned xb_add(unsigned* p, unsigned v) { return __hip_atomic_fetch_add(p, v, __ATOMIC_RELAXED, __HIP_MEMORY_SCOPE_AGENT); }
__device__ __forceinline__ unsigned xb_xcc_id() { return (unsigned)__builtin_amdgcn_s_getreg((3 << 11) | 20) & 0xFu; }
#define XB_SPIN(cond, bar) do { unsigned _sp = 0; while (cond) { __builtin_amdgcn_s_sleep(1); \
    if ((++_sp & 255u) == 0u) { if (xb_ld(&(bar)[XB_TMO])) break; if (_sp > XB_SPIN_CAP) { atomicAdd(&(bar)[XB_TMO], 1u); break; } } } } while (0)
struct XcdBarrier { unsigned* bar; unsigned x; volatile LAS unsigned* st; };
__device__ __forceinline__ XcdBarrier xcd_barrier_post(unsigned* bar, volatile LAS unsigned* st) {
    XcdBarrier b; b.bar = bar; b.x = xb_xcc_id(); b.st = st;
    if (threadIdx.x == 0) (void)xb_add(&bar[XB_XCNT(b.x)], 1u);
    return b;
}
__device__ __forceinline__ void xcd_barrier_complete(unsigned* bar, unsigned x, unsigned& nloc, unsigned& nx) {
    const unsigned G = gridDim.x * gridDim.y * gridDim.z;
    unsigned sum, cnt, mine, sp = 0u;
    for (;;) {
        sum = 0u; cnt = 0u; mine = 0u;
#pragma unroll
        for (unsigned j = 0; j < 16; ++j) { const unsigned c = xb_ld(&bar[XB_XCNT(j)]); sum += c; cnt += (c > 0u) ? 1u : 0u; mine = (j == x) ? c : mine; }
        if (sum == G) break;
        __builtin_amdgcn_s_sleep(1);
        if ((++sp & 255u) == 0u) { if (xb_ld(&bar[XB_TMO])) break; if (sp > XB_SPIN_CAP) { atomicAdd(&bar[XB_TMO], 1u); break; } }
    }
    nloc = mine > 0u ? mine : 1u; nx = cnt > 0u ? cnt : 1u;
}
__device__ __forceinline__ void xcd_barrier(const XcdBarrier& b) {
    asm volatile("s_waitcnt vmcnt(0)" ::: "memory");
    __syncthreads();
    if (threadIdx.x == 0) {
        unsigned* bar = b.bar;
        __builtin_amdgcn_s_waitcnt(0);
        unsigned nloc = b.st[0], nx = b.st[1];
        if (nloc == 0u) { xcd_barrier_complete(bar, b.x, nloc, nx); b.st[0] = nloc; b.st[1] = nx; }
        const unsigned old = xb_add(&bar[XB_XSUB(b.x)], 1u);
        const unsigned gen = old / nloc;
        if (old + 1u == (gen + 1u) * nloc) {
            __builtin_amdgcn_fence(__ATOMIC_RELEASE, "agent");
            asm volatile("s_waitcnt vmcnt(0)" ::: "memory");
            const unsigned og = xb_add(&bar[XB_TOP], 1u);
            const unsigned tg = og / nx;
            if (og + 1u == (tg + 1u) * nx) xb_add(&bar[XB_TOPGEN], 1u);
            else XB_SPIN(xb_ld(&bar[XB_TOPGEN]) == tg, bar);
            __builtin_amdgcn_fence(__ATOMIC_ACQUIRE, "agent");
            xb_add(&bar[XB_XGEN(b.x)], 1u);
            asm volatile("s_waitcnt vmcnt(0)" ::: "memory");
        } else {
            XB_SPIN(xb_ld(&bar[XB_XGEN(b.x)]) == gen, bar);
            __builtin_amdgcn_fence(__ATOMIC_ACQUIRE, "agent");
            asm volatile("s_waitcnt vmcnt(0)" ::: "memory");
        }
    }
    __syncthreads();
}

struct Frame {
    LAS unsigned char* lds;
    int tid, lane, wave, G, gw, NGW;
    const float *x, *c, *w_cond, *b_cond, *w_in, *gln_g, *gln_b, *w_sp, *b_sp, *conv_w, *p_a, *p_b, *w_o, *ln1_g, *ln1_b, *w_q, *keys, *eu, *ev, *ln2_g, *ln2_b;
    float* out; float* mod;
    bf16 *Win_t, *Pa_t, *Pb_t, *Wo_t, *Wq_t, *Keys, *Wsp, *EU, *EV;
    unsigned* sel;
    bf16 *H, *B1, *B2, *B3, *B4, *B5, *B6;
};

__device__ __forceinline__ void p0_transpose_item(const float* W, int K, int N, bf16* WT, LAS float* scr, int item, int lane) {
    const int nblk = N / 32, kb = item / nblk, nb = item % nblk, k0 = 64 * kb, n0 = 32 * nb;
#pragma unroll 8
    for (int i = 0; i < 32; ++i) { const int kk = 2 * i + (lane >> 5); scr[kk * 33 + (lane & 31)] = W[(size_t)(k0 + kk) * N + n0 + (lane & 31)]; }
    LDS_WAIT(); asm volatile("" ::: "memory");
    const int c = lane & 7;
#pragma unroll
    for (int j = 0; j < 4; ++j) { const int n = (lane >> 3) + 8 * j; const LAS float* s = scr + (8 * c) * 33 + n;
        v4u o; o.x = pk_bf16(s[0 * 33], s[1 * 33]); o.y = pk_bf16(s[2 * 33], s[3 * 33]); o.z = pk_bf16(s[4 * 33], s[5 * 33]); o.w = pk_bf16(s[6 * 33], s[7 * 33]);
        *(GAS v4u*)(WT + (size_t)(n0 + n) * K + k0 + 8 * c) = o; }
    LDS_WAIT(); asm volatile("" ::: "memory");
}
__device__ __forceinline__ void p0_cond_item(Frame& F, int it) {
    LAS float* sc = (LAS float*)F.lds;
    for (int e = F.tid; e < 32768; e += 512) { const int b = e & 31, k = e >> 5; const float v = F.c[b * D + k]; sc[k * 32 + b] = v / (1.0f + __expf(-v)); }
    __syncthreads();
    float acc[32];
#pragma unroll
    for (int b = 0; b < 32; ++b) acc[b] = 0.f;
    const float* W = F.w_cond + it * 64 + F.lane;
    for (int k0 = F.wave * 128; k0 < F.wave * 128 + 128; k0 += 16) {
        float wv[16];
#pragma unroll
        for (int i = 0; i < 16; ++i) wv[i] = W[(size_t)(k0 + i) * NMOD];
#pragma unroll
        for (int i = 0; i < 16; ++i) { const LAS f32x4* s4 = (const LAS f32x4*)(sc + (k0 + i) * 32);
#pragma unroll
            for (int q = 0; q < 8; ++q) { const f32x4 s = s4[q]; acc[4 * q + 0] += s.x * wv[i]; acc[4 * q + 1] += s.y * wv[i]; acc[4 * q + 2] += s.z * wv[i]; acc[4 * q + 3] += s.w * wv[i]; } }
    }
    __syncthreads();
    LAS float* red = (LAS float*)F.lds;
#pragma unroll
    for (int b = 0; b < 32; ++b) red[(F.wave * 32 + b) * 64 + F.lane] = acc[b];
    __syncthreads();
#pragma unroll
    for (int i = 0; i < 4; ++i) { const int e = F.tid + 512 * i, b = e >> 6, ln = e & 63; float s = F.b_cond[it * 64 + ln];
#pragma unroll
        for (int w = 0; w < 8; ++w) s += red[(w * 32 + b) * 64 + ln];
        F.mod[b * NMOD + it * 64 + ln] = s; }
    __syncthreads();
}
__device__ __forceinline__ void cvt8(const float* src, bf16* dst, size_t i8) {
    const f32x4 a = *(const GAS f32x4*)(src + i8 * 8), b = *(const GAS f32x4*)(src + i8 * 8 + 4);
    v4u o; o.x = pk_bf16(a.x, a.y); o.y = pk_bf16(a.z, a.w); o.z = pk_bf16(b.x, b.y); o.w = pk_bf16(b.z, b.w);
    *(GAS v4u*)(dst + i8 * 8) = o;
}
__device__ __forceinline__ void phase0(Frame& F) {
    for (int it = blockIdx.x; it < NMOD / 64; it += F.G) p0_cond_item(F, it);
    LAS float* scr = (LAS float*)(F.lds + F.wave * 16384);
    constexpr int I_IN = (D / 64) * (NIN / 32), I_SQ = (D / 64) * (D / 32), I_Q = (D / 64) * (NQ / 32);
    constexpr int NITEMS = I_IN + 3 * I_SQ + I_Q;
    for (int it = F.gw; it < NITEMS; it += F.NGW) {
        int r = it;
        if (r < I_IN) { p0_transpose_item(F.w_in, D, NIN, F.Win_t, scr, r, F.lane); continue; } r -= I_IN;
        if (r < I_SQ) { p0_transpose_item(F.p_a, D, D, F.Pa_t, scr, r, F.lane); continue; } r -= I_SQ;
        if (r < I_SQ) { p0_transpose_item(F.p_b, D, D, F.Pb_t, scr, r, F.lane); continue; } r -= I_SQ;
        if (r < I_SQ) { p0_transpose_item(F.w_o, D, D, F.Wo_t, scr, r, F.lane); continue; } r -= I_SQ;
        p0_transpose_item(F.w_q, D, NQ, F.Wq_t, scr, r, F.lane);
    }
    const size_t gt = (size_t)blockIdx.x * 512 + F.tid, NT = (size_t)F.G * 512;
    for (size_t i = gt; i < (size_t)NE * D / 8; i += NT) { cvt8(F.eu, F.EU, i); cvt8(F.ev, F.EV, i); }
    for (size_t i = gt; i < (size_t)8 * 2 * 128 * 128 / 8; i += NT) cvt8(F.keys, F.Keys, i);
    for (size_t i = gt; i < (size_t)8 * 128 * 128 / 8; i += NT) {
        const int e = (int)i * 8, j = e & 127, ii = (e >> 7) & 127;
        if ((j >> 6) <= (ii >> 6)) cvt8(F.w_sp, F.Wsp, i); else *(GAS v4u*)(F.Wsp + i * 8) = (v4u){0u, 0u, 0u, 0u};
    }
}

__device__ __forceinline__ void phase1(Frame& F) {
    for (int blk = F.gw; blk < M / 32; blk += F.NGW) {
        const int r0 = blk * 32, b = r0 >> 11;
        const GAS f32x4* mp = (const GAS f32x4*)(F.mod + (size_t)b * NMOD) + F.lane;
        f32x4 sh[4], sc[4];
#pragma unroll
        for (int j = 0; j < 4; ++j) { sh[j] = mp[64 * j]; sc[j] = mp[256 + 64 * j] + 1.0f; }
#pragma unroll 2
        for (int r = 0; r < 32; ++r) {
            const GAS f32x4* xr = (const GAS f32x4*)(F.x + (size_t)(r0 + r) * D) + F.lane;
            f32x4 v[4]; float s = 0.f;
#pragma unroll
            for (int j = 0; j < 4; ++j) { v[j] = xr[64 * j]; s += (v[j].x + v[j].y) + (v[j].z + v[j].w); }
            const float mean = wave_sum(s) * (1.f / D); float s2 = 0.f;
#pragma unroll
            for (int j = 0; j < 4; ++j) { v[j] = v[j] - mean; s2 += (v[j].x * v[j].x + v[j].y * v[j].y) + (v[j].z * v[j].z + v[j].w * v[j].w); }
            const float rstd = 1.f / sqrtf(wave_sum(s2) * (1.f / D) + LN_EPS);
            GAS v2u* o8 = (GAS v2u*)(F.H + (size_t)(r0 + r) * D) + F.lane;
#pragma unroll
            for (int j = 0; j < 4; ++j) { const f32x4 y = v[j] * rstd * sc[j] + sh[j]; v2u o; o.x = pk_bf16(y.x, y.y); o.y = pk_bf16(y.z, y.w); o8[64 * j] = o; }
        }
    }
}

__device__ __forceinline__ unsigned off_b(unsigned row, unsigned ch) { return 256u * row + 16u * (ch ^ (((row & 3) << 2) | ((row >> 2) & 3))); }
__device__ __forceinline__ unsigned tr_read_addr_16(unsigned lane, unsigned c, unsigned ks, unsigned t) {
    const unsigned g = lane >> 4, q = (lane & 15) >> 2, p = lane & 3;
    return off_b(32 * ks + 8 * g + 4 * t + q, 2 * c + (p >> 1)) + 8 * (p & 1);
}
typedef short v4i16_t __attribute__((ext_vector_type(4)));
__device__ __forceinline__ s16x4 lds_tr(LAS unsigned char* p) { return __builtin_bit_cast(s16x4, __builtin_amdgcn_ds_read_tr16_b64_v4i16((LAS v4i16_t*)p)); }

__device__ __forceinline__ void phase3(Frame& F) {
    LAS f32x2* stat = (LAS f32x2*)(F.lds + 65536);
    const int fr = F.lane & 15, fq = F.lane >> 4;
    for (int blk = blockIdx.x; blk < M / 128; blk += F.G) {
        const size_t T0 = (size_t)blk * 128;
        for (int r = 0; r < 16; ++r) {
            const int j = 16 * F.wave + r;
            const GAS v4u* row = (const GAS v4u*)(F.B2 + (T0 + j) * D);
            const v4u a = row[F.lane], b = row[F.lane + 64];
            float v[16] = {bf_lo(a.x), bf_hi(a.x), bf_lo(a.y), bf_hi(a.y), bf_lo(a.z), bf_hi(a.z), bf_lo(a.w), bf_hi(a.w),
                           bf_lo(b.x), bf_hi(b.x), bf_lo(b.y), bf_hi(b.y), bf_lo(b.z), bf_hi(b.z), bf_lo(b.w), bf_hi(b.w)};
            float s = 0.f;
#pragma unroll
            for (int e = 0; e < 16; ++e) s += v[e];
            const float mean = wave_sum(s) * (1.f / D); float s2 = 0.f;
#pragma unroll
            for (int e = 0; e < 16; ++e) { const float d = v[e] - mean; s2 += d * d; }
            const float rstd = 1.f / sqrtf(wave_sum(s2) * (1.f / D) + LN_EPS);
            if (F.lane == 0) stat[j] = (f32x2){mean, rstd};
        }
        __syncthreads();
        for (int g = 0; g < 8; ++g) {
            LAS unsigned char* img = F.lds + (g & 1) * 32768;
            {
                const int ch = F.tid & 15;
                const GAS f32x4* lg = (const GAS f32x4*)(F.gln_g + g * 128 + 8 * ch); const GAS f32x4* lb = (const GAS f32x4*)(F.gln_b + g * 128 + 8 * ch);
                const f32x4 g0 = lg[0], g1 = lg[1], b0 = lb[0], b1 = lb[1];
#pragma unroll
                for (int i = 0; i < 4; ++i) { const int q = F.tid + 512 * i, j = q >> 4;
                    const v4u w = *(const GAS v4u*)(F.B2 + (T0 + j) * D + g * 128 + 8 * ch);
                    const f32x2 st = stat[j];
                    v4u o;
                    o.x = pk_bf16((bf_lo(w.x) - st.x) * st.y * g0.x + b0.x, (bf_hi(w.x) - st.x) * st.y * g0.y + b0.y);
                    o.y = pk_bf16((bf_lo(w.y) - st.x) * st.y * g0.z + b0.z, (bf_hi(w.y) - st.x) * st.y * g0.w + b0.w);
                    o.z = pk_bf16((bf_lo(w.z) - st.x) * st.y * g1.x + b1.x, (bf_hi(w.z) - st.x) * st.y * g1.y + b1.y);
                    o.w = pk_bf16((bf_lo(w.w) - st.x) * st.y * g1.z + b1.z, (bf_hi(w.w) - st.x) * st.y * g1.w + b1.w);
                    *(LAS v4u*)(img + off_b(j, ch)) = o; }
            }
            __syncthreads();
            f32x4 acc[8];
#pragma unroll
            for (int ct = 0; ct < 8; ++ct) acc[ct] = (f32x4){0.f, 0.f, 0.f, 0.f};
#pragma unroll
            for (int ks = 0; ks < 4; ++ks) {
                const bf16x8 wf = *(const GAS bf16x8*)(F.Wsp + ((size_t)(g * 128 + 16 * F.wave + fr)) * 128 + 32 * ks + 8 * fq);
#pragma unroll
                for (int ct = 0; ct < 8; ++ct) {
                    const s16x4 t0 = lds_tr(img + tr_read_addr_16(F.lane, ct, ks, 0)), t1 = lds_tr(img + tr_read_addr_16(F.lane, ct, ks, 1));
                    const bf16x8 vf = {t0[0], t0[1], t0[2], t0[3], t1[0], t1[1], t1[2], t1[3]};
                    acc[ct] = __builtin_amdgcn_mfma_f32_16x16x32_bf16(vf, wf, acc[ct], 0, 0, 0);
                }
            }
            const int i = 16 * F.wave + fr;
            const float bias = F.b_sp[g * 128 + i];
            GAS v2u* up = (GAS v2u*)(F.B1 + (T0 + i) * D + g * 128 + 4 * fq);
#pragma unroll
            for (int ct = 0; ct < 8; ++ct) { const v2u uu = up[4 * ct];
                v2u o; o.x = pk_bf16(bf_lo(uu.x) * (acc[ct][0] + bias), bf_hi(uu.x) * (acc[ct][1] + bias)); o.y = pk_bf16(bf_lo(uu.y) * (acc[ct][2] + bias), bf_hi(uu.y) * (acc[ct][3] + bias));
                up[4 * ct] = o; }
        }
        __syncthreads();
    }
    for (int it = F.gw; it < (M / 64) * 2; it += F.NGW) {
        const int t0 = (it >> 1) * 64, col = (it & 1) * 512 + F.lane * 8;
        float w0[8], w1[8], w2[8], p1[8], p2[8];
#pragma unroll
        for (int e = 0; e < 8; ++e) { w0[e] = F.conv_w[col + e]; w1[e] = F.conv_w[D + col + e]; w2[e] = F.conv_w[2 * D + col + e]; p1[e] = 0.f; p2[e] = 0.f; }
        if ((t0 & (SEQ - 1)) != 0) {
            const v4u c1 = *(const GAS v4u*)(F.B4 + (size_t)(t0 - 1) * D + col), z1 = *(const GAS v4u*)(F.B5 + (size_t)(t0 - 1) * D + col);
            const v4u c2 = *(const GAS v4u*)(F.B4 + (size_t)(t0 - 2) * D + col), z2 = *(const GAS v4u*)(F.B5 + (size_t)(t0 - 2) * D + col);
            p1[0] = bf_lo(c1.x) * bf_lo(z1.x); p1[1] = bf_hi(c1.x) * bf_hi(z1.x); p1[2] = bf_lo(c1.y) * bf_lo(z1.y); p1[3] = bf_hi(c1.y) * bf_hi(z1.y);
            p1[4] = bf_lo(c1.z) * bf_lo(z1.z); p1[5] = bf_hi(c1.z) * bf_hi(z1.z); p1[6] = bf_lo(c1.w) * bf_lo(z1.w); p1[7] = bf_hi(c1.w) * bf_hi(z1.w);
            p2[0] = bf_lo(c2.x) * bf_lo(z2.x); p2[1] = bf_hi(c2.x) * bf_hi(z2.x); p2[2] = bf_lo(c2.y) * bf_lo(z2.y); p2[3] = bf_hi(c2.y) * bf_hi(z2.y);
            p2[4] = bf_lo(c2.z) * bf_lo(z2.z); p2[5] = bf_hi(c2.z) * bf_hi(z2.z); p2[6] = bf_lo(c2.w) * bf_lo(z2.w); p2[7] = bf_hi(c2.w) * bf_hi(z2.w);
        }
#pragma unroll 4
        for (int t = t0; t < t0 + 64; ++t) {
            const size_t o = (size_t)t * D + col;
            const v4u gb = *(const GAS v4u*)(F.B3 + o), gc = *(const GAS v4u*)(F.B4 + o), zz = *(const GAS v4u*)(F.B5 + o);
            float p[8], gbv[8], y[8];
            p[0] = bf_lo(gc.x) * bf_lo(zz.x); p[1] = bf_hi(gc.x) * bf_hi(zz.x); p[2] = bf_lo(gc.y) * bf_lo(zz.y); p[3] = bf_hi(gc.y) * bf_hi(zz.y);
            p[4] = bf_lo(gc.z) * bf_lo(zz.z); p[5] = bf_hi(gc.z) * bf_hi(zz.z); p[6] = bf_lo(gc.w) * bf_lo(zz.w); p[7] = bf_hi(gc.w) * bf_hi(zz.w);
            gbv[0] = bf_lo(gb.x); gbv[1] = bf_hi(gb.x); gbv[2] = bf_lo(gb.y); gbv[3] = bf_hi(gb.y); gbv[4] = bf_lo(gb.z); gbv[5] = bf_hi(gb.z); gbv[6] = bf_lo(gb.w); gbv[7] = bf_hi(gb.w);
#pragma unroll
            for (int e = 0; e < 8; ++e) { y[e] = gbv[e] * (w0[e] * p2[e] + w1[e] * p1[e] + w2[e] * p[e]); p2[e] = p1[e]; p1[e] = p[e]; }
            v4u ov; ov.x = pk_bf16(y[0], y[1]); ov.y = pk_bf16(y[2], y[3]); ov.z = pk_bf16(y[4], y[5]); ov.w = pk_bf16(y[6], y[7]);
            *(GAS v4u*)(F.B3 + o) = ov;
        }
    }
}

__device__ __forceinline__ void unpack16(const v4u a, const v4u b, float (&v)[16]) {
    v[0] = bf_lo(a.x); v[1] = bf_hi(a.x); v[2] = bf_lo(a.y); v[3] = bf_hi(a.y); v[4] = bf_lo(a.z); v[5] = bf_hi(a.z); v[6] = bf_lo(a.w); v[7] = bf_hi(a.w);
    v[8] = bf_lo(b.x); v[9] = bf_hi(b.x); v[10] = bf_lo(b.y); v[11] = bf_hi(b.y); v[12] = bf_lo(b.z); v[13] = bf_hi(b.z); v[14] = bf_lo(b.w); v[15] = bf_hi(b.w);
}
__device__ __forceinline__ void load16f(const float* p, int lane, float (&v)[16]) {
    const f32x4 a = *(const GAS f32x4*)(p + 8 * lane), b = *(const GAS f32x4*)(p + 8 * lane + 4), c = *(const GAS f32x4*)(p + 512 + 8 * lane), d = *(const GAS f32x4*)(p + 512 + 8 * lane + 4);
    v[0] = a.x; v[1] = a.y; v[2] = a.z; v[3] = a.w; v[4] = b.x; v[5] = b.y; v[6] = b.z; v[7] = b.w; v[8] = c.x; v[9] = c.y; v[10] = c.z; v[11] = c.w; v[12] = d.x; v[13] = d.y; v[14] = d.z; v[15] = d.w;
}
__device__ __forceinline__ void ln16(float (&v)[16]) {
    float s = 0.f;
#pragma unroll
    for (int e = 0; e < 16; ++e) s += v[e];
    const float mean = wave_sum(s) * (1.f / D); float s2 = 0.f;
#pragma unroll
    for (int e = 0; e < 16; ++e) { v[e] -= mean; s2 += v[e] * v[e]; }
    const float rstd = 1.f / sqrtf(wave_sum(s2) * (1.f / D) + LN_EPS);
#pragma unroll
    for (int e = 0; e < 16; ++e) v[e] *= rstd;
}
__device__ __forceinline__ void store16bf(bf16* p, int lane, const float (&v)[16]) {
    v4u a, b; a.x = pk_bf16(v[0], v[1]); a.y = pk_bf16(v[2], v[3]); a.z = pk_bf16(v[4], v[5]); a.w = pk_bf16(v[6], v[7]);
    b.x = pk_bf16(v[8], v[9]); b.y = pk_bf16(v[10], v[11]); b.z = pk_bf16(v[12], v[13]); b.w = pk_bf16(v[14], v[15]);
    ((GAS v4u*)p)[lane] = a; ((GAS v4u*)p)[lane + 64] = b;
}
__device__ __forceinline__ void phase6(Frame& F) {
    float g1[16], b1[16];
    load16f(F.ln1_g, F.lane, g1); load16f(F.ln1_b, F.lane, b1);
    for (int blk = F.gw; blk < M / 32; blk += F.NGW) {
        const int r0 = blk * 32, b = r0 >> 11;
        float sh[16], sc[16];
        load16f(F.mod + (size_t)b * NMOD + 3072, F.lane, sh); load16f(F.mod + (size_t)b * NMOD + 4096, F.lane, sc);
#pragma unroll 2
        for (int r = 0; r < 32; ++r) {
            const GAS v4u* rr = (const GAS v4u*)(F.B4 + (size_t)(r0 + r) * D);
            float v[16]; unpack16(rr[F.lane], rr[F.lane + 64], v);
            ln16(v);
#pragma unroll
            for (int e = 0; e < 16; ++e) v[e] = v[e] * g1[e] + b1[e];
            store16bf(F.B5 + (size_t)(r0 + r) * D, F.lane, v);
            ln16(v);
#pragma unroll
            for (int e = 0; e < 16; ++e) v[e] = v[e] * (1.0f + sc[e]) + sh[e];
            store16bf(F.B1 + (size_t)(r0 + r) * D, F.lane, v);
        }
    }
}

#define TOP_INSERT(top, v) do { float _v = (v); _Pragma("unroll") for (int _i = 0; _i < 16; ++_i) { const float _hi = vmaxf(top[_i], _v); _v = vminf(top[_i], _v); top[_i] = _hi; } } while (0)
#define TOP_MERGE(top, mask) do { float _p[16]; _Pragma("unroll") for (int _i = 0; _i < 16; ++_i) _p[_i] = __shfl_xor(top[_i], mask); \
    _Pragma("unroll") for (int _i = 0; _i < 16; ++_i) top[_i] = vmaxf(top[_i], _p[15 - _i]); \
    _Pragma("unroll") for (int _d = 8; _d >= 1; _d >>= 1) { _Pragma("unroll") for (int _i = 0; _i < 16; ++_i) if ((_i & _d) == 0) { const float _a = top[_i], _b = top[_i + _d]; top[_i] = vmaxf(_a, _b); top[_i + _d] = vminf(_a, _b); } } } while (0)
constexpr int S_PITCH = 144, T_PITCH = 20;
__device__ __forceinline__ void phase8(Frame& F) {
    LAS float* S = (LAS float*)F.lds;
    LAS float* tops = (LAS float*)(F.lds + 73728);
    const int fr = F.lane & 15, fq = F.lane >> 4;
    const bf16* Q = F.B6;
    for (int it = blockIdx.x; it < M / 64; it += F.G) {
        const size_t T0 = (size_t)it * 64;
        for (int h = 0; h < 8; ++h) {
            {
                const int p = F.wave >> 2, tq = F.wave & 3;
                bf16x8 a[4];
#pragma unroll
                for (int ks = 0; ks < 4; ++ks) a[ks] = *(const GAS bf16x8*)(Q + (T0 + 16 * tq + fr) * NQ + h * 256 + p * 128 + 32 * ks + 8 * fq);
                const bf16* kb = F.Keys + ((size_t)(h * 2 + p) * 128 + fr) * 128 + 8 * fq;
#pragma unroll
                for (int nt = 0; nt < 8; ++nt) {
                    f32x4 acc = (f32x4){0.f, 0.f, 0.f, 0.f};
#pragma unroll
                    for (int ks = 0; ks < 4; ++ks) { const bf16x8 bfr = *(const GAS bf16x8*)(kb + (size_t)nt * 16 * 128 + 32 * ks); acc = __builtin_amdgcn_mfma_f32_16x16x32_bf16(a[ks], bfr, acc, 0, 0, 0); }
#pragma unroll
                    for (int e = 0; e < 4; ++e) S[(p * 64 + 16 * tq + 4 * fq + e) * S_PITCH + 16 * nt + fr] = acc[e];
                }
            }
            __syncthreads();
            {
                const int prob = F.tid >> 2, sub = F.tid & 3;
                float top[16];
#pragma unroll
                for (int i = 0; i < 16; ++i) top[i] = -__builtin_inff();
#pragma unroll
                for (int i = 0; i < 8; ++i) { const int c = 4 * i + sub; const f32x4 v = *(const LAS f32x4*)(S + prob * S_PITCH + 4 * c);
#pragma unroll
                    for (int e = 0; e < 4; ++e) { const unsigned bits = (__float_as_uint(v[e]) & ~0x7Fu) | (unsigned)(127 - (4 * c + e)); TOP_INSERT(top, __uint_as_float(bits)); } }
                TOP_MERGE(top, 1); TOP_MERGE(top, 2);
                if (sub == 0) { LAS f32x4* tp = (LAS f32x4*)(tops + ((size_t)(h * 128 + prob)) * T_PITCH);
#pragma unroll
                    for (int i = 0; i < 4; ++i) tp[i] = (f32x4){top[4 * i], top[4 * i + 1], top[4 * i + 2], top[4 * i + 3]}; }
            }
            __syncthreads();
        }
        {
            const int h = F.wave, tok = F.lane;
            const LAS float* t1 = tops + ((size_t)(h * 128 + tok)) * T_PITCH; const LAS float* t2 = tops + ((size_t)(h * 128 + 64 + tok)) * T_PITCH;
            float L1[16], L2[16];
#pragma unroll
            for (int i = 0; i < 4; ++i) { const f32x4 x = ((const LAS f32x4*)t1)[i], y = ((const LAS f32x4*)t2)[i];
                L1[4 * i] = x.x; L1[4 * i + 1] = x.y; L1[4 * i + 2] = x.z; L1[4 * i + 3] = x.w; L2[4 * i] = y.x; L2[4 * i + 1] = y.y; L2[4 * i + 2] = y.z; L2[4 * i + 3] = y.w; }
            float top[16];
#pragma unroll
            for (int i = 0; i < 16; ++i) top[i] = -__builtin_inff();
#pragma unroll
            for (int a = 0; a < 16; ++a)
#pragma unroll
                for (int b = 0; b < 16; ++b) if ((a + 1) * (b + 1) <= 16) {
                    const unsigned bits = (__float_as_uint(L1[a] + L2[b]) & ~0xFFu) | (unsigned)(255 - (a * 16 + b)); TOP_INSERT(top, __uint_as_float(bits)); }
            float sv[16]; unsigned ex[16]; float mx = -__builtin_inff();
#pragma unroll
            for (int k = 0; k < 16; ++k) { const unsigned code = 255u - (__float_as_uint(top[k]) & 0xFFu); const float f1 = t1[code >> 4], f2 = t2[code & 15];
                const unsigned i1 = 127u - (__float_as_uint(f1) & 0x7Fu), i2 = 127u - (__float_as_uint(f2) & 0x7Fu);
                sv[k] = f1 + f2; ex[k] = i1 * 128u + i2; mx = fmaxf(mx, sv[k]); }
            float den = 0.f;
#pragma unroll
            for (int k = 0; k < 16; ++k) { sv[k] = __builtin_amdgcn_exp2f((sv[k] - mx) * 1.4426950408889634f); den += sv[k]; }
            const float inv = 1.0f / den;
            GAS v4u* sp = (GAS v4u*)(F.sel + (T0 + tok) * 128 + h * 16);
#pragma unroll
            for (int i = 0; i < 4; ++i) { v4u o;
                o.x = (ex[4 * i + 0] << 18) | (__float_as_uint(sv[4 * i + 0] * inv) >> 13); o.y = (ex[4 * i + 1] << 18) | (__float_as_uint(sv[4 * i + 1] * inv) >> 13);
                o.z = (ex[4 * i + 2] << 18) | (__float_as_uint(sv[4 * i + 2] * inv) >> 13); o.w = (ex[4 * i + 3] << 18) | (__float_as_uint(sv[4 * i + 3] * inv) >> 13);
                sp[i] = o; }
        }
        __syncthreads();
    }
}

__device__ __forceinline__ void phase9(Frame& F) {
    float l2g[16], l2b[16];
    load16f(F.ln2_g, F.lane, l2g); load16f(F.ln2_b, F.lane, l2b);
    for (int blk = F.gw; blk < M / 32; blk += F.NGW) {
        const int r0 = blk * 32, b = r0 >> 11;
        float g2[16]; load16f(F.mod + (size_t)b * NMOD + 5120, F.lane, g2);
        for (int r = 0; r < 32; ++r) {
            const size_t tok = (size_t)(r0 + r);
            const GAS v4u* hr = (const GAS v4u*)(F.B1 + tok * D);
            const v4u xa = hr[F.lane], xb = hr[F.lane + 64];
            float acc[16];
#pragma unroll
            for (int e = 0; e < 16; ++e) acc[e] = 0.f;
#pragma unroll
            for (int jj = 0; jj < 2; ++jj) {
                const unsigned selw = F.sel[tok * 128 + 64 * jj + F.lane];
#pragma unroll 4
                for (int e = 0; e < 64; ++e) {
                    const unsigned w = (unsigned)__builtin_amdgcn_readlane((int)selw, e);
                    const unsigned idx = w >> 18; const float gate = __uint_as_float((w & 0x3FFFFu) << 13);
                    const GAS v4u* ur = (const GAS v4u*)(F.EU + (size_t)idx * D); const GAS v4u* vr = (const GAS v4u*)(F.EV + (size_t)idx * D);
                    const v4u ua = ur[F.lane], ub = ur[F.lane + 64];
                    const v4u va = vr[F.lane], vb = vr[F.lane + 64];
                    float d0 = dot2_bf16(ua.x, xa.x, 0.f), d1 = dot2_bf16(ua.y, xa.y, 0.f);
                    d0 = dot2_bf16(ua.z, xa.z, d0); d1 = dot2_bf16(ua.w, xa.w, d1);
                    d0 = dot2_bf16(ub.x, xb.x, d0); d1 = dot2_bf16(ub.y, xb.y, d1);
                    d0 = dot2_bf16(ub.z, xb.z, d0); d1 = dot2_bf16(ub.w, xb.w, d1);
                    const float tot = wave_sum(d0 + d1);
                    const float coef = gate * gelu_tanh(tot);
                    float vv[16]; unpack16(va, vb, vv);
#pragma unroll
                    for (int q = 0; q < 16; ++q) acc[q] += coef * vv[q];
                }
            }
            const GAS v4u* xr = (const GAS v4u*)(F.B5 + tok * D);
            float y[16]; unpack16(xr[F.lane], xr[F.lane + 64], y);
#pragma unroll
            for (int e = 0; e < 16; ++e) y[e] = ALPHA * y[e] + g2[e] * acc[e];
            ln16(y);
#pragma unroll
            for (int e = 0; e < 16; ++e) y[e] = y[e] * l2g[e] + l2b[e];
            float* op = F.out + tok * D;
            *(GAS f32x4*)(op + 8 * F.lane) = (f32x4){y[0], y[1], y[2], y[3]}; *(GAS f32x4*)(op + 8 * F.lane + 4) = (f32x4){y[4], y[5], y[6], y[7]};
            *(GAS f32x4*)(op + 512 + 8 * F.lane) = (f32x4){y[8], y[9], y[10], y[11]}; *(GAS f32x4*)(op + 512 + 8 * F.lane + 4) = (f32x4){y[12], y[13], y[14], y[15]};
        }
    }
}

struct Args { const float* in[21]; float* out; unsigned char* ws; int ph_lo, ph_hi, li, pad; };
__global__ void __launch_bounds__(512, 2) fwd(Args args) {
    extern __shared__ __attribute__((aligned(16))) unsigned char lds[];
    Frame F;
    F.lds = (LAS unsigned char*)lds;
    volatile LAS unsigned* MISC = (volatile LAS unsigned*)(F.lds + MISC_OFF);
    F.tid = threadIdx.x; F.lane = F.tid & 63; F.wave = __builtin_amdgcn_readfirstlane(F.tid >> 6);
    F.G = gridDim.x; F.gw = blockIdx.x * 8 + F.wave; F.NGW = F.G * 8;
    unsigned char* ws = args.ws;
    gu32* ctl = (gu32*)(ws + WS_CTL);
    F.x = args.in[0]; F.c = args.in[1]; F.w_cond = args.in[2]; F.b_cond = args.in[3]; F.w_in = args.in[4]; F.gln_g = args.in[5]; F.gln_b = args.in[6];
    F.w_sp = args.in[7]; F.b_sp = args.in[8]; F.conv_w = args.in[9]; F.p_a = args.in[10]; F.p_b = args.in[11]; F.w_o = args.in[12]; F.ln1_g = args.in[13]; F.ln1_b = args.in[14];
    F.w_q = args.in[15]; F.keys = args.in[16]; F.eu = args.in[17]; F.ev = args.in[18]; F.ln2_g = args.in[19]; F.ln2_b = args.in[20];
    F.out = args.out; F.mod = (float*)(ws + WS_MOD);
    F.Win_t = (bf16*)(ws + WS_WIN); F.Pa_t = (bf16*)(ws + WS_PA); F.Pb_t = (bf16*)(ws + WS_PB); F.Wo_t = (bf16*)(ws + WS_WO); F.Wq_t = (bf16*)(ws + WS_WQ);
    F.Keys = (bf16*)(ws + WS_KEYS); F.Wsp = (bf16*)(ws + WS_WSP); F.EU = (bf16*)(ws + WS_EU); F.EV = (bf16*)(ws + WS_EV); F.sel = (unsigned*)(ws + WS_SEL);
    F.H = (bf16*)args.out;
    F.B1 = (bf16*)(ws + 1 * WS_U); F.B2 = (bf16*)(ws + 2 * WS_U); F.B3 = (bf16*)(ws + 3 * WS_U); F.B4 = (bf16*)(ws + 4 * WS_U); F.B5 = (bf16*)(ws + 5 * WS_U); F.B6 = (bf16*)(ws + 6 * WS_U);
    for (int u = F.tid; u < (LDS_BYTES - LDSCTL_OFF) / 4; u += 512) ((LAS unsigned*)(F.lds + LDSCTL_OFF))[u] = 0u;
    __syncthreads();
    XcdBarrier bar; bar.bar = (unsigned*)(ctl + CW_BAR); bar.x = 0; bar.st = nullptr;
    if (MK_N_LAUNCHES == 1) bar = xcd_barrier_post((unsigned*)(ctl + CW_BAR), MISC + 8);
    const int lo = args.ph_lo, hi = args.ph_hi;
#define IN(k) (lo <= (k) && (k) < hi)
#define SEAM(k) do { if (IN(k) && IN((k) + 1)) xcd_barrier(bar); } while (0)

    if (IN(0)) { phase0(F); SEAM(0); }
    if (IN(1)) { phase1(F); SEAM(1); }
    if (IN(2)) {
        pg8::Gemm g{F.H, F.Win_t, nullptr, nullptr, M, NIN, D}; pg8::StaticOrder S; S.init(M, NIN, F.G, (int)blockIdx.x);
        pg8::EpiProj E{F.B1};
        pg8::gemm_phase<pg8::EpiProj, pg8::StaticOrder, true, true>(F.lds, g, S, E);
        SEAM(2);
    }
    if (IN(3)) { phase3(F); SEAM(3); }
    if (IN(4)) {
        pg8::Gemm g{F.B1, F.Pa_t, F.B3, F.Pb_t, M, D, D}; pg8::DualOrder S; S.init(M, D, F.G, (int)blockIdx.x);
        pg8::EpiDual E{F.B2, F.B6, F.B6 + SEG};
        pg8::gemm_phase<pg8::EpiDual, pg8::DualOrder, true, true>(F.lds, g, S, E);
        SEAM(4);
    }
    if (IN(5)) {
        pg8::Gemm g{F.B2, F.Wo_t, nullptr, nullptr, M, D, D}; pg8::StaticOrder S; S.init(M, D, F.G, (int)blockIdx.x);
        pg8::EpiRes E{F.B4, F.x, F.mod};
        pg8::gemm_phase<pg8::EpiRes, pg8::StaticOrder, true, true>(F.lds, g, S, E);
        SEAM(5);
    }
    if (IN(6)) { phase6(F); SEAM(6); }
    if (IN(7)) {
        pg8::Gemm g{F.B1, F.Wq_t, nullptr, nullptr, M, NQ, D}; pg8::StaticOrder S; S.init(M, NQ, F.G, (int)blockIdx.x);
        pg8::EpiPlain E{F.B6, NQ};
        pg8::gemm_phase<pg8::EpiPlain, pg8::StaticOrder, true, true>(F.lds, g, S, E);
        SEAM(7);
    }
    if (IN(8)) { phase8(F); SEAM(8); }
    if (IN(9)) { phase9(F); }
#undef IN
#undef SEAM
}

extern "C" void kernel_launch(void* const* d_in, const int* in_sizes, int n_in, void* d_out, int out_size, void* d_ws, size_t ws_size, hipStream_t stream) {
    static int grid = 0;
    if (grid == 0) {
        if (n_in != 21 || in_sizes[0] != M * D || out_size != M * D || ws_size < WS_END) { fprintf(stderr, "kernel_launch: unexpected shapes (n_in %d, in0 %d, out %d, ws %zu); nothing launched\n", n_in, n_in > 0 ? in_sizes[0] : -1, out_size, ws_size); grid = -1; return; }
        int dev = 0, cus = 0, per_cu = 0;
        if (hipGetDevice(&dev) != hipSuccess || hipDeviceGetAttribute(&cus, hipDeviceAttributeMultiprocessorCount, dev) != hipSuccess) { grid = -1; return; }
        if (hipFuncSetAttribute((const void*)fwd, hipFuncAttributeMaxDynamicSharedMemorySize, LDS_BYTES) != hipSuccess) { fprintf(stderr, "kernel_launch: hipFuncSetAttribute failed\n"); grid = -1; return; }
        if (hipOccupancyMaxActiveBlocksPerMultiprocessor(&per_cu, (const void*)fwd, 512, LDS_BYTES) != hipSuccess || per_cu < 1) { fprintf(stderr, "kernel_launch: occupancy query reports %d workgroups per CU\n", per_cu); }
        (void)hipGetLastError();
        grid = cus;
    }
    if (grid < 0) return;
    if (hipMemsetAsync((char*)d_ws + WS_CTL, 0, CTL_ZERO_BYTES, stream) != hipSuccess) return;
    Args a{};
    for (int i = 0; i < 21; ++i) a.in[i] = (const float*)d_in[i];
    a.out = (float*)d_out; a.ws = (unsigned char*)d_ws;
    for (int li = 0; li < MK_N_LAUNCHES; ++li) {
        a.ph_lo = (MK_N_LAUNCHES == 1) ? 0 : li; a.ph_hi = (MK_N_LAUNCHES == 1) ? NPHASE : li + 1; a.li = li;
        hipLaunchKernelGGL(fwd, dim3(grid), dim3(512), LDS_BYTES, stream, a);
    }
}
```

```cpp
#include <hip/hip_runtime.h>
#include <cstdio>
#include <cstdint>

#define P9_ROUND_BARRIER 1
#ifndef MK_N_LAUNCHES
#define MK_N_LAUNCHES 1
#endif

#define GAS __attribute__((address_space(1)))
#define LAS __attribute__((address_space(3)))
#define PG8_LAS __attribute__((address_space(3)))
typedef unsigned short bf16;
typedef unsigned v4u __attribute__((ext_vector_type(4)));
typedef unsigned v2u __attribute__((ext_vector_type(2)));
typedef float f32x4 __attribute__((ext_vector_type(4)));
typedef float f32x2 __attribute__((ext_vector_type(2)));
typedef short bf16x8 __attribute__((ext_vector_type(8)));
typedef short s16x4 __attribute__((ext_vector_type(4)));
typedef __bf16 bf16x2 __attribute__((ext_vector_type(2)));
typedef GAS unsigned gu32;

constexpr int D = 1024, BATCH = 32, SEQ = 2048, M = BATCH * SEQ;
constexpr int NIN = 7168, NQ = 2048, NE = 16384, NMOD = 6144;
constexpr float LN_EPS = 1e-5f, ALPHA = 1.189207115002721f;
constexpr int NPHASE = 10;

constexpr size_t MiB = 1u << 20;
constexpr size_t WS_CTL = 0, CTL_ZERO_BYTES = 1 * MiB;
constexpr size_t WS_MOD = 1 * MiB;
constexpr size_t WS_WIN = 2 * MiB, WS_PA = 16 * MiB, WS_PB = 18 * MiB, WS_WO = 20 * MiB, WS_WQ = 22 * MiB, WS_KEYS = 26 * MiB, WS_WSP = 26 * MiB + 512 * 1024;
constexpr size_t WS_CM = WS_CTL + 768 * 1024;
constexpr size_t WS_SW = 29 * MiB, WS_SH = 30 * MiB;
constexpr size_t WS_EU = 32 * MiB, WS_EV = 64 * MiB, WS_SEL = 96 * MiB;
constexpr size_t WS_U = 128 * MiB;
constexpr size_t WS_END = 1024 * MiB;
constexpr size_t SEG = (size_t)M * D;
constexpr int CW_TMO = 0, CW_BAR = 4096;

constexpr int RING_BYTES = 131072;
constexpr int LDSCTL_OFF = 155648, MISC_OFF = LDSCTL_OFF + 320;
constexpr int LDS_BYTES = 156672;

__device__ __forceinline__ int lane_now() { int l; asm volatile("v_mbcnt_lo_u32_b32 %0, -1, 0\n\tv_mbcnt_hi_u32_b32 %0, -1, %0" : "=v"(l)); return l; }
__device__ __forceinline__ float bf_lo(unsigned w) { return __uint_as_float(w << 16); }
__device__ __forceinline__ float bf_hi(unsigned w) { return __uint_as_float(w & 0xffff0000u); }
__device__ __forceinline__ unsigned pk_bf16(float lo, float hi) { unsigned r; asm("v_cvt_pk_bf16_f32 %0, %1, %2" : "=v"(r) : "v"(lo), "v"(hi)); return r; }
__device__ __forceinline__ float vmaxf(float a, float b) { float r; asm("v_max_f32 %0, %1, %2" : "=v"(r) : "v"(a), "v"(b)); return r; }
__device__ __forceinline__ float vminf(float a, float b) { float r; asm("v_min_f32 %0, %1, %2" : "=v"(r) : "v"(a), "v"(b)); return r; }
__device__ __forceinline__ float gelu_tanh(float x) {
    const float u = x * (1.5957691216057308f + 0.07135481627260025f * x * x);
    return x * __builtin_amdgcn_rcpf(1.0f + __builtin_amdgcn_exp2f(-1.4426950408889634f * u));
}
__device__ __forceinline__ float sigmoidf_(float x) { return __builtin_amdgcn_rcpf(1.0f + __builtin_amdgcn_exp2f(-1.4426950408889634f * x)); }
__device__ __forceinline__ float shx(float v, int m) { const int l = lane_now(); return __builtin_bit_cast(float, __builtin_amdgcn_ds_bpermute((l ^ m) << 2, __builtin_bit_cast(int, v))); }
__device__ __forceinline__ float shx(float v, int m, int l) { return __builtin_bit_cast(float, __builtin_amdgcn_ds_bpermute((l ^ m) << 2, __builtin_bit_cast(int, v))); }
__device__ __forceinline__ int shx(int v, int m, int l) { return __builtin_amdgcn_ds_bpermute((l ^ m) << 2, v); }
#define WS_DPP(v, ctrl) __builtin_bit_cast(float, __builtin_amdgcn_update_dpp(0, __builtin_bit_cast(int, v), ctrl, 0xF, 0xF, false))
__device__ __forceinline__ float wave_sum(float v) {
    v += WS_DPP(v, 0xB1); v += WS_DPP(v, 0x4E); v += WS_DPP(v, 0x141); v += WS_DPP(v, 0x140);
    const int b = __builtin_bit_cast(int, v);
    const float r0 = __builtin_bit_cast(float, __builtin_amdgcn_readlane(b, 0)), r1 = __builtin_bit_cast(float, __builtin_amdgcn_readlane(b, 16));
    const float r2 = __builtin_bit_cast(float, __builtin_amdgcn_readlane(b, 32)), r3 = __builtin_bit_cast(float, __builtin_amdgcn_readlane(b, 48));
    return (r0 + r1) + (r2 + r3);
}
__device__ __forceinline__ float wave_max(float v) {
    v = fmaxf(v, WS_DPP(v, 0xB1)); v = fmaxf(v, WS_DPP(v, 0x4E)); v = fmaxf(v, WS_DPP(v, 0x141)); v = fmaxf(v, WS_DPP(v, 0x140));
    const int b = __builtin_bit_cast(int, v);
    const float r0 = __builtin_bit_cast(float, __builtin_amdgcn_readlane(b, 0)), r1 = __builtin_bit_cast(float, __builtin_amdgcn_readlane(b, 16));
    const float r2 = __builtin_bit_cast(float, __builtin_amdgcn_readlane(b, 32)), r3 = __builtin_bit_cast(float, __builtin_amdgcn_readlane(b, 48));
    return fmaxf(fmaxf(r0, r1), fmaxf(r2, r3));
}
__device__ __forceinline__ unsigned pk4_i8(float a, float b, float c, float d) {
    const unsigned q0 = (unsigned)__float2int_rn(a) & 0xFFu, q1 = (unsigned)__float2int_rn(b) & 0xFFu, q2 = (unsigned)__float2int_rn(c) & 0xFFu, q3 = (unsigned)__float2int_rn(d);
    return q0 | (q1 << 8) | (q2 << 16) | (q3 << 24);
}
__device__ __forceinline__ float dot2_bf16(unsigned w, unsigned x, float acc) { return __builtin_amdgcn_fdot2_f32_bf16(__builtin_bit_cast(bf16x2, w), __builtin_bit_cast(bf16x2, x), acc, false); }
#define LDS_WAIT() asm volatile("s_waitcnt lgkmcnt(0)" ::: "memory")

namespace pg8 {
typedef unsigned short bf16_t;
typedef unsigned u32x4 __attribute__((ext_vector_type(4)));
constexpr int BM = 256, BK = 64, HALF = 128, HTB = HALF * BK * 2, STAGE_BYTES = 8 * HTB, NXCD = 8, WGM = 8;
__host__ __device__ __forceinline__ int lds_byte(int r, int c) { const int st = (r >> 4) * 2 + (c >> 5), rr = r & 15, cc = c & 31, ob = rr * 64 + cc * 2; return st * 1024 + (ob ^ (((ob >> 9) & 1) << 5)); }
__host__ __device__ __forceinline__ void stage_rc(int b, int& R, int& C) { const int st = b / 1024, sb = b % 1024, swz = sb ^ (((sb >> 9) & 1) << 5); R = (st >> 1) * 16 + swz / 64; C = (st & 1) * 32 + (swz % 64) / 2; }
__host__ __device__ __forceinline__ int perm32(int rho) { const int n = rho >> 4, i = rho & 15; return 8 * (i >> 2) + 4 * n + (i & 3); }

struct Unit { int pm, pn, z; };
struct Gemm { const bf16_t* A; const bf16_t* Bt; const bf16_t* A2; const bf16_t* Bt2; int M, N, K; };

__host__ __device__ __forceinline__ void tile_of(int wgid, int nwg, int nM, int nN, Unit& u) {
    { const int q = nwg / NXCD, r = nwg % NXCD, xcd = wgid % NXCD, off = wgid / NXCD; wgid = (xcd < r ? xcd * (q + 1) : r * (q + 1) + (xcd - r) * q) + off; }
    const int nig = WGM * nN, gid = wgid / nig, fm = gid * WGM, gsz = (nM - fm) < WGM ? (nM - fm) : WGM;
    u.pm = fm + ((wgid % nig) % gsz); u.pn = (wgid % nig) / gsz;
}
struct StaticOrder {
    int nM, nN, nwg, G, c;
    __host__ __device__ void init(int M_, int N_, int G_, int c_) { nM = M_ / BM; nN = N_ / BM; nwg = nM * nN; G = G_; c = c_; }
    __host__ __device__ bool next(int i, Unit& u) const {
        const long L = (long)i * G + c; if (L >= nwg) return false;
        tile_of((int)L, nwg, nM, nN, u); u.z = 0; return true;
    }
    __device__ __forceinline__ void a_ready(const Unit&) const {}
    __device__ __forceinline__ void done(const Unit&) const {}
};
struct RowOrder {
    int nM, nN, G, c;
    __host__ __device__ void init(int M_, int N_, int G_, int c_) { nM = M_ / BM; nN = N_ / BM; G = G_; c = c_; }
    __host__ __device__ bool next(int i, Unit& u) const { const int pm = c + G * (i / nN); if (pm >= nM) return false; u.pm = pm; u.pn = i % nN; u.z = 0; return true; }
    __device__ __forceinline__ void a_ready(const Unit&) const {}
    __device__ __forceinline__ void done(const Unit&) const {}
};
struct DualOrder {
    int nM, nN, nwg, G, c;
    __host__ __device__ void init(int M_, int N_, int G_, int c_) { nM = M_ / BM; nN = N_ / BM; nwg = nM * nN; G = G_; c = c_; }
    __host__ __device__ bool next(int i, Unit& u) const {
        const long L = (long)(i >> 1) * G + c; if (L >= nwg) return false;
        tile_of((int)L, nwg, nM, nN, u); u.z = i & 1; return true;
    }
    __device__ __forceinline__ void a_ready(const Unit&) const {}
    __device__ __forceinline__ void done(const Unit&) const {}
};

typedef int v8i_t __attribute__((ext_vector_type(8)));
typedef int v4i_t __attribute__((ext_vector_type(4)));
__device__ __forceinline__ v8i_t cat8(bf16x8 a, bf16x8 b) { return __builtin_shufflevector(__builtin_bit_cast(v4i_t, a), __builtin_bit_cast(v4i_t, b), 0, 1, 2, 3, 4, 5, 6, 7); }
struct PanelDual {
    int pm;
    __host__ __device__ bool next(int i, Unit& u) const { if (i >= 8) return false; u.pm = pm; u.pn = i >> 1; u.z = i & 1; return true; }
    __device__ __forceinline__ void a_ready(const Unit&) const {}
    __device__ __forceinline__ void done(const Unit&) const {}
};
struct PanelOrder {
    int pm, nN;
    __host__ __device__ bool next(int i, Unit& u) const { if (i >= nN) return false; u.pm = pm; u.pn = i; u.z = 0; return true; }
    __device__ __forceinline__ void a_ready(const Unit&) const {}
    __device__ __forceinline__ void done(const Unit&) const {}
};
template <class Epi, class Sched, bool ALIGN_EPI = false, bool SP2 = false, int MODE = 0>
__device__ __forceinline__ void gemm_phase(PG8_LAS unsigned char* lds, const Gemm g, const Sched& S, const Epi& E, const int wid) {
    const int lane = lane_now(), tid = wid * 64 + lane, wr = wid >> 2, wc = wid & 3, fr = lane & 15, fq = lane >> 4;
    constexpr bool FP8 = (MODE == 1); constexpr int ES = MODE ? 1 : 2;
    const int K = g.K, nt = K * ES / (BK * 2);
    unsigned voffA[2], voffB[2];
#pragma unroll
    for (int i = 0; i < 2; ++i) { int R, C; stage_rc(tid * 16 + i * 8192, R, C); const int Rb = Epi::PERM ? ((R & ~31) + perm32(R & 31)) : R;
        voffA[i] = (unsigned)(R * K * ES + C * 2); voffB[i] = (unsigned)(Rb * K * ES + C * 2); }
    const size_t kstep = (size_t)(BK * 2);
    const size_t hstep = (size_t)HALF * K * ES;
    const size_t tstep = 2 * hstep;
    const unsigned ldsw = (unsigned)wid * 1024u;
    const int aoff = lds_byte(wr * 64 + fr, fq * 8), boff = lds_byte(wc * 32 + fr, fq * 8);
#define PG8_SA(b, h) (((b) * 2 + (h)) * HTB)
#define PG8_SB(b, h) ((4 + (b) * 2 + (h)) * HTB)
#define PG8_STAGE(bufoff, gbase, voff) do { _Pragma("unroll") for (int _i = 0; _i < 2; ++_i) { unsigned _v = (voff)[_i]; asm volatile("" : "+v"(_v));   \
        __builtin_amdgcn_global_load_lds((const unsigned*)((const char*)(gbase) + _v), (PG8_LAS unsigned*)(lds + (bufoff) + ldsw + _i * 8192), 16, 0, 0); } } while (0)
#define PG8_LDA(dst, b, h) do { _Pragma("unroll") for (int m = 0; m < 4; ++m) _Pragma("unroll") for (int k = 0; k < 2; ++k) dst[m][k] = *(const PG8_LAS bf16x8*)(lds + PG8_SA(b, h) + aoff + m * 2048 + k * 1024); } while (0)
#define PG8_LDB(dst, b, h) do { _Pragma("unroll") for (int n = 0; n < 2; ++n) _Pragma("unroll") for (int k = 0; k < 2; ++k) dst[n][k] = *(const PG8_LAS bf16x8*)(lds + PG8_SB(b, h) + boff + n * 2048 + k * 1024); } while (0)
#define PG8_MMA(ai, bj, At, Bt) do { __builtin_amdgcn_s_setprio(1); \
        if constexpr (FP8) { _Pragma("unroll") for (int m = 0; m < 4; ++m) _Pragma("unroll") for (int n = 0; n < 2; ++n) \
            asm volatile("v_mfma_f32_16x16x128_f8f6f4 %0, %1, %2, %0" : "+v"(acc[ai][bj][m][n]) : "v"(cat8(Bt[n][0], Bt[n][1])), "v"(cat8(At[m][0], At[m][1]))); } \
        else if constexpr (MODE == 2) { _Pragma("unroll") for (int m = 0; m < 4; ++m) _Pragma("unroll") for (int n = 0; n < 2; ++n) _Pragma("unroll") for (int k = 0; k < 2; ++k) \
            acc[ai][bj][m][n] = __builtin_bit_cast(f32x4, __builtin_amdgcn_mfma_i32_16x16x64_i8(__builtin_bit_cast(v4i_t, Bt[n][k]), __builtin_bit_cast(v4i_t, At[m][k]), __builtin_bit_cast(v4i_t, acc[ai][bj][m][n]), 0, 0, 0)); } \
        else { _Pragma("unroll") for (int m = 0; m < 4; ++m) _Pragma("unroll") for (int n = 0; n < 2; ++n) _Pragma("unroll") for (int k = 0; k < 2; ++k) \
            acc[ai][bj][m][n] = __builtin_amdgcn_mfma_f32_16x16x32_bf16(Bt[n][k], At[m][k], acc[ai][bj][m][n], 0, 0, 0); } \
        __builtin_amdgcn_s_setprio(0); } while (0)
#define PG8_WAIT_V(n) asm volatile("s_waitcnt vmcnt(" #n ")" ::: "memory")
#define PG8_WAIT_L(n) asm volatile("s_waitcnt lgkmcnt(" #n ")" ::: "memory")
#define PG8_BAR __builtin_amdgcn_s_barrier()
#define PG8_SCHED __builtin_amdgcn_sched_barrier(0)
#define PG8_ABASE(u) ((const char*)((u).z ? g.A2 : g.A) + (size_t)(u).pm * tstep)
#define PG8_BBASE(u) ((const char*)((u).z ? g.Bt2 : g.Bt) + (size_t)(u).pn * tstep)
    Unit cur, nxt; int ui = 0;
    if (!S.next(0, cur)) return;
    f32x4 acc[2][2][4][2];
#pragma unroll
    for (int a = 0; a < 2; ++a)
#pragma unroll
        for (int b = 0; b < 2; ++b)
#pragma unroll
            for (int m = 0; m < 4; ++m)
#pragma unroll
                for (int n = 0; n < 2; ++n) acc[a][b][m][n] = (f32x4){0.f, 0.f, 0.f, 0.f};
    bf16x8 At[4][2], B0[2][2], B1[2][2];
    const char* cA = PG8_ABASE(cur); const char* cB = PG8_BBASE(cur);
    S.a_ready(cur);
    if constexpr (SP2) {
        PG8_STAGE(PG8_SB(0, 0), cB, voffB); PG8_STAGE(PG8_SB(0, 1), cB + hstep, voffB); PG8_STAGE(PG8_SA(0, 0), cA, voffA); PG8_STAGE(PG8_SA(0, 1), cA + hstep, voffA);
        if (wr == 1) PG8_BAR;
        PG8_WAIT_V(2); PG8_BAR;
        PG8_STAGE(PG8_SB(1, 0), cB + kstep, voffB); PG8_STAGE(PG8_SA(1, 0), cA + kstep, voffA); PG8_STAGE(PG8_SB(1, 1), cB + hstep + kstep, voffB);
        PG8_WAIT_V(6); PG8_BAR;
    } else {
        PG8_STAGE(PG8_SB(0, 0), cB, voffB); PG8_STAGE(PG8_SA(0, 0), cA, voffA); PG8_STAGE(PG8_SB(0, 1), cB + hstep, voffB); PG8_STAGE(PG8_SA(0, 1), cA + hstep, voffA);
        if (wr == 1) PG8_BAR;
        PG8_WAIT_V(4); PG8_BAR;
        PG8_STAGE(PG8_SB(1, 0), cB + kstep, voffB); PG8_STAGE(PG8_SA(1, 0), cA + kstep, voffA); PG8_STAGE(PG8_SB(1, 1), cB + hstep + kstep, voffB);
        PG8_WAIT_V(6); PG8_BAR;
    }
    for (;;) {
        const bool has_next = S.next(ui + 1, nxt);
        const char* nA = has_next ? PG8_ABASE(nxt) : cA; const char* nB = has_next ? PG8_BBASE(nxt) : cB;
#pragma nounroll
        for (int t = 0; t < nt; t += 2) {
            const bool last = (t == nt - 2);
            const char* a1 = cA + (size_t)(t + 1) * kstep;
            const char* a2 = last ? nA : cA + (size_t)(t + 2) * kstep; const char* b2 = last ? nB : cB + (size_t)(t + 2) * kstep;
            const char* a3 = a2 + kstep; const char* b3 = b2 + kstep;
            if (last && has_next) S.a_ready(nxt);
            if constexpr (SP2) {
            PG8_LDB(B0, 0, 0); PG8_LDB(B1, 0, 1); PG8_SCHED; PG8_LDA(At, 0, 0); PG8_STAGE(PG8_SA(1, 1), a1 + hstep, voffA);
            PG8_WAIT_V(8); PG8_WAIT_L(0); PG8_BAR; PG8_MMA(0, 0, At, B0); PG8_MMA(0, 1, At, B1); PG8_BAR; PG8_SCHED;
            PG8_LDA(At, 0, 1); PG8_STAGE(PG8_SB(0, 0), b2, voffB); PG8_STAGE(PG8_SB(0, 1), b2 + hstep, voffB); PG8_STAGE(PG8_SA(0, 0), a2, voffA);
            PG8_WAIT_V(8); PG8_WAIT_L(0); PG8_BAR; PG8_MMA(1, 0, At, B0); PG8_MMA(1, 1, At, B1); PG8_BAR; PG8_SCHED;
            PG8_LDB(B0, 1, 0); PG8_LDB(B1, 1, 1); PG8_SCHED; PG8_LDA(At, 1, 0); PG8_STAGE(PG8_SA(0, 1), a2 + hstep, voffA);
            PG8_WAIT_V(8); PG8_WAIT_L(0); PG8_BAR; PG8_MMA(0, 0, At, B0); PG8_MMA(0, 1, At, B1); PG8_BAR; PG8_SCHED;
            PG8_LDA(At, 1, 1); PG8_STAGE(PG8_SB(1, 0), b3, voffB); PG8_STAGE(PG8_SB(1, 1), b3 + hstep, voffB); PG8_STAGE(PG8_SA(1, 0), a3, voffA);
            PG8_WAIT_V(8); PG8_WAIT_L(0); PG8_BAR; PG8_MMA(1, 0, At, B0); PG8_MMA(1, 1, At, B1); PG8_BAR; PG8_SCHED;
            } else {
            PG8_LDB(B0, 0, 0); PG8_SCHED; PG8_LDA(At, 0, 0); PG8_STAGE(PG8_SA(1, 1), a1 + hstep, voffA);
            PG8_WAIT_L(8); PG8_BAR; PG8_WAIT_L(0); PG8_MMA(0, 0, At, B0); PG8_BAR; PG8_SCHED;
            PG8_LDB(B1, 0, 1); PG8_STAGE(PG8_SB(0, 0), b2, voffB);
            PG8_BAR; PG8_WAIT_L(0); PG8_MMA(0, 1, At, B1); PG8_BAR;
            PG8_LDA(At, 0, 1); PG8_STAGE(PG8_SA(0, 0), a2, voffA);
            PG8_BAR; PG8_WAIT_L(0); PG8_MMA(1, 0, At, B0); PG8_BAR; PG8_SCHED;
            PG8_STAGE(PG8_SB(0, 1), b2 + hstep, voffB);
            PG8_WAIT_V(6); PG8_BAR; PG8_MMA(1, 1, At, B1); PG8_BAR;
            PG8_LDB(B0, 1, 0); PG8_SCHED; PG8_LDA(At, 1, 0); PG8_STAGE(PG8_SA(0, 1), a2 + hstep, voffA);
            PG8_WAIT_L(8); PG8_BAR; PG8_WAIT_L(0); PG8_MMA(0, 0, At, B0); PG8_BAR; PG8_SCHED;
            PG8_LDB(B1, 1, 1); PG8_STAGE(PG8_SB(1, 0), b3, voffB);
            PG8_BAR; PG8_WAIT_L(0); PG8_MMA(0, 1, At, B1); PG8_BAR;
            PG8_LDA(At, 1, 1); PG8_STAGE(PG8_SA(1, 0), a3, voffA);
            PG8_BAR; PG8_WAIT_L(0); PG8_MMA(1, 0, At, B0); PG8_BAR; PG8_SCHED;
            PG8_STAGE(PG8_SB(1, 1), b3 + hstep, voffB);
            PG8_WAIT_V(6); PG8_BAR; PG8_MMA(1, 1, At, B1); PG8_BAR;
            }
        }
        if constexpr (ALIGN_EPI) { if (wr == 0) PG8_BAR; }
        if constexpr (FP8) asm volatile("s_nop 7\n\ts_nop 7\n\ts_nop 7" ::: "memory");
        E(acc, cur, wr, wc, fr, fq);
        if (!has_next) break;
#pragma unroll
        for (int a = 0; a < 2; ++a)
#pragma unroll
            for (int b = 0; b < 2; ++b)
#pragma unroll
                for (int m = 0; m < 4; ++m)
#pragma unroll
                    for (int n = 0; n < 2; ++n) acc[a][b][m][n] = (f32x4){0.f, 0.f, 0.f, 0.f};
        cur = nxt; cA = nA; cB = nB; ++ui;
        if constexpr (ALIGN_EPI) { if (wr == 1) PG8_BAR; }
    }
    PG8_WAIT_V(0);
    if constexpr (!ALIGN_EPI) { if (wr == 0) PG8_BAR; }
    PG8_BAR;
#undef PG8_SA
#undef PG8_SB
#undef PG8_STAGE
#undef PG8_LDA
#undef PG8_LDB
#undef PG8_MMA
#undef PG8_WAIT_V
#undef PG8_WAIT_L
#undef PG8_BAR
#undef PG8_SCHED
#undef PG8_ABASE
#undef PG8_BBASE
}

__device__ __forceinline__ f32x4 cvt_i4(f32x4 a) { const v4i_t i = __builtin_bit_cast(v4i_t, a); return (f32x4){(float)i.x, (float)i.y, (float)i.z, (float)i.w}; }
struct EpiProj {
    static constexpr bool PERM = true;
    bf16_t* O; float* ST; const float* SH; const float* SW;
    __device__ __forceinline__ void operator()(const f32x4 (&acc)[2][2][4][2], const Unit& u, int wr, int wc, int fr, int fq) const {
        const int row0 = u.pm * BM + wr * 64 + fr;
        f32x4 cs[2][2]; float rsc[2][4];
#pragma unroll
        for (int bj = 0; bj < 2; ++bj)
#pragma unroll
            for (int n = 0; n < 2; ++n) cs[bj][n] = *(const f32x4*)(SW + u.pn * BM + bj * HALF + wc * 32 + 8 * fq + 4 * n);
#pragma unroll
        for (int ai = 0; ai < 2; ++ai)
#pragma unroll
            for (int m = 0; m < 4; ++m) rsc[ai][m] = SH[row0 + ai * HALF + m * 16];
#define PG8_DQ(ai, bj, m, n) (cvt_i4(acc[ai][bj][m][n]) * cs[bj][n] * rsc[ai][m])
        if (u.pn >= 12 && u.pn < 20) {
            bf16_t* base = O + (size_t)3 * SEG + (u.pn - 12) * 128 + wc * 32 + 8 * fq;
#pragma unroll
            for (int ai = 0; ai < 2; ++ai)
#pragma unroll
                for (int m = 0; m < 4; ++m) { const f32x4 v0 = PG8_DQ(ai, 0, m, 0) * PG8_DQ(ai, 1, m, 0), v1 = PG8_DQ(ai, 0, m, 1) * PG8_DQ(ai, 1, m, 1);
                    u32x4 w; w.x = pk_bf16(v0[0], v0[1]); w.y = pk_bf16(v0[2], v0[3]); w.z = pk_bf16(v1[0], v1[1]); w.w = pk_bf16(v1[2], v1[3]);
                    *(u32x4*)(base + (size_t)(row0 + ai * HALF + m * 16) * D) = w; }
            return;
        }
        const int s = (u.pn < 12) ? (u.pn >> 2) : 5 + ((u.pn - 20) >> 2), act = (s < 2) ? 1 : (s >= 5 ? 2 : 0);
        const int col0 = (u.pn & 3) * BM + wc * 32 + 8 * fq;
        bf16_t* base = O + (size_t)s * SEG;
#pragma unroll
        for (int ai = 0; ai < 2; ++ai)
#pragma unroll
            for (int m = 0; m < 4; ++m) { bf16_t* rowp = base + (size_t)(row0 + ai * HALF + m * 16) * D + col0; float rs = 0.f, rq = 0.f;
#pragma unroll
                for (int bj = 0; bj < 2; ++bj) { f32x4 v0 = PG8_DQ(ai, bj, m, 0), v1 = PG8_DQ(ai, bj, m, 1);
                    if (act == 1) {
#pragma unroll
                        for (int j = 0; j < 4; ++j) { v0[j] = gelu_tanh(v0[j]); v1[j] = gelu_tanh(v1[j]); } }
                    else if (act == 2) {
#pragma unroll
                        for (int j = 0; j < 4; ++j) { v0[j] = sigmoidf_(v0[j]); v1[j] = sigmoidf_(v1[j]); } }
                    u32x4 w; w.x = pk_bf16(v0[0], v0[1]); w.y = pk_bf16(v0[2], v0[3]); w.z = pk_bf16(v1[0], v1[1]); w.w = pk_bf16(v1[2], v1[3]);
                    *(u32x4*)(rowp + bj * HALF) = w;
                    if (s == 1) {
                        const float a0 = bf_lo(w.x), a1 = bf_hi(w.x), a2 = bf_lo(w.y), a3 = bf_hi(w.y), a4 = bf_lo(w.z), a5 = bf_hi(w.z), a6 = bf_lo(w.w), a7 = bf_hi(w.w);
                        const float ps = ((a0 + a1) + (a2 + a3)) + ((a4 + a5) + (a6 + a7)), pq = ((a0 * a0 + a1 * a1) + (a2 * a2 + a3 * a3)) + ((a4 * a4 + a5 * a5) + (a6 * a6 + a7 * a7));
                        if (bj == 0) { rs = ps; rq = pq; } else { rs += ps; rq += pq; } } }
                if (s == 1) {
                    rs += shx(rs, 16); rq += shx(rq, 16); rs += shx(rs, 32); rq += shx(rq, 32);
                    if (fq == 0) *(f32x2*)(ST + ((size_t)(row0 + ai * HALF + m * 16) * 16 + (u.pn - 4) * 4 + wc) * 2) = (f32x2){rs, rq}; } }
    }
};
#undef PG8_DQ
struct EpiDual {
    static constexpr bool PERM = true;
    bf16_t* Mo; const bf16_t* SA; const bf16_t* SB; const float* SH; const float* SW; PG8_LAS unsigned* RM;
    __device__ __forceinline__ void operator()(const f32x4 (&acc)[2][2][4][2], const Unit& u, int wr, int wc, int fr, int fq) const {
        const int row0 = u.pm * BM + wr * 64 + fr, col0 = u.pn * BM + wc * 32 + 8 * fq;
        const bf16_t* G = u.z ? SB : SA;
        const float* shz = SH + (u.z ? M : 0); const float* swz = SW + (u.z ? 1024 : 0);
        f32x4 cs[2][2];
#pragma unroll
        for (int bj = 0; bj < 2; ++bj)
#pragma unroll
            for (int n = 0; n < 2; ++n) cs[bj][n] = *(const f32x4*)(swz + col0 + bj * HALF + 4 * n);
#pragma unroll
        for (int ai = 0; ai < 2; ++ai)
#pragma unroll
            for (int m = 0; m < 4; ++m) { const size_t ro = (size_t)(row0 + ai * HALF + m * 16) * D + col0; const float rsc = shz[row0 + ai * HALF + m * 16]; float rm = 0.f;
#pragma unroll
                for (int bj = 0; bj < 2; ++bj) { const u32x4 gw = *(const u32x4*)(G + ro + bj * HALF);
                    f32x4 v0 = cvt_i4(acc[ai][bj][m][0]) * cs[bj][0] * rsc, v1 = cvt_i4(acc[ai][bj][m][1]) * cs[bj][1] * rsc;
                    v0[0] *= bf_lo(gw.x); v0[1] *= bf_hi(gw.x); v0[2] *= bf_lo(gw.y); v0[3] *= bf_hi(gw.y);
                    v1[0] *= bf_lo(gw.z); v1[1] *= bf_hi(gw.z); v1[2] *= bf_lo(gw.w); v1[3] *= bf_hi(gw.w);
                    if (u.z) { const u32x4 pw = *(const u32x4*)(Mo + ro + bj * HALF);
                        v0[0] += bf_lo(pw.x); v0[1] += bf_hi(pw.x); v0[2] += bf_lo(pw.y); v0[3] += bf_hi(pw.y);
                        v1[0] += bf_lo(pw.z); v1[1] += bf_hi(pw.z); v1[2] += bf_lo(pw.w); v1[3] += bf_hi(pw.w); }
                    u32x4 w; w.x = pk_bf16(v0[0], v0[1]); w.y = pk_bf16(v0[2], v0[3]); w.z = pk_bf16(v1[0], v1[1]); w.w = pk_bf16(v1[2], v1[3]);
                    *(u32x4*)(Mo + ro + bj * HALF) = w;
                    rm = fmaxf(rm, fmaxf(fmaxf(fmaxf(fabsf(v0[0]), fabsf(v0[1])), fmaxf(fabsf(v0[2]), fabsf(v0[3]))), fmaxf(fmaxf(fabsf(v1[0]), fabsf(v1[1])), fmaxf(fabsf(v1[2]), fabsf(v1[3]))))); }
                if (u.z) { rm = fmaxf(rm, shx(rm, 16)); rm = fmaxf(rm, shx(rm, 32));
                    if (fq == 0) (void)__hip_atomic_fetch_max(RM + (ai * HALF + wr * 64 + m * 16 + fr), __float_as_uint(rm), __ATOMIC_RELAXED, __HIP_MEMORY_SCOPE_WORKGROUP); } }
    }
};
struct EpiRes {
    static constexpr bool PERM = true;
    bf16_t* R; const float* X; const float* mod; const float* SH; const float* SW;
    __device__ __forceinline__ void operator()(const f32x4 (&acc)[2][2][4][2], const Unit& u, int wr, int wc, int fr, int fq) const {
        const int row0 = u.pm * BM + wr * 64 + fr, col0 = u.pn * BM + wc * 32 + 8 * fq;
        const int b = (u.pm * BM) >> 11;
        f32x4 g1[2][2];
#pragma unroll
        for (int bj = 0; bj < 2; ++bj)
#pragma unroll
            for (int n = 0; n < 2; ++n) g1[bj][n] = *(const f32x4*)(mod + (size_t)b * NMOD + 2048 + col0 + bj * HALF + 4 * n) * *(const f32x4*)(SW + col0 + bj * HALF + 4 * n);
#pragma unroll
        for (int ai = 0; ai < 2; ++ai)
#pragma unroll
            for (int m = 0; m < 4; ++m) { const size_t ro = (size_t)(row0 + ai * HALF + m * 16) * D + col0; const float rsc = SH[row0 + ai * HALF + m * 16];
#pragma unroll
                for (int bj = 0; bj < 2; ++bj) { const f32x4 x0 = *(const f32x4*)(X + ro + bj * HALF), x1 = *(const f32x4*)(X + ro + bj * HALF + 4);
                    const f32x4 v0 = x0 * ALPHA + g1[bj][0] * (cvt_i4(acc[ai][bj][m][0]) * rsc), v1 = x1 * ALPHA + g1[bj][1] * (cvt_i4(acc[ai][bj][m][1]) * rsc);
                    u32x4 w; w.x = pk_bf16(v0[0], v0[1]); w.y = pk_bf16(v0[2], v0[3]); w.z = pk_bf16(v1[0], v1[1]); w.w = pk_bf16(v1[2], v1[3]);
                    *(u32x4*)(R + ro + bj * HALF) = w; } }
    }
};
struct EpiPlainI8 {
    static constexpr bool PERM = true;
    bf16_t* O; bf16_t* O2; int ldc; const float* SH; const float* SW;
    __device__ __forceinline__ void operator()(const f32x4 (&acc)[2][2][4][2], const Unit& u, int wr, int wc, int fr, int fq) const {
        const int row0 = u.pm * BM + wr * 64 + fr, col0 = u.pn * BM + wc * 32 + 8 * fq;
        bf16_t* Oz = ((u.pn < 4) ? O : O2) + (u.pn & 3) * BM + wc * 32 + 8 * fq;
        f32x4 cs[2][2];
#pragma unroll
        for (int bj = 0; bj < 2; ++bj)
#pragma unroll
            for (int n = 0; n < 2; ++n) cs[bj][n] = *(const f32x4*)(SW + col0 + bj * HALF + 4 * n);
#pragma unroll
        for (int ai = 0; ai < 2; ++ai)
#pragma unroll
            for (int m = 0; m < 4; ++m) { bf16_t* rowp = Oz + (size_t)(row0 + ai * HALF + m * 16) * ldc; const float rsc = SH[row0 + ai * HALF + m * 16];
#pragma unroll
                for (int bj = 0; bj < 2; ++bj) { const f32x4 v0 = cvt_i4(acc[ai][bj][m][0]) * cs[bj][0] * rsc, v1 = cvt_i4(acc[ai][bj][m][1]) * cs[bj][1] * rsc;
                    u32x4 w; w.x = pk_bf16(v0[0], v0[1]); w.y = pk_bf16(v0[2], v0[3]); w.z = pk_bf16(v1[0], v1[1]); w.w = pk_bf16(v1[2], v1[3]);
                    *(u32x4*)(rowp + bj * HALF) = w; } }
    }
};
struct EpiPlain {
    static constexpr bool PERM = true;
    bf16_t* O; int ldc;
    __device__ __forceinline__ void operator()(const f32x4 (&acc)[2][2][4][2], const Unit& u, int wr, int wc, int fr, int fq) const {
        const int row0 = u.pm * BM + wr * 64 + fr, col0 = u.pn * BM + wc * 32 + 8 * fq;
#pragma unroll
        for (int ai = 0; ai < 2; ++ai)
#pragma unroll
            for (int m = 0; m < 4; ++m) { bf16_t* rowp = O + (size_t)(row0 + ai * HALF + m * 16) * ldc + col0;
#pragma unroll
                for (int bj = 0; bj < 2; ++bj) { const f32x4 v0 = acc[ai][bj][m][0], v1 = acc[ai][bj][m][1];
                    u32x4 w; w.x = pk_bf16(v0[0], v0[1]); w.y = pk_bf16(v0[2], v0[3]); w.z = pk_bf16(v1[0], v1[1]); w.w = pk_bf16(v1[2], v1[3]);
                    *(u32x4*)(rowp + bj * HALF) = w; } }
    }
};
}

#define XB_TMO      128
#define XB_XCNT(j)  (256  + 64 * (j))
#define XB_XSUB(j)  (1280 + 64 * (j))
#define XB_XGEN(j)  (2304 + 64 * (j))
#define XB_TOP      3328
#define XB_TOPGEN   3392
#define XCD_BAR_WORDS 3456
#define XB_SPIN_CAP (1u << 18)
__device__ __forceinline__ unsigned xb_ld(unsigned* p)              { return __hip_atomic_load(p, __ATOMIC_RELAXED, __HIP_MEMORY_SCOPE_AGENT); }
__device__ __forceinline__ unsigned xb_add(unsigned* p, unsigned v) { return __hip_atomic_fetch_add(p, v, __ATOMIC_RELAXED, __HIP_MEMORY_SCOPE_AGENT); }
__device__ __forceinline__ unsigned xb_xcc_id() { return (unsigned)__builtin_amdgcn_s_getreg((3 << 11) | 20) & 0xFu; }
#define XB_SPIN(cond, bar) do { unsigned _sp = 0; while (cond) { __builtin_amdgcn_s_sleep(1); \
    if ((++_sp & 255u) == 0u) { if (xb_ld(&(bar)[XB_TMO])) break; if (_sp > XB_SPIN_CAP) { atomicAdd(&(bar)[XB_TMO], 1u); break; } } } } while (0)
struct XcdBarrier { unsigned* bar; unsigned x; volatile LAS unsigned* st; int wave; };
__device__ __forceinline__ XcdBarrier xcd_barrier_post(unsigned* bar, volatile LAS unsigned* st, int wave) {
    XcdBarrier b; b.bar = bar; b.x = xb_xcc_id(); b.st = st; b.wave = wave;
    if (wave == 0 && lane_now() == 0) (void)xb_add(&bar[XB_XCNT(b.x)], 1u);
    return b;
}
__device__ __forceinline__ void xcd_barrier_complete(unsigned* bar, unsigned x, unsigned& nloc, unsigned& nx) {
    const unsigned G = gridDim.x * gridDim.y * gridDim.z;
    unsigned sum, cnt, mine, sp = 0u;
    for (;;) {
        sum = 0u; cnt = 0u; mine = 0u;
#pragma unroll
        for (unsigned j = 0; j < 16; ++j) { const unsigned c = xb_ld(&bar[XB_XCNT(j)]); sum += c; cnt += (c > 0u) ? 1u : 0u; mine = (j == x) ? c : mine; }
        if (sum == G) break;
        __builtin_amdgcn_s_sleep(1);
        if ((++sp & 255u) == 0u) { if (xb_ld(&bar[XB_TMO])) break; if (sp > XB_SPIN_CAP) { atomicAdd(&bar[XB_TMO], 1u); break; } }
    }
    nloc = mine > 0u ? mine : 1u; nx = cnt > 0u ? cnt : 1u;
}
__device__ __forceinline__ void xcd_barrier(const XcdBarrier& b) {
    asm volatile("s_waitcnt vmcnt(0)" ::: "memory");
    __syncthreads();
    if (b.wave == 0 && lane_now() == 0) {
        unsigned* bar = b.bar;
        __builtin_amdgcn_s_waitcnt(0);
        unsigned nloc = b.st[0], nx = b.st[1];
        if (nloc == 0u) { xcd_barrier_complete(bar, b.x, nloc, nx); b.st[0] = nloc; b.st[1] = nx; }
        const unsigned old = xb_add(&bar[XB_XSUB(b.x)], 1u);
        const unsigned gen = old / nloc;
        if (old + 1u == (gen + 1u) * nloc) {
            __builtin_amdgcn_fence(__ATOMIC_RELEASE, "agent");
            asm volatile("s_waitcnt vmcnt(0)" ::: "memory");
            const unsigned og = xb_add(&bar[XB_TOP], 1u);
            const unsigned tg = og / nx;
            if (og + 1u == (tg + 1u) * nx) xb_add(&bar[XB_TOPGEN], 1u);
            else XB_SPIN(xb_ld(&bar[XB_TOPGEN]) == tg, bar);
            __builtin_amdgcn_fence(__ATOMIC_ACQUIRE, "agent");
            xb_add(&bar[XB_XGEN(b.x)], 1u);
            asm volatile("s_waitcnt vmcnt(0)" ::: "memory");
        } else {
            XB_SPIN(xb_ld(&bar[XB_XGEN(b.x)]) == gen, bar);
            __builtin_amdgcn_fence(__ATOMIC_ACQUIRE, "agent");
            asm volatile("s_waitcnt vmcnt(0)" ::: "memory");
        }
    }
    __syncthreads();
}

struct Frame {
    LAS unsigned char* lds;
    int tid, lane, wave, G, gw, NGW;
    const float *x, *c, *w_cond, *b_cond, *w_in, *gln_g, *gln_b, *w_sp, *b_sp, *conv_w, *p_a, *p_b, *w_o, *ln1_g, *ln1_b, *w_q, *keys, *eu, *ev, *ln2_g, *ln2_b;
    float* out; float* mod;
    bf16 *Win_t, *Pa_t, *Pb_t, *Wo_t, *Wq_t, *Keys, *Wsp, *EU, *EV;
    unsigned* sel; const bf16* zrow; unsigned char *EU8, *EV8; float* SC; float* ST;
    unsigned* CM; float* SW; float* SH;
    float* TOPS; bf16* Rb; unsigned char* H2q; unsigned char* M8;
    bf16 *H, *B1, *B2, *B3, *B4, *B5, *B6;
};

constexpr float WSC8 = 256.0f;
__device__ __forceinline__ unsigned pk4_fp8(float a, float b, float c, float d) {
    a = fminf(fmaxf(a, -448.f), 448.f); b = fminf(fmaxf(b, -448.f), 448.f); c = fminf(fmaxf(c, -448.f), 448.f); d = fminf(fmaxf(d, -448.f), 448.f);
    int w = __builtin_amdgcn_cvt_pk_fp8_f32(a, b, 0, false); w = __builtin_amdgcn_cvt_pk_fp8_f32(c, d, w, true); return (unsigned)w;
}
template <bool PAIRED = false, bool FP8OUT = false>
__device__ __forceinline__ void p0_transpose_item(const float* W, int K, int N, bf16* WT, LAS float* scr, int item, int lane) {
    const int nblk = N / 32, kb = item / nblk, nb = item % nblk, k0 = 64 * kb, n0 = 32 * nb;
    int ns = n0;
    if (PAIRED && n0 >= 3072 && n0 < 5120) { const int q = n0 - 3072; ns = (((q >> 7) & 1) ? 4096 : 3072) + 128 * (q >> 8) + (q & 127); }
#pragma unroll 8
    for (int i = 0; i < 32; ++i) { const int kk = 2 * i + (lane >> 5); scr[kk * 33 + (lane & 31)] = W[(size_t)(k0 + kk) * N + ns + (lane & 31)]; }
    LDS_WAIT(); asm volatile("" ::: "memory");
    const int c = lane & 7;
#pragma unroll
    for (int j = 0; j < 4; ++j) { const int n = (lane >> 3) + 8 * j; const LAS float* s = scr + (8 * c) * 33 + n;
        if constexpr (FP8OUT) {
            v2u o8; o8.x = pk4_fp8(s[0 * 33] * WSC8, s[1 * 33] * WSC8, s[2 * 33] * WSC8, s[3 * 33] * WSC8); o8.y = pk4_fp8(s[4 * 33] * WSC8, s[5 * 33] * WSC8, s[6 * 33] * WSC8, s[7 * 33] * WSC8);
            *(GAS v2u*)((unsigned char*)WT + (size_t)(n0 + n) * K + k0 + 8 * c) = o8; continue; }
        v4u o; o.x = pk_bf16(s[0 * 33], s[1 * 33]); o.y = pk_bf16(s[2 * 33], s[3 * 33]); o.z = pk_bf16(s[4 * 33], s[5 * 33]); o.w = pk_bf16(s[6 * 33], s[7 * 33]);
        *(GAS v4u*)(WT + (size_t)(n0 + n) * K + k0 + 8 * c) = o; }
    LDS_WAIT(); asm volatile("" ::: "memory");
}
template <bool PAIRED = false>
__device__ __forceinline__ void p0_colmax_item(const float* W, int K, int N, unsigned* CM, int item, int lane) {
    const int nblk = N / 32, kb = item / nblk, nb = item % nblk, k0 = 64 * kb, n0 = 32 * nb;
    int ns = n0;
    if (PAIRED && n0 >= 3072 && n0 < 5120) { const int q = n0 - 3072; ns = (((q >> 7) & 1) ? 4096 : 3072) + 128 * (q >> 8) + (q & 127); }
    float mx = 0.f;
#pragma unroll 8
    for (int i = 0; i < 32; ++i) { const int kk = 2 * i + (lane >> 5); mx = fmaxf(mx, fabsf(W[(size_t)(k0 + kk) * N + ns + (lane & 31)])); }
    mx = fmaxf(mx, shx(mx, 32));
    if (lane < 32) (void)__hip_atomic_fetch_max(&CM[n0 + lane], __float_as_uint(mx), __ATOMIC_RELAXED, __HIP_MEMORY_SCOPE_AGENT);
}
template <bool PAIRED = false>
__device__ __forceinline__ void p1_quant_item(const float* W, int K, int N, unsigned char* WT8, const unsigned* CM, float* SW, LAS float* scr, int item, int lane) {
    const int nblk = N / 32, kb = item / nblk, nb = item % nblk, k0 = 64 * kb, n0 = 32 * nb;
    int ns = n0;
    if (PAIRED && n0 >= 3072 && n0 < 5120) { const int q = n0 - 3072; ns = (((q >> 7) & 1) ? 4096 : 3072) + 128 * (q >> 8) + (q & 127); }
#pragma unroll 8
    for (int i = 0; i < 32; ++i) { const int kk = 2 * i + (lane >> 5); scr[kk * 33 + (lane & 31)] = W[(size_t)(k0 + kk) * N + ns + (lane & 31)]; }
    LDS_WAIT(); asm volatile("" ::: "memory");
    const int c = lane & 7;
#pragma unroll
    for (int j = 0; j < 4; ++j) { const int n = (lane >> 3) + 8 * j; const LAS float* t = scr + (8 * c) * 33 + n;
        const float amax = __uint_as_float(CM[n0 + n]), inv = (amax > 0.f) ? 127.0f / amax : 0.f;
        v2u o8; o8.x = pk4_i8(t[0 * 33] * inv, t[1 * 33] * inv, t[2 * 33] * inv, t[3 * 33] * inv); o8.y = pk4_i8(t[4 * 33] * inv, t[5 * 33] * inv, t[6 * 33] * inv, t[7 * 33] * inv);
        *(GAS v2u*)(WT8 + (size_t)(n0 + n) * K + k0 + 8 * c) = o8;
        if (kb == 0 && c == 0) SW[n0 + n] = amax * (1.0f / 127.0f); }
    LDS_WAIT(); asm volatile("" ::: "memory");
}
__device__ __forceinline__ void p0_cond_item(Frame& F, int it) {
    LAS float* sc = (LAS float*)F.lds;
    for (int i0 = 0; i0 < 64; i0 += 8) {
        float v[8];
#pragma unroll
        for (int i = 0; i < 8; ++i) v[i] = F.c[F.tid + 512 * (i0 + i)];
#pragma unroll
        for (int i = 0; i < 8; ++i) { const int e = F.tid + 512 * (i0 + i), b = e >> 10, k = e & 1023; sc[k * 32 + b] = v[i] / (1.0f + __expf(-v[i])); }
    }
    __syncthreads();
    float acc[32];
#pragma unroll
    for (int b = 0; b < 32; ++b) acc[b] = 0.f;
    const float* W = F.w_cond + it * 64 + F.lane;
    for (int k0 = F.wave * 128; k0 < F.wave * 128 + 128; k0 += 16) {
        float wv[16];
#pragma unroll
        for (int i = 0; i < 16; ++i) wv[i] = W[(size_t)(k0 + i) * NMOD];
#pragma unroll
        for (int i = 0; i < 16; ++i) { const LAS f32x4* s4 = (const LAS f32x4*)(sc + (k0 + i) * 32);
#pragma unroll
            for (int q = 0; q < 8; ++q) { const f32x4 s = s4[q]; acc[4 * q + 0] += s.x * wv[i]; acc[4 * q + 1] += s.y * wv[i]; acc[4 * q + 2] += s.z * wv[i]; acc[4 * q + 3] += s.w * wv[i]; } }
    }
    __syncthreads();
    LAS float* red = (LAS float*)F.lds;
#pragma unroll
    for (int b = 0; b < 32; ++b) red[(F.wave * 32 + b) * 64 + F.lane] = acc[b];
    __syncthreads();
#pragma unroll
    for (int i = 0; i < 4; ++i) { const int e = F.tid + 512 * i, b = e >> 6, ln = e & 63; float s = F.b_cond[it * 64 + ln];
#pragma unroll
        for (int w = 0; w < 8; ++w) s += red[(w * 32 + b) * 64 + ln];
        F.mod[b * NMOD + it * 64 + ln] = s; }
    __syncthreads();
}
__device__ __forceinline__ void cvt8(const float* src, bf16* dst, size_t i8) {
    const f32x4 a = *(const GAS f32x4*)(src + i8 * 8), b = *(const GAS f32x4*)(src + i8 * 8 + 4);
    v4u o; o.x = pk_bf16(a.x, a.y); o.y = pk_bf16(a.z, a.w); o.z = pk_bf16(b.x, b.y); o.w = pk_bf16(b.z, b.w);
    *(GAS v4u*)(dst + i8 * 8) = o;
}
__device__ __forceinline__ void phase0(Frame& F) {
    for (int it = blockIdx.x; it < NMOD / 64; it += F.G) p0_cond_item(F, it);
    LAS float* scr = (LAS float*)(F.lds + F.wave * 16384);
    constexpr int I_IN = (D / 64) * (NIN / 32), I_SQ = (D / 64) * (D / 32), I_Q = (D / 64) * (NQ / 32);
    constexpr int NITEMS = I_IN + 3 * I_SQ + I_Q;
    for (int it = F.gw; it < NITEMS; it += F.NGW) {
        int r = it;
        if (r < I_IN) { p0_colmax_item<true>(F.w_in, D, NIN, F.CM, r, F.lane); continue; } r -= I_IN;
        if (r < I_SQ) { p0_colmax_item<false>(F.p_a, D, D, F.CM + NIN + NQ, r, F.lane); continue; } r -= I_SQ;
        if (r < I_SQ) { p0_colmax_item<false>(F.p_b, D, D, F.CM + NIN + NQ + D, r, F.lane); continue; } r -= I_SQ;
        if (r < I_SQ) { p0_colmax_item<false>(F.w_o, D, D, F.CM + NIN + NQ + 2 * D, r, F.lane); continue; } r -= I_SQ;
        p0_colmax_item<false>(F.w_q, D, NQ, F.CM + NIN, r, F.lane);
    }
    const size_t gt = (size_t)blockIdx.x * 512 + F.tid, NT = (size_t)F.G * 512;
    for (int e0 = 2 * F.gw; e0 < NE; e0 += 2 * F.NGW) {
        f32x4 ru[2][4], rv[2][4];
#pragma unroll
        for (int x = 0; x < 2; ++x) { const GAS f32x4* su = (const GAS f32x4*)(F.eu + (size_t)(e0 + x) * D) + 4 * F.lane; const GAS f32x4* sv = (const GAS f32x4*)(F.ev + (size_t)(e0 + x) * D) + 4 * F.lane;
#pragma unroll
            for (int i = 0; i < 4; ++i) { ru[x][i] = su[i]; rv[x][i] = sv[i]; } }
#pragma unroll
        for (int x = 0; x < 2; ++x) {
            const int e = e0 + x;
            float amu = 0.f, amv = 0.f;
#pragma unroll
            for (int i = 0; i < 4; ++i) { amu = fmaxf(amu, fmaxf(fmaxf(fabsf(ru[x][i].x), fabsf(ru[x][i].y)), fmaxf(fabsf(ru[x][i].z), fabsf(ru[x][i].w))));
                                          amv = fmaxf(amv, fmaxf(fmaxf(fabsf(rv[x][i].x), fabsf(rv[x][i].y)), fmaxf(fabsf(rv[x][i].z), fabsf(rv[x][i].w)))); }
            amu = wave_max(amu); amv = wave_max(amv);
            const int ex = (int)((__float_as_uint(amv) >> 23) & 0xFFu) - 127;
            const int k = (amv > 0.f) ? ((7 - ex) < 100 ? (7 - ex) : 100) : 0;
            const float sc = __uint_as_float((unsigned)(127 + k) << 23), iscv = __uint_as_float((unsigned)(127 - k) << 23);
            unsigned ov[4], ou[4];
#pragma unroll
            for (int i = 0; i < 4; ++i) { int w = __builtin_amdgcn_cvt_pk_fp8_f32(rv[x][i].x * sc, rv[x][i].y * sc, 0, false); w = __builtin_amdgcn_cvt_pk_fp8_f32(rv[x][i].z * sc, rv[x][i].w * sc, w, true); ov[i] = (unsigned)w; }
            const float inv = (amu > 0.f) ? 127.0f / amu : 0.f, iscu = amu * (1.0f / 127.0f);
#define Q8(v) ((unsigned)__float2int_rn((v) * inv) & 0xFFu)
#pragma unroll
            for (int i = 0; i < 4; ++i) ou[i] = Q8(ru[x][i].x) | (Q8(ru[x][i].y) << 8) | (Q8(ru[x][i].z) << 16) | (Q8(ru[x][i].w) << 24);
#undef Q8
            *((GAS v4u*)(F.EU8 + (size_t)e * D) + F.lane) = (v4u){ou[0], ou[1], ou[2], ou[3]};
            *((GAS v4u*)(F.EV8 + (size_t)e * D) + F.lane) = (v4u){ov[0], ov[1], ov[2], ov[3]};
            if (F.lane == 0) *(GAS f32x2*)(F.SC + 2 * e) = (f32x2){iscu, iscv};
        }
    }
    for (size_t i = gt; i < (size_t)8 * 2 * 128 * 128 / 8; i += NT) cvt8(F.keys, F.Keys, i);
    for (size_t i = gt; i < (size_t)8 * 128 * 128 / 8; i += NT) {
        const int e = (int)i * 8, j = e & 127, ii = (e >> 7) & 127;
        if ((j >> 6) <= (ii >> 6)) cvt8(F.w_sp, F.Wsp, i); else *(GAS v4u*)(F.Wsp + i * 8) = (v4u){0u, 0u, 0u, 0u};
    }
}

__device__ __forceinline__ void phase1(Frame& F) {
    {   LAS float* scr = (LAS float*)(F.lds + F.wave * 16384);
        constexpr int I_IN = (D / 64) * (NIN / 32), I_Q = (D / 64) * (NQ / 32), I_SQ = (D / 64) * (D / 32);
        for (int it = F.gw; it < I_IN + I_Q + 3 * I_SQ; it += F.NGW) {
            if (it < I_IN) p1_quant_item<true>(F.w_in, D, NIN, (unsigned char*)F.Win_t, F.CM, F.SW, scr, it, F.lane);
            else if (it < I_IN + I_Q) p1_quant_item<false>(F.w_q, D, NQ, (unsigned char*)F.Wq_t, F.CM + NIN, F.SW + 8192, scr, it - I_IN, F.lane);
            else if (it < I_IN + I_Q + I_SQ) p1_quant_item<false>(F.p_a, D, D, (unsigned char*)F.Pa_t, F.CM + NIN + NQ, F.SW + 10240, scr, it - I_IN - I_Q, F.lane);
            else if (it < I_IN + I_Q + 2 * I_SQ) p1_quant_item<false>(F.p_b, D, D, (unsigned char*)F.Pb_t, F.CM + NIN + NQ + D, F.SW + 11264, scr, it - I_IN - I_Q - I_SQ, F.lane);
            else p1_quant_item<false>(F.w_o, D, D, (unsigned char*)F.Wo_t, F.CM + NIN + NQ + 2 * D, F.SW + 12288, scr, it - I_IN - I_Q - 2 * I_SQ, F.lane);
        }
    }
    for (int blk = F.gw; blk < M / 32; blk += F.NGW) {
        const int r0 = blk * 32, b = r0 >> 11;
        const GAS f32x4* mp = (const GAS f32x4*)(F.mod + (size_t)b * NMOD) + F.lane;
        f32x4 sh[4], sc[4];
#pragma unroll
        for (int j = 0; j < 4; ++j) { sh[j] = mp[64 * j]; sc[j] = mp[256 + 64 * j] + 1.0f; }
#pragma unroll 2
        for (int r = 0; r < 32; ++r) {
            const GAS f32x4* xr = (const GAS f32x4*)(F.x + (size_t)(r0 + r) * D) + F.lane;
            f32x4 v[4]; float s = 0.f;
#pragma unroll
            for (int j = 0; j < 4; ++j) { v[j] = xr[64 * j]; s += (v[j].x + v[j].y) + (v[j].z + v[j].w); }
            const float mean = wave_sum(s) * (1.f / D); float s2 = 0.f;
#pragma unroll
            for (int j = 0; j < 4; ++j) { v[j] = v[j] - mean; s2 += (v[j].x * v[j].x + v[j].y * v[j].y) + (v[j].z * v[j].z + v[j].w * v[j].w); }
            const float rstd = 1.f / sqrtf(wave_sum(s2) * (1.f / D) + LN_EPS);
            GAS unsigned* o8 = (GAS unsigned*)((unsigned char*)F.H + (size_t)(r0 + r) * D) + F.lane;
            float mx = 0.f;
#pragma unroll
            for (int j = 0; j < 4; ++j) { v[j] = v[j] * rstd * sc[j] + sh[j]; mx = fmaxf(mx, fmaxf(fmaxf(fabsf(v[j].x), fabsf(v[j].y)), fmaxf(fabsf(v[j].z), fabsf(v[j].w)))); }
            mx = wave_max(mx);
            const float inv = (mx > 0.f) ? 127.0f / mx : 0.f;
#pragma unroll
            for (int j = 0; j < 4; ++j) o8[64 * j] = pk4_i8(v[j].x * inv, v[j].y * inv, v[j].z * inv, v[j].w * inv);
            if (F.lane == 0) F.SH[r0 + r] = mx * (1.0f / 127.0f);
        }
    }
}

__device__ __forceinline__ unsigned off_b(unsigned row, unsigned ch) { return 256u * row + 16u * (ch ^ (((row & 3) << 2) | ((row >> 2) & 3))); }
__device__ __forceinline__ unsigned tr_read_addr_16(unsigned lane, unsigned c, unsigned ks, unsigned t) {
    const unsigned g = lane >> 4, q = (lane & 15) >> 2, p = lane & 3;
    return off_b(32 * ks + 8 * g + 4 * t + q, 2 * c + (p >> 1)) + 8 * (p & 1);
}
typedef short v4i16_t __attribute__((ext_vector_type(4)));
__device__ __forceinline__ s16x4 lds_tr(LAS unsigned char* p) { return __builtin_bit_cast(s16x4, __builtin_amdgcn_ds_read_tr16_b64_v4i16((LAS v4i16_t*)p)); }

__device__ __forceinline__ void phase3_panel(Frame& F, const int pm) {
    LAS f32x2* stat = (LAS f32x2*)(F.lds + 65536);
    const int fr = F.lane & 15, fq = F.lane >> 4;
    for (int blk = 2 * pm; blk < 2 * pm + 2; ++blk) {
        const size_t T0 = (size_t)blk * 128;
        if (F.tid < 128) {
            const GAS f32x4* sp = (const GAS f32x4*)(F.ST + (T0 + F.tid) * 32);
            float sm = 0.f, sq = 0.f;
#pragma unroll
            for (int i = 0; i < 8; ++i) { const f32x4 v = sp[i]; sm += v.x + v.z; sq += v.y + v.w; }
            const float mean = sm * (1.f / D), var = fmaxf(sq * (1.f / D) - mean * mean, 0.f);
            stat[F.tid] = (f32x2){mean, 1.f / sqrtf(var + LN_EPS)};
        }
        __syncthreads();
        float rmx = 0.f;
        for (int g = 0; g < 8; ++g) {
            LAS unsigned char* img = F.lds + (g & 1) * 32768;
            {
                const int ch = F.tid & 15;
                const GAS f32x4* lg = (const GAS f32x4*)(F.gln_g + g * 128 + 8 * ch); const GAS f32x4* lb = (const GAS f32x4*)(F.gln_b + g * 128 + 8 * ch);
                const f32x4 g0 = lg[0], g1 = lg[1], b0 = lb[0], b1 = lb[1];
#pragma unroll
                for (int i = 0; i < 4; ++i) { const int q = F.tid + 512 * i, j = q >> 4;
                    const v4u w = *(const GAS v4u*)(F.B2 + (T0 + j) * D + g * 128 + 8 * ch);
                    const f32x2 st = stat[j];
                    v4u o;
                    o.x = pk_bf16((bf_lo(w.x) - st.x) * st.y * g0.x + b0.x, (bf_hi(w.x) - st.x) * st.y * g0.y + b0.y);
                    o.y = pk_bf16((bf_lo(w.y) - st.x) * st.y * g0.z + b0.z, (bf_hi(w.y) - st.x) * st.y * g0.w + b0.w);
                    o.z = pk_bf16((bf_lo(w.z) - st.x) * st.y * g1.x + b1.x, (bf_hi(w.z) - st.x) * st.y * g1.y + b1.y);
                    o.w = pk_bf16((bf_lo(w.w) - st.x) * st.y * g1.z + b1.z, (bf_hi(w.w) - st.x) * st.y * g1.w + b1.w);
                    *(LAS v4u*)(img + off_b(j, ch)) = o; }
            }
            __syncthreads();
            f32x4 acc[8];
#pragma unroll
            for (int ct = 0; ct < 8; ++ct) acc[ct] = (f32x4){0.f, 0.f, 0.f, 0.f};
#pragma unroll
            for (int ks = 0; ks < 4; ++ks) {
                const bf16x8 wf = *(const GAS bf16x8*)(F.Wsp + ((size_t)(g * 128 + 16 * F.wave + fr)) * 128 + 32 * ks + 8 * fq);
#pragma unroll
                for (int ct = 0; ct < 8; ++ct) {
                    const s16x4 t0 = lds_tr(img + tr_read_addr_16(F.lane, ct, ks, 0)), t1 = lds_tr(img + tr_read_addr_16(F.lane, ct, ks, 1));
                    const bf16x8 vf = {t0[0], t0[1], t0[2], t0[3], t1[0], t1[1], t1[2], t1[3]};
                    acc[ct] = __builtin_amdgcn_mfma_f32_16x16x32_bf16(vf, wf, acc[ct], 0, 0, 0);
                }
            }
            const int i = 16 * F.wave + fr;
            const float bias = F.b_sp[g * 128 + i];
            GAS v2u* up = (GAS v2u*)(F.B1 + (T0 + i) * D + g * 128 + 4 * fq);
#pragma unroll
            for (int ct = 0; ct < 8; ++ct) { const v2u uu = up[4 * ct];
                const float y0 = bf_lo(uu.x) * (acc[ct][0] + bias), y1 = bf_hi(uu.x) * (acc[ct][1] + bias), y2 = bf_lo(uu.y) * (acc[ct][2] + bias), y3 = bf_hi(uu.y) * (acc[ct][3] + bias);
                rmx = fmaxf(rmx, fmaxf(fmaxf(fabsf(y0), fabsf(y1)), fmaxf(fabsf(y2), fabsf(y3))));
                v2u o; o.x = pk_bf16(y0, y1); o.y = pk_bf16(y2, y3);
                up[4 * ct] = o; }
        }
        {
            rmx = fmaxf(rmx, shx(rmx, 16)); rmx = fmaxf(rmx, shx(rmx, 32));
            const float inv = (rmx > 0.f) ? 127.0f / rmx : 0.f;
            const int i = 16 * F.wave + fr;
            asm volatile("s_waitcnt vmcnt(0)" ::: "memory");
            for (int g = 0; g < 8; ++g) {
                const GAS v2u* up = (const GAS v2u*)(F.B1 + (T0 + i) * D + g * 128 + 4 * fq);
                GAS unsigned* qp = (GAS unsigned*)((unsigned char*)F.B5 + (T0 + i) * D + g * 128 + 4 * fq);
                v2u uu[8];
#pragma unroll
                for (int ct = 0; ct < 8; ++ct) uu[ct] = up[4 * ct];
#pragma unroll
                for (int ct = 0; ct < 8; ++ct) qp[4 * ct] = pk4_i8(bf_lo(uu[ct].x) * inv, bf_hi(uu[ct].x) * inv, bf_lo(uu[ct].y) * inv, bf_hi(uu[ct].y) * inv);
            }
            if (fq == 0) F.SH[2 * M + T0 + i] = rmx * (1.0f / 127.0f);
        }
        __syncthreads();
    }
    {   const int it = pm * 8 + F.wave;
        const int t0 = it * 32;
        float w0[16], w1[16], w2[16], p1[16], p2[16];
#pragma unroll
        for (int h = 0; h < 2; ++h)
#pragma unroll
            for (int e = 0; e < 8; ++e) { const int col = h * 512 + F.lane * 8 + e; w0[8 * h + e] = F.conv_w[col]; w1[8 * h + e] = F.conv_w[D + col]; w2[8 * h + e] = F.conv_w[2 * D + col]; p1[8 * h + e] = 0.f; p2[8 * h + e] = 0.f; }
        if ((t0 & (SEQ - 1)) != 0) {
#pragma unroll
            for (int h = 0; h < 2; ++h) { const int col = h * 512 + F.lane * 8;
                const v4u c1 = *(const GAS v4u*)(F.B4 + (size_t)(t0 - 1) * D + col), c2 = *(const GAS v4u*)(F.B4 + (size_t)(t0 - 2) * D + col);
                p1[8 * h + 0] = bf_lo(c1.x); p1[8 * h + 1] = bf_hi(c1.x); p1[8 * h + 2] = bf_lo(c1.y); p1[8 * h + 3] = bf_hi(c1.y); p1[8 * h + 4] = bf_lo(c1.z); p1[8 * h + 5] = bf_hi(c1.z); p1[8 * h + 6] = bf_lo(c1.w); p1[8 * h + 7] = bf_hi(c1.w);
                p2[8 * h + 0] = bf_lo(c2.x); p2[8 * h + 1] = bf_hi(c2.x); p2[8 * h + 2] = bf_lo(c2.y); p2[8 * h + 3] = bf_hi(c2.y); p2[8 * h + 4] = bf_lo(c2.z); p2[8 * h + 5] = bf_hi(c2.z); p2[8 * h + 6] = bf_lo(c2.w); p2[8 * h + 7] = bf_hi(c2.w); }
        }
#pragma unroll 2
        for (int t = t0; t < t0 + 32; ++t) {
            float y[16]; float mx = 0.f;
#pragma unroll
            for (int h = 0; h < 2; ++h) {
                const size_t o = (size_t)t * D + h * 512 + F.lane * 8;
                const v4u gb = *(const GAS v4u*)(F.B3 + o), pc = *(const GAS v4u*)(F.B4 + o);
                float p[8], gbv[8];
                p[0] = bf_lo(pc.x); p[1] = bf_hi(pc.x); p[2] = bf_lo(pc.y); p[3] = bf_hi(pc.y); p[4] = bf_lo(pc.z); p[5] = bf_hi(pc.z); p[6] = bf_lo(pc.w); p[7] = bf_hi(pc.w);
                gbv[0] = bf_lo(gb.x); gbv[1] = bf_hi(gb.x); gbv[2] = bf_lo(gb.y); gbv[3] = bf_hi(gb.y); gbv[4] = bf_lo(gb.z); gbv[5] = bf_hi(gb.z); gbv[6] = bf_lo(gb.w); gbv[7] = bf_hi(gb.w);
#pragma unroll
                for (int e = 0; e < 8; ++e) { const int k = 8 * h + e; y[k] = gbv[e] * (w0[k] * p2[k] + w1[k] * p1[k] + w2[k] * p[e]); p2[k] = p1[k]; p1[k] = p[e]; mx = fmaxf(mx, fabsf(y[k])); }
            }
            mx = wave_max(mx);
            const float inv = (mx > 0.f) ? 127.0f / mx : 0.f;
            GAS v2u* o8 = (GAS v2u*)((unsigned char*)F.B5 + (size_t)64 * MiB + (size_t)t * D) + F.lane;
            o8[0] = (v2u){pk4_i8(y[0] * inv, y[1] * inv, y[2] * inv, y[3] * inv), pk4_i8(y[4] * inv, y[5] * inv, y[6] * inv, y[7] * inv)};
            o8[64] = (v2u){pk4_i8(y[8] * inv, y[9] * inv, y[10] * inv, y[11] * inv), pk4_i8(y[12] * inv, y[13] * inv, y[14] * inv, y[15] * inv)};
            if (F.lane == 0) F.SH[3 * M + t] = mx * (1.0f / 127.0f);
        }
    }
}

__device__ __forceinline__ void unpack16(const v4u a, const v4u b, float (&v)[16]) {
    v[0] = bf_lo(a.x); v[1] = bf_hi(a.x); v[2] = bf_lo(a.y); v[3] = bf_hi(a.y); v[4] = bf_lo(a.z); v[5] = bf_hi(a.z); v[6] = bf_lo(a.w); v[7] = bf_hi(a.w);
    v[8] = bf_lo(b.x); v[9] = bf_hi(b.x); v[10] = bf_lo(b.y); v[11] = bf_hi(b.y); v[12] = bf_lo(b.z); v[13] = bf_hi(b.z); v[14] = bf_lo(b.w); v[15] = bf_hi(b.w);
}
__device__ __forceinline__ void load16f(const float* p, int lane, float (&v)[16]) {
    const f32x4 a = *(const GAS f32x4*)(p + 8 * lane), b = *(const GAS f32x4*)(p + 8 * lane + 4), c = *(const GAS f32x4*)(p + 512 + 8 * lane), d = *(const GAS f32x4*)(p + 512 + 8 * lane + 4);
    v[0] = a.x; v[1] = a.y; v[2] = a.z; v[3] = a.w; v[4] = b.x; v[5] = b.y; v[6] = b.z; v[7] = b.w; v[8] = c.x; v[9] = c.y; v[10] = c.z; v[11] = c.w; v[12] = d.x; v[13] = d.y; v[14] = d.z; v[15] = d.w;
}
__device__ __forceinline__ void ln16(float (&v)[16]) {
    float s = 0.f;
#pragma unroll
    for (int e = 0; e < 16; ++e) s += v[e];
    const float mean = wave_sum(s) * (1.f / D); float s2 = 0.f;
#pragma unroll
    for (int e = 0; e < 16; ++e) { v[e] -= mean; s2 += v[e] * v[e]; }
    const float rstd = 1.f / sqrtf(wave_sum(s2) * (1.f / D) + LN_EPS);
#pragma unroll
    for (int e = 0; e < 16; ++e) v[e] *= rstd;
}
__device__ __forceinline__ void store16bf(bf16* p, int lane, const float (&v)[16]) {
    v4u a, b; a.x = pk_bf16(v[0], v[1]); a.y = pk_bf16(v[2], v[3]); a.z = pk_bf16(v[4], v[5]); a.w = pk_bf16(v[6], v[7]);
    b.x = pk_bf16(v[8], v[9]); b.y = pk_bf16(v[10], v[11]); b.z = pk_bf16(v[12], v[13]); b.w = pk_bf16(v[14], v[15]);
    ((GAS v4u*)p)[lane] = a; ((GAS v4u*)p)[lane + 64] = b;
}
__device__ __forceinline__ void phase6_panel(Frame& F, const int pm) {
    float g1[16], b1[16];
    load16f(F.ln1_g, F.lane, g1); load16f(F.ln1_b, F.lane, b1);
    {   const int blk = pm * 8 + F.wave;
        const int r0 = blk * 32, b = r0 >> 11;
        float sh[16], sc[16];
        load16f(F.mod + (size_t)b * NMOD + 3072, F.lane, sh); load16f(F.mod + (size_t)b * NMOD + 4096, F.lane, sc);
#pragma unroll 2
        for (int r = 0; r < 32; ++r) {
            const GAS v4u* rr = (const GAS v4u*)(F.Rb + (size_t)(r0 + r) * D);
            float v[16]; unpack16(rr[F.lane], rr[F.lane + 64], v);
            ln16(v);
#pragma unroll
            for (int e = 0; e < 16; ++e) v[e] = v[e] * g1[e] + b1[e];
            ln16(v);
#pragma unroll
            for (int e = 0; e < 16; ++e) v[e] = v[e] * (1.0f + sc[e]) + sh[e];
            float mx = 0.f;
#pragma unroll
            for (int e = 0; e < 16; ++e) mx = fmaxf(mx, fabsf(v[e]));
            mx = wave_max(mx);
            const float inv = (mx > 0.f) ? 127.0f / mx : 0.f;
            GAS v2u* o8 = (GAS v2u*)(F.H2q + (size_t)(r0 + r) * D) + F.lane;
            o8[0] = (v2u){pk4_i8(v[0] * inv, v[1] * inv, v[2] * inv, v[3] * inv), pk4_i8(v[4] * inv, v[5] * inv, v[6] * inv, v[7] * inv)};
            o8[64] = (v2u){pk4_i8(v[8] * inv, v[9] * inv, v[10] * inv, v[11] * inv), pk4_i8(v[12] * inv, v[13] * inv, v[14] * inv, v[15] * inv)};
            if (F.lane == 0) F.SH[M + r0 + r] = mx * (1.0f / 127.0f);
        }
    }
}

#define CE_DESC(a, b) do { const float _x = vmaxf(a, b), _y = vminf(a, b); a = _x; b = _y; } while (0)
template <int N> __device__ __forceinline__ void bitonic_merge_desc(float (&v)[N]) {
#pragma unroll
    for (int j = N / 2; j > 0; j >>= 1) {
#pragma unroll
        for (int i = 0; i < N; ++i) { const int l = i ^ j; if (l > i) CE_DESC(v[i], v[l]); } }
}
template <int N> __device__ __forceinline__ void bitonic_sort_desc(float (&v)[N]) {
#pragma unroll
    for (int k = 2; k <= N; k <<= 1) {
#pragma unroll
        for (int j = k >> 1; j > 0; j >>= 1) {
#pragma unroll
            for (int i = 0; i < N; ++i) { const int l = i ^ j; if (l > i) { if ((i & k) == 0) CE_DESC(v[i], v[l]); else CE_DESC(v[l], v[i]); } } } }
}
__device__ __forceinline__ void top16_merge(float (&a)[16], const float (&b)[16]) {
#pragma unroll
    for (int i = 0; i < 16; ++i) a[i] = vmaxf(a[i], b[15 - i]);
    bitonic_merge_desc<16>(a);
}
__device__ __forceinline__ void top16_merge_lane(float (&a)[16], int mask) {
    float p[16]; const int l = lane_now();
#pragma unroll
    for (int i = 0; i < 16; ++i) p[i] = shx(a[i], mask, l);
    top16_merge(a, p);
}
typedef float f32x16 __attribute__((ext_vector_type(16)));
__device__ __forceinline__ void phase8b_block(Frame& F, size_t T0) {
    float* TOPS = F.TOPS;
    LAS float* scr = (LAS float*)F.lds;
    for (int k4 = 0; k4 < 4; ++k4) {
        const size_t gid = T0 * 8 + (size_t)k4 * 512 + F.tid;
        const GAS f32x4* t1 = (const GAS f32x4*)(TOPS + gid * 32);
        float L1[16], L2[16];
#pragma unroll
        for (int i = 0; i < 4; ++i) { const f32x4 x = t1[i], y = t1[4 + i];
            L1[4 * i] = x.x; L1[4 * i + 1] = x.y; L1[4 * i + 2] = x.z; L1[4 * i + 3] = x.w; L2[4 * i] = y.x; L2[4 * i + 1] = y.y; L2[4 * i + 2] = y.z; L2[4 * i + 3] = y.w; }
#pragma unroll
        for (int i = 0; i < 16; ++i) { scr[i * 512 + F.tid] = L1[i]; scr[(16 + i) * 512 + F.tid] = L2[i]; }
#define P8_CAND(a, b) __uint_as_float((__float_as_uint(L1[a] + L2[b]) & ~0xFFu) | (unsigned)(255 - ((a) * 16 + (b))))
        float top[16], g1[16], g2[16], g3[16];
#pragma unroll
        for (int b = 0; b < 16; ++b) top[b] = P8_CAND(0, b);
        {
            int n = 0;
#pragma unroll
            for (int i = 0; i < 16; ++i) { g1[i] = -__builtin_inff(); g2[i] = -__builtin_inff(); g3[i] = -__builtin_inff(); }
#pragma unroll
            for (int a = 1; a < 16; ++a)
#pragma unroll
                for (int b = 0; b < 16; ++b) if ((a + 1) * (b + 1) <= 16) { const float cv = P8_CAND(a, b);
                    if (n < 16) g1[n] = cv; else if (n < 32) g2[n - 16] = cv; else g3[n - 32] = cv; ++n; }
        }
#undef P8_CAND
        bitonic_sort_desc<16>(g1); bitonic_sort_desc<16>(g2); CE_DESC(g3[0], g3[1]);
        top16_merge(top, g1); top16_merge(top, g2); top16_merge(top, g3);
        float sv[16]; unsigned ex[16]; float mx = -__builtin_inff();
#pragma unroll
        for (int k = 0; k < 16; ++k) { const unsigned code = 255u - (__float_as_uint(top[k]) & 0xFFu); const float f1 = scr[(code >> 4) * 512 + F.tid], f2 = scr[(16 + (code & 15)) * 512 + F.tid];
            const unsigned i1 = 127u - (__float_as_uint(f1) & 0x7Fu), i2 = 127u - (__float_as_uint(f2) & 0x7Fu);
            sv[k] = f1 + f2; ex[k] = i1 * 128u + i2; mx = fmaxf(mx, sv[k]); }
        float den = 0.f;
#pragma unroll
        for (int k = 0; k < 16; ++k) { sv[k] = __builtin_amdgcn_exp2f((sv[k] - mx) * 1.4426950408889634f); den += sv[k]; }
        const float inv = 1.0f / den;
        GAS v4u* sp = (GAS v4u*)(F.sel + gid * 16);
#pragma unroll
        for (int i = 0; i < 4; ++i) { v4u o;
            o.x = (ex[4 * i + 0] << 18) | (__float_as_uint(sv[4 * i + 0] * inv) >> 13); o.y = (ex[4 * i + 1] << 18) | (__float_as_uint(sv[4 * i + 1] * inv) >> 13);
            o.z = (ex[4 * i + 2] << 18) | (__float_as_uint(sv[4 * i + 2] * inv) >> 13); o.w = (ex[4 * i + 3] << 18) | (__float_as_uint(sv[4 * i + 3] * inv) >> 13);
            sp[i] = o; }
    }
}

__device__ __forceinline__ void phase8_panel(Frame& F, const int blk) {
    const int lane = F.lane, c32 = lane & 31, hh = lane >> 5;
    float* TOPS = F.TOPS;
    {
        const size_t T0 = (size_t)blk * 256;
        for (int h = 0; h < 8; ++h) {
            const bf16* Q = ((h < 4) ? F.B1 : F.B2) + (h & 3) * 256;
            __syncthreads();
            {
                v4u kreg[8];
#pragma unroll
                for (int i = 0; i < 8; ++i) { const int q = F.tid + 512 * i; kreg[i] = *(const GAS v4u*)(F.Keys + (size_t)h * 32768 + (size_t)q * 8); }
#pragma unroll
                for (int i = 0; i < 8; ++i) { const int q = F.tid + 512 * i, pp = q >> 11, key = (q >> 4) & 127, c = q & 15;
                    *(LAS v4u*)(F.lds + pp * 32768 + key * 256 + 16 * (c ^ (key & 15))) = kreg[i]; }
            }
            __syncthreads();
            LAS unsigned char* qimg = F.lds + 65536 + F.wave * 8192;
            v4u qn[8];
            { const int tile0 = F.wave >> 1, p0 = F.wave & 1;
#pragma unroll
              for (int i = 0; i < 8; ++i) qn[i] = *(const GAS v4u*)(Q + (T0 + 32 * tile0 + 4 * i + (lane >> 4)) * D + p0 * 128 + 8 * (lane & 15)); }
#pragma unroll 1
            for (int j = 0; j < 2; ++j) {
                const int task = F.wave + 8 * j, tile = task >> 1, p = task & 1;
                const size_t tok = T0 + 32 * tile + c32;
#pragma unroll
                for (int i = 0; i < 8; ++i) { const int row = 4 * i + (lane >> 4); *(LAS v4u*)(qimg + row * 256 + 16 * ((lane & 15) ^ (row & 15))) = qn[i]; }
                if (j == 0) { const int task1 = F.wave + 8, tile1 = task1 >> 1, p1 = task1 & 1;
#pragma unroll
                    for (int i = 0; i < 8; ++i) qn[i] = *(const GAS v4u*)(Q + (T0 + 32 * tile1 + 4 * i + (lane >> 4)) * D + p1 * 128 + 8 * (lane & 15)); }
                bf16x8 bq[8];
#pragma unroll
                for (int ks = 0; ks < 8; ++ks) bq[ks] = *(const LAS bf16x8*)(qimg + c32 * 256 + 16 * ((2 * ks + hh) ^ (c32 & 15)));
#define P8_CHAIN(dst, kt) do { _Pragma("unroll") for (int r = 0; r < 16; ++r) dst[r] = 0.f; \
        _Pragma("unroll") for (int ks = 0; ks < 8; ++ks) { const int key = 32 * (kt) + c32; \
            const bf16x8 ak = *(const LAS bf16x8*)(F.lds + p * 32768 + key * 256 + 16 * ((2 * ks + hh) ^ (key & 15))); \
            dst = __builtin_amdgcn_mfma_f32_32x32x16_bf16(ak, bq[ks], dst, 0, 0, 0); } } while (0)
                float t[16], g[16];
                f32x16 accC, accN;
                unsigned hh4 = 4u * (unsigned)hh; asm volatile("" : "+v"(hh4));
                P8_CHAIN(accC, 0);
#pragma unroll
                for (int kt = 0; kt < 4; ++kt) {
                    if (kt < 3) P8_CHAIN(accN, kt + 1);
#pragma unroll
                    for (int r = 0; r < 16; ++r) { const int key0 = 32 * kt + (r & 3) + 8 * (r >> 2);
                        const unsigned bits = ((__float_as_uint(accC[r]) & ~0x7Fu) | (unsigned)(127 - key0)) - hh4;
                        if (kt == 0) t[r] = __uint_as_float(bits); else g[r] = __uint_as_float(bits); }
                    if (kt == 0) bitonic_sort_desc<16>(t); else { bitonic_sort_desc<16>(g); top16_merge(t, g); }
                    accC = accN;
                }
#undef P8_CHAIN
                top16_merge_lane(t, 32);
                if (hh == 0) { GAS f32x4* tp = (GAS f32x4*)(TOPS + ((tok * 8 + h) * 2 + p) * 16);
#pragma unroll
                    for (int i = 0; i < 4; ++i) tp[i] = (f32x4){t[4 * i], t[4 * i + 1], t[4 * i + 2], t[4 * i + 3]}; }
            }
        }
        asm volatile("s_waitcnt vmcnt(0)" ::: "memory");
        __syncthreads();
        F.lane = lane_now(); F.tid = F.wave * 64 + F.lane;
        phase8b_block(F, T0);
    }
}
constexpr int P9_NT = 8;
constexpr int P9_SRT = 0, P9_CF = 2048, P9_WB = 4096;
constexpr int P9_CH = 8;
template <class T> __device__ __forceinline__ T reduce8(const T (&p)[8], int lane) {
    const bool b5 = (lane & 32) != 0, b4 = (lane & 16) != 0, b3 = (lane & 8) != 0;
    T q[4], r[2], t;
#pragma unroll
    for (int i = 0; i < 4; ++i) { const T keep = b5 ? p[i + 4] : p[i], send = b5 ? p[i] : p[i + 4]; q[i] = keep + shx(send, 32, lane); }
#pragma unroll
    for (int i = 0; i < 2; ++i) { const T keep = b4 ? q[i + 2] : q[i], send = b4 ? q[i] : q[i + 2]; r[i] = keep + shx(send, 16, lane); }
    { const T keep = b3 ? r[1] : r[0], send = b3 ? r[0] : r[1]; t = keep + shx(send, 8, lane); }
    t += shx(t, 4, lane); t += shx(t, 2, lane); t += shx(t, 1, lane);
    return t;
}
__device__ __forceinline__ void p9_issue(const __amdgpu_buffer_rsrc_t rs, const LAS unsigned* srt, int pos, int lane, v4u (&rows)[P9_CH]) {
    const int ro = (int)((srt[pos + (lane & (P9_CH - 1))] >> 18) * 1024u), l16 = lane * 16;
#pragma unroll
    for (int e = 0; e < P9_CH; ++e) rows[e] = __builtin_amdgcn_raw_buffer_load_b128(rs, l16, __builtin_amdgcn_readlane(ro, e), 0);
}
__device__ __forceinline__ void p9_issue_sc(Frame& F, const LAS unsigned* srt, int pos, int lane, unsigned& wg, f32x2& scv) {
    wg = srt[pos + (lane >> 3)];
    scv = *(const GAS f32x2*)(F.SC + 2 * (size_t)(wg >> 18));
}
__device__ __forceinline__ void fp8x16_to_f32(const v4u w, f32x2 (&f)[8]) {
    f[0] = __builtin_amdgcn_cvt_pk_f32_fp8((int)w.x, false); f[1] = __builtin_amdgcn_cvt_pk_f32_fp8((int)w.x, true);
    f[2] = __builtin_amdgcn_cvt_pk_f32_fp8((int)w.y, false); f[3] = __builtin_amdgcn_cvt_pk_f32_fp8((int)w.y, true);
    f[4] = __builtin_amdgcn_cvt_pk_f32_fp8((int)w.z, false); f[5] = __builtin_amdgcn_cvt_pk_f32_fp8((int)w.z, true);
    f[6] = __builtin_amdgcn_cvt_pk_f32_fp8((int)w.w, false); f[7] = __builtin_amdgcn_cvt_pk_f32_fp8((int)w.w, true);
}
__device__ __forceinline__ void p9_compute_u(const v4u (&rows)[P9_CH], const unsigned wg, const f32x2 scv, const v4u xq, const float sx, LAS float* cf, int pos, int lane) {
    int p[P9_CH];
#pragma unroll
    for (int e = 0; e < P9_CH; ++e) { int a = __builtin_amdgcn_sdot4((int)rows[e].x, (int)xq.x, 0, false); a = __builtin_amdgcn_sdot4((int)rows[e].y, (int)xq.y, a, false);
        a = __builtin_amdgcn_sdot4((int)rows[e].z, (int)xq.z, a, false); p[e] = __builtin_amdgcn_sdot4((int)rows[e].w, (int)xq.w, a, false); }
    const float tot = (float)reduce8<int>(p, lane) * (scv.x * sx);
    const float coef = __uint_as_float((wg & 0x3FFFFu) << 13) * gelu_tanh(tot) * scv.y;
    if ((lane & 7) == 0) cf[pos + (lane >> 3)] = coef;
}
__device__ __forceinline__ void p9_compute_v(const v4u (&rows)[P9_CH], f32x2 (&acc)[8], const LAS float* cf, int pos, int lane) {
    const float cl = cf[pos + (lane & (P9_CH - 1))];
#pragma unroll
    for (int e = 0; e < P9_CH; ++e) {
        const float c = __uint_as_float((unsigned)__builtin_amdgcn_readlane((int)__float_as_uint(cl), e));
        f32x2 f[8]; fp8x16_to_f32(rows[e], f);
#pragma unroll
        for (int q = 0; q < 8; ++q) acc[q] += f[q] * c; }
}
#ifdef PROBE_PHASE
#define P9P_START(k) unsigned long long p9t_##k = 0; if ((k) == PROBE_PHASE) p9t_##k = __builtin_amdgcn_s_memrealtime();
#define P9P_END(k) if ((k) == PROBE_PHASE) { const unsigned long long t1 = __builtin_amdgcn_s_memrealtime(), dt = (t1 - p9t_##k) * PROBE_MULT; while (__builtin_amdgcn_s_memrealtime() - t1 < dt) __builtin_amdgcn_s_sleep(8); }
#else
#define P9P_START(k)
#define P9P_END(k)
#endif
constexpr int P9_TU = 16;
__device__ __forceinline__ void phase9(Frame& F, const XcdBarrier& bar) {
    LAS unsigned* srt = (LAS unsigned*)(F.lds + F.wave * 16384);
    LAS float* cf = (LAS float*)(F.lds + F.wave * 16384 + 8192);
    LAS float* sxl = (LAS float*)(F.lds + 131072 + F.wave * 64);
    const __amdgpu_buffer_rsrc_t rsU = __builtin_amdgcn_make_buffer_rsrc((void*)F.EU8, 0, NE * D, 0x00020000);
    const __amdgpu_buffer_rsrc_t rsV = __builtin_amdgcn_make_buffer_rsrc((void*)F.EV8, 0, NE * D, 0x00020000);
    constexpr int NJ = 128 / P9_CH;
    for (int blk = blockIdx.x; blk < M / 128; blk += F.G) {
#ifdef P9_ROUND_BARRIER
        if (MK_N_LAUNCHES == 1 && blk != (int)blockIdx.x && (M / 128) % F.G == 0) xcd_barrier(bar);
#endif
        P9P_START(90)
        int lane; asm volatile("v_mbcnt_lo_u32_b32 %0, -1, 0\n\tv_mbcnt_hi_u32_b32 %0, -1, %0" : "=v"(lane));
        const unsigned long long lt_mask = (1ull << lane) - 1ull;
        const size_t tb = (size_t)blk * 128 + F.wave * P9_TU;
        for (int t = 0; t < P9_TU; ++t) {
            const unsigned w0 = F.sel[(tb + t) * 128 + lane], w1 = F.sel[(tb + t) * 128 + 64 + lane];
            const unsigned b0 = w0 >> 28, b1 = w1 >> 28;
            unsigned base = 0, pos0 = 0, pos1 = 0;
#pragma unroll
            for (unsigned b = 0; b < 16u; ++b) {
                const unsigned long long m0 = __ballot(b0 == b), m1 = __ballot(b1 == b);
                const unsigned c0 = (unsigned)__popcll(m0), c1 = (unsigned)__popcll(m1);
                if (b0 == b) pos0 = base + (unsigned)__popcll(m0 & lt_mask);
                if (b1 == b) pos1 = base + c0 + (unsigned)__popcll(m1 & lt_mask);
                base += c0 + c1;
            }
            srt[t * 128 + pos0] = w0; srt[t * 128 + pos1] = w1;
        }
        v4u xq[P9_TU];
#pragma unroll
        for (int t = 0; t < P9_TU; ++t) xq[t] = *((const GAS v4u*)(F.H2q + (tb + t) * D) + lane);
        if (lane < P9_TU) sxl[lane] = F.SH[M + tb + lane];
        P9P_END(90)
        P9P_START(91)
        {
            v4u r0[P9_CH], r1[P9_CH]; unsigned w0_, w1_; f32x2 s0, s1;
            p9_issue_sc(F, srt, 0, lane, w0_, s0); p9_issue(rsU, srt, 0, lane, r0);
            for (int j = 0; j < NJ; ++j) {
                __builtin_amdgcn_s_barrier();
                const int pj = P9_CH * j, pn = P9_CH * ((j < NJ - 1) ? j + 1 : NJ - 1);
#define P9_USTEP(t, RI, WI, SI, RC, WC, SC_) { const int ti = (t) + 1; const int ip = (ti < P9_TU) ? (ti * 128 + pj) : ((ti - P9_TU) * 128 + pn); \
                    p9_issue_sc(F, srt, ip, lane, WI, SI); p9_issue(rsU, srt, ip, lane, RI); p9_compute_u(RC, WC, SC_, xq[t], sxl[t], cf, (t) * 128 + pj, lane); }
                P9_USTEP(0, r1, w1_, s1, r0, w0_, s0)  P9_USTEP(1, r0, w0_, s0, r1, w1_, s1)  P9_USTEP(2, r1, w1_, s1, r0, w0_, s0)  P9_USTEP(3, r0, w0_, s0, r1, w1_, s1)
                P9_USTEP(4, r1, w1_, s1, r0, w0_, s0)  P9_USTEP(5, r0, w0_, s0, r1, w1_, s1)  P9_USTEP(6, r1, w1_, s1, r0, w0_, s0)  P9_USTEP(7, r0, w0_, s0, r1, w1_, s1)
                P9_USTEP(8, r1, w1_, s1, r0, w0_, s0)  P9_USTEP(9, r0, w0_, s0, r1, w1_, s1)  P9_USTEP(10, r1, w1_, s1, r0, w0_, s0) P9_USTEP(11, r0, w0_, s0, r1, w1_, s1)
                P9_USTEP(12, r1, w1_, s1, r0, w0_, s0) P9_USTEP(13, r0, w0_, s0, r1, w1_, s1) P9_USTEP(14, r1, w1_, s1, r0, w0_, s0) P9_USTEP(15, r0, w0_, s0, r1, w1_, s1)
#undef P9_USTEP
            }
        }
        P9P_END(91)
        for (int sub = 0; sub < P9_TU / P9_NT; ++sub) {
            P9P_START(92)
            const LAS unsigned* srs = srt + sub * (P9_NT * 128); const LAS float* cfs = cf + sub * (P9_NT * 128);
            f32x2 acc[P9_NT][8];
#pragma unroll
            for (int tt = 0; tt < P9_NT; ++tt)
#pragma unroll
                for (int q = 0; q < 8; ++q) acc[tt][q] = (f32x2){0.f, 0.f};
            {
                v4u r0[P9_CH], r1[P9_CH];
                p9_issue(rsV, srs, 0, lane, r0);
                for (int j = 0; j < NJ; ++j) {
                    __builtin_amdgcn_s_barrier();
                    const int pj = P9_CH * j, pn = P9_CH * ((j < NJ - 1) ? j + 1 : NJ - 1);
                    p9_issue(rsV, srs, 128 + pj, lane, r1); p9_compute_v(r0, acc[0], cfs, pj, lane);
                    p9_issue(rsV, srs, 256 + pj, lane, r0); p9_compute_v(r1, acc[1], cfs, 128 + pj, lane);
                    p9_issue(rsV, srs, 384 + pj, lane, r1); p9_compute_v(r0, acc[2], cfs, 256 + pj, lane);
                    p9_issue(rsV, srs, 512 + pj, lane, r0); p9_compute_v(r1, acc[3], cfs, 384 + pj, lane);
                    p9_issue(rsV, srs, 640 + pj, lane, r1); p9_compute_v(r0, acc[4], cfs, 512 + pj, lane);
                    p9_issue(rsV, srs, 768 + pj, lane, r0); p9_compute_v(r1, acc[5], cfs, 640 + pj, lane);
                    p9_issue(rsV, srs, 896 + pj, lane, r1); p9_compute_v(r0, acc[6], cfs, 768 + pj, lane);
                    p9_issue(rsV, srs, pn, lane, r0);       p9_compute_v(r1, acc[7], cfs, 896 + pj, lane);
                }
            }
            P9P_END(92)
            P9P_START(93)
            {
                const size_t tb4 = tb + (size_t)sub * P9_NT;
                const int b = (int)(tb4 >> 11);
                float g2[16], l2g[16], l2b[16];
                {
                    const GAS f32x4* pg = (const GAS f32x4*)(F.mod + (size_t)b * NMOD + 5120) + 4 * lane; const GAS f32x4* pl = (const GAS f32x4*)F.ln2_g + 4 * lane; const GAS f32x4* pb = (const GAS f32x4*)F.ln2_b + 4 * lane;
#pragma unroll
                    for (int i = 0; i < 4; ++i) { const f32x4 a = pg[i], c = pl[i], e = pb[i];
                        g2[4 * i] = a.x; g2[4 * i + 1] = a.y; g2[4 * i + 2] = a.z; g2[4 * i + 3] = a.w; l2g[4 * i] = c.x; l2g[4 * i + 1] = c.y; l2g[4 * i + 2] = c.z; l2g[4 * i + 3] = c.w;
                        l2b[4 * i] = e.x; l2b[4 * i + 1] = e.y; l2b[4 * i + 2] = e.z; l2b[4 * i + 3] = e.w; }
                }
#pragma unroll
                for (int tt = 0; tt < P9_NT; ++tt) {
                    const size_t tok = tb4 + tt;
                    const GAS v4u* xr = (const GAS v4u*)(F.Rb + tok * D) + 2 * lane;
                    float y[16]; unpack16(xr[0], xr[1], y);
                    ln16(y);
                    {
                        const GAS f32x4* p1g = (const GAS f32x4*)F.ln1_g + 4 * lane; const GAS f32x4* p1b = (const GAS f32x4*)F.ln1_b + 4 * lane;
#pragma unroll
                        for (int i = 0; i < 4; ++i) { const f32x4 gg = p1g[i], bb = p1b[i];
                            y[4 * i] = y[4 * i] * gg.x + bb.x; y[4 * i + 1] = y[4 * i + 1] * gg.y + bb.y; y[4 * i + 2] = y[4 * i + 2] * gg.z + bb.z; y[4 * i + 3] = y[4 * i + 3] * gg.w + bb.w; }
                    }
#pragma unroll
                    for (int e = 0; e < 8; ++e) { y[2 * e] = ALPHA * y[2 * e] + g2[2 * e] * acc[tt][e].x; y[2 * e + 1] = ALPHA * y[2 * e + 1] + g2[2 * e + 1] * acc[tt][e].y; }
                    ln16(y);
#pragma unroll
                    for (int e = 0; e < 16; ++e) y[e] = y[e] * l2g[e] + l2b[e];
                    GAS f32x4* op = (GAS f32x4*)(F.out + tok * D) + 4 * lane;
                    op[0] = (f32x4){y[0], y[1], y[2], y[3]}; op[1] = (f32x4){y[4], y[5], y[6], y[7]}; op[2] = (f32x4){y[8], y[9], y[10], y[11]}; op[3] = (f32x4){y[12], y[13], y[14], y[15]};
                }
            }
            P9P_END(93)
        }
    }
}

struct Args { const float* in[21]; float* out; unsigned char* ws; int ph_lo, ph_hi, li, pad; };
__global__ void __launch_bounds__(512, 2) fwd(Args args) {
    extern __shared__ __attribute__((aligned(16))) unsigned char lds[];
    Frame F;
    F.lds = (LAS unsigned char*)lds;
    volatile LAS unsigned* MISC = (volatile LAS unsigned*)(F.lds + MISC_OFF);
    F.tid = threadIdx.x; F.lane = F.tid & 63; F.wave = __builtin_amdgcn_readfirstlane(F.tid >> 6);
    F.G = gridDim.x; F.gw = blockIdx.x * 8 + F.wave; F.NGW = F.G * 8;
    unsigned char* ws = args.ws;
    gu32* ctl = (gu32*)(ws + WS_CTL);
    F.x = args.in[0]; F.c = args.in[1]; F.w_cond = args.in[2]; F.b_cond = args.in[3]; F.w_in = args.in[4]; F.gln_g = args.in[5]; F.gln_b = args.in[6];
    F.w_sp = args.in[7]; F.b_sp = args.in[8]; F.conv_w = args.in[9]; F.p_a = args.in[10]; F.p_b = args.in[11]; F.w_o = args.in[12]; F.ln1_g = args.in[13]; F.ln1_b = args.in[14];
    F.w_q = args.in[15]; F.keys = args.in[16]; F.eu = args.in[17]; F.ev = args.in[18]; F.ln2_g = args.in[19]; F.ln2_b = args.in[20];
    F.out = args.out; F.mod = (float*)(ws + WS_MOD);
    F.Win_t = (bf16*)(ws + WS_WIN); F.Pa_t = (bf16*)(ws + WS_PA); F.Pb_t = (bf16*)(ws + WS_PB); F.Wo_t = (bf16*)(ws + WS_WO); F.Wq_t = (bf16*)(ws + WS_WQ);
    F.Keys = (bf16*)(ws + WS_KEYS); F.Wsp = (bf16*)(ws + WS_WSP); F.EU = (bf16*)(ws + WS_EU); F.EV = (bf16*)(ws + WS_EV); F.sel = (unsigned*)(ws + WS_SEL); F.zrow = (const bf16*)(ws + WS_CTL + 512 * 1024); F.EU8 = ws + WS_EU; F.EV8 = ws + WS_EV; F.SC = (float*)(ws + 28 * MiB); F.ST = (float*)(ws + 48 * MiB);
    F.CM = (unsigned*)(ws + WS_CM); F.SW = (float*)(ws + WS_SW); F.SH = (float*)(ws + WS_SH);
    F.H = (bf16*)args.out;
    F.TOPS = (float*)args.out; F.M8 = (unsigned char*)args.out + (size_t)64 * MiB;
    F.Rb = (bf16*)(ws + 3 * WS_U); F.H2q = ws + 5 * WS_U;
    F.B1 = (bf16*)(ws + 1 * WS_U); F.B2 = (bf16*)(ws + 2 * WS_U); F.B3 = (bf16*)(ws + 3 * WS_U); F.B4 = (bf16*)(ws + 4 * WS_U); F.B5 = (bf16*)(ws + 5 * WS_U); F.B6 = (bf16*)(ws + 6 * WS_U);
    for (int u = F.tid; u < (LDS_BYTES - LDSCTL_OFF) / 4; u += 512) ((LAS unsigned*)(F.lds + LDSCTL_OFF))[u] = 0u;
    __syncthreads();
    XcdBarrier bar; bar.bar = (unsigned*)(ctl + CW_BAR); bar.x = 0; bar.st = nullptr; bar.wave = F.wave;
    if (MK_N_LAUNCHES == 1) bar = xcd_barrier_post((unsigned*)(ctl + CW_BAR), MISC + 8, F.wave);
    const int lo = args.ph_lo, hi = args.ph_hi;
#define IN(k) (lo <= (k) && (k) < hi)
#ifdef PROBE_PHASE
    unsigned long long pr_t0 = 0;
#define PSTART(k) do { if ((k) == PROBE_PHASE) pr_t0 = __builtin_amdgcn_s_memrealtime(); } while (0)
#define PEND(k) do { if ((k) == PROBE_PHASE) { const unsigned long long t1 = __builtin_amdgcn_s_memrealtime(), dt = (t1 - pr_t0) * PROBE_MULT; while (__builtin_amdgcn_s_memrealtime() - t1 < dt) __builtin_amdgcn_s_sleep(8); } } while (0)
#else
#define PSTART(k) do {} while (0)
#define PEND(k) do {} while (0)
#endif
#define SEAM(k) do { PEND(k); if (IN(k) && IN((k) + 1)) xcd_barrier(bar); PSTART((k) + 1); } while (0)

    PSTART(0);
    if (IN(0)) { phase0(F); SEAM(0); }
    if (IN(1)) { phase1(F); SEAM(1); }
    if (IN(2)) {
        pg8::Gemm g{F.H, F.Win_t, nullptr, nullptr, M, NIN, D}; pg8::StaticOrder S; S.init(M, NIN, F.G, (int)blockIdx.x);
        pg8::EpiProj E{F.B1, F.ST, F.SH, F.SW};
        pg8::gemm_phase<pg8::EpiProj, pg8::StaticOrder, true, true, 2>(F.lds, g, S, E, F.wave);
        SEAM(2);
    }
    if (IN(3)) {
        LAS unsigned* RM = (LAS unsigned*)(F.lds + 131072);
        float* SHm = (float*)((unsigned char*)F.SH + MiB);
#define OPQ() do { F.lane = lane_now(); F.tid = F.wave * 64 + F.lane; } while (0)
        for (int pm = blockIdx.x; pm < M / 256; pm += F.G) {
            OPQ();
            phase3_panel(F, pm);
            asm volatile("s_waitcnt vmcnt(0)" ::: "memory");
            __syncthreads();
            PEND(3); PSTART(4); OPQ();
            if (F.tid < 256) RM[F.tid] = 0u;
            __syncthreads();
            {   pg8::Gemm g{F.B5, F.Pa_t, (const pg8::bf16_t*)((const unsigned char*)F.B5 + (size_t)64 * MiB), F.Pb_t, M, D, D}; pg8::PanelDual S{pm};
                pg8::EpiDual E{F.B2, F.B6, F.B6 + SEG, F.SH + 2 * M, F.SW + 10240, RM};
                pg8::gemm_phase<pg8::EpiDual, pg8::PanelDual, true, true, 2>(F.lds, g, S, E, F.wave); }
            __syncthreads();
#pragma unroll 4
            for (int r = 0; r < 32; ++r) {
                const int pr = 32 * F.wave + r; const size_t row = (size_t)pm * 256 + pr;
                const float mx = __uint_as_float(RM[pr]), inv = (mx > 0.f) ? 127.0f / mx : 0.f;
                const GAS v4u* mp = (const GAS v4u*)(F.B2 + row * D) + F.lane;
                const v4u a = mp[0], b = mp[64];
                GAS v2u* o8 = (GAS v2u*)(F.M8 + row * D) + F.lane;
                o8[0] = (v2u){pk4_i8(bf_lo(a.x) * inv, bf_hi(a.x) * inv, bf_lo(a.y) * inv, bf_hi(a.y) * inv), pk4_i8(bf_lo(a.z) * inv, bf_hi(a.z) * inv, bf_lo(a.w) * inv, bf_hi(a.w) * inv)};
                o8[64] = (v2u){pk4_i8(bf_lo(b.x) * inv, bf_hi(b.x) * inv, bf_lo(b.y) * inv, bf_hi(b.y) * inv), pk4_i8(bf_lo(b.z) * inv, bf_hi(b.z) * inv, bf_lo(b.w) * inv, bf_hi(b.w) * inv)};
                if (F.lane == 0) SHm[row] = mx * (1.0f / 127.0f);
            }
            asm volatile("s_waitcnt vmcnt(0)" ::: "memory");
            __syncthreads();
            PEND(4); PSTART(5); OPQ();
            {   pg8::Gemm g{(const pg8::bf16_t*)F.M8, F.Wo_t, nullptr, nullptr, M, D, D}; pg8::PanelOrder S{pm, 4};
                pg8::EpiRes E{F.Rb, F.x, F.mod, SHm, F.SW + 12288};
                pg8::gemm_phase<pg8::EpiRes, pg8::PanelOrder, true, true, 2>(F.lds, g, S, E, F.wave); }
            __syncthreads();
            PEND(5); PSTART(6); OPQ();
            phase6_panel(F, pm);
            asm volatile("s_waitcnt vmcnt(0)" ::: "memory");
            __syncthreads();
            PEND(6); PSTART(7); OPQ();
            {   pg8::Gemm g{(const pg8::bf16_t*)F.H2q, F.Wq_t, nullptr, nullptr, M, NQ, D}; pg8::PanelOrder S{pm, 8};
                pg8::EpiPlainI8 E{F.B1, F.B2, D, F.SH + M, F.SW + 8192};
                pg8::gemm_phase<pg8::EpiPlainI8, pg8::PanelOrder, true, true, 2>(F.lds, g, S, E, F.wave); }
            __syncthreads();
            PEND(7); PSTART(8); OPQ();
            phase8_panel(F, pm);
            __syncthreads();
            PEND(8); PSTART(3);
        }
        if (IN(8) && IN(9)) xcd_barrier(bar);
        PSTART(9);
    }
    if (IN(9)) { OPQ(); phase9(F, bar); PEND(9); }
#undef IN
#undef SEAM
}

extern "C" void kernel_launch(void* const* d_in, const int* in_sizes, int n_in, void* d_out, int out_size, void* d_ws, size_t ws_size, hipStream_t stream) {
    static int grid = 0;
    if (grid == 0) {
        if (n_in != 21 || in_sizes[0] != M * D || out_size != M * D || ws_size < WS_END) { fprintf(stderr, "kernel_launch: unexpected shapes (n_in %d, in0 %d, out %d, ws %zu); nothing launched\n", n_in, n_in > 0 ? in_sizes[0] : -1, out_size, ws_size); grid = -1; return; }
        int dev = 0, cus = 0, per_cu = 0;
        if (hipGetDevice(&dev) != hipSuccess || hipDeviceGetAttribute(&cus, hipDeviceAttributeMultiprocessorCount, dev) != hipSuccess) { grid = -1; return; }
        if (hipFuncSetAttribute((const void*)fwd, hipFuncAttributeMaxDynamicSharedMemorySize, LDS_BYTES) != hipSuccess) { fprintf(stderr, "kernel_launch: hipFuncSetAttribute failed\n"); grid = -1; return; }
        if (hipOccupancyMaxActiveBlocksPerMultiprocessor(&per_cu, (const void*)fwd, 512, LDS_BYTES) != hipSuccess || per_cu < 1) { fprintf(stderr, "kernel_launch: occupancy query reports %d workgroups per CU\n", per_cu); }
        (void)hipGetLastError();
        grid = cus;
    }
    if (grid < 0) return;
    if (hipMemsetAsync((char*)d_ws + WS_CTL, 0, CTL_ZERO_BYTES, stream) != hipSuccess) return;
    Args a{};
    for (int i = 0; i < 21; ++i) a.in[i] = (const float*)d_in[i];
    a.out = (float*)d_out; a.ws = (unsigned char*)d_ws;
    for (int li = 0; li < MK_N_LAUNCHES; ++li) {
        a.ph_lo = (MK_N_LAUNCHES == 1) ? 0 : li; a.ph_hi = (MK_N_LAUNCHES == 1) ? NPHASE : li + 1; a.li = li;
        hipLaunchKernelGGL(fwd, dim3(grid), dim3(512), LDS_BYTES, stream, a);
    }
}
```

```cpp
#include <hip/hip_runtime.h>
#include <cstdio>
#include <cstdint>

#define P9_ROUND_BARRIER 1
#ifndef MK_N_LAUNCHES
#define MK_N_LAUNCHES 1
#endif

#define GAS __attribute__((address_space(1)))
#define LAS __attribute__((address_space(3)))
#define PG8_LAS __attribute__((address_space(3)))
typedef unsigned short bf16;
typedef unsigned v4u __attribute__((ext_vector_type(4)));
typedef unsigned v2u __attribute__((ext_vector_type(2)));
typedef float f32x4 __attribute__((ext_vector_type(4)));
typedef float f32x2 __attribute__((ext_vector_type(2)));
typedef short bf16x8 __attribute__((ext_vector_type(8)));
typedef short s16x4 __attribute__((ext_vector_type(4)));
typedef __bf16 bf16x2 __attribute__((ext_vector_type(2)));
typedef GAS unsigned gu32;

constexpr int D = 1024, BATCH = 32, SEQ = 2048, M = BATCH * SEQ;
constexpr int NIN = 7168, NQ = 2048, NE = 16384, NMOD = 6144;
constexpr float LN_EPS = 1e-5f, ALPHA = 1.189207115002721f;
constexpr int NPHASE = 10;

constexpr size_t MiB = 1u << 20;
constexpr size_t WS_CTL = 0, CTL_ZERO_BYTES = 1 * MiB;
constexpr size_t WS_MOD = 1 * MiB;
constexpr size_t WS_WIN = 2 * MiB, WS_PA = 16 * MiB, WS_PB = 18 * MiB, WS_WO = 20 * MiB, WS_WQ = 22 * MiB, WS_KEYS = 26 * MiB, WS_WSP = 26 * MiB + 512 * 1024;
constexpr size_t WS_CM = WS_CTL + 768 * 1024;
constexpr size_t WS_SW = 29 * MiB, WS_SH = 30 * MiB;
constexpr size_t WS_EU = 32 * MiB, WS_EV = 64 * MiB, WS_SEL = 96 * MiB;
constexpr size_t WS_U = 128 * MiB;
constexpr size_t WS_END = 1024 * MiB;
constexpr size_t SEG = (size_t)M * D;
constexpr int CW_TMO = 0, CW_BAR = 4096;

constexpr int RING_BYTES = 131072;
constexpr int LDSCTL_OFF = 155648, MISC_OFF = LDSCTL_OFF + 320;
constexpr int LDS_BYTES = 156672;

__device__ __forceinline__ int lane_now() { int l; asm volatile("v_mbcnt_lo_u32_b32 %0, -1, 0\n\tv_mbcnt_hi_u32_b32 %0, -1, %0" : "=v"(l)); return l; }
__device__ __forceinline__ float bf_lo(unsigned w) { return __uint_as_float(w << 16); }
__device__ __forceinline__ float bf_hi(unsigned w) { return __uint_as_float(w & 0xffff0000u); }
__device__ __forceinline__ unsigned pk_bf16(float lo, float hi) { unsigned r; asm("v_cvt_pk_bf16_f32 %0, %1, %2" : "=v"(r) : "v"(lo), "v"(hi)); return r; }
__device__ __forceinline__ float vmaxf(float a, float b) { float r; asm("v_max_f32 %0, %1, %2" : "=v"(r) : "v"(a), "v"(b)); return r; }
__device__ __forceinline__ float vminf(float a, float b) { float r; asm("v_min_f32 %0, %1, %2" : "=v"(r) : "v"(a), "v"(b)); return r; }
__device__ __forceinline__ float gelu_tanh(float x) {
    const float u = x * (1.5957691216057308f + 0.07135481627260025f * x * x);
    return x * __builtin_amdgcn_rcpf(1.0f + __builtin_amdgcn_exp2f(-1.4426950408889634f * u));
}
__device__ __forceinline__ float sigmoidf_(float x) { return __builtin_amdgcn_rcpf(1.0f + __builtin_amdgcn_exp2f(-1.4426950408889634f * x)); }
__device__ __forceinline__ float shx(float v, int m) { const int l = lane_now(); return __builtin_bit_cast(float, __builtin_amdgcn_ds_bpermute((l ^ m) << 2, __builtin_bit_cast(int, v))); }
__device__ __forceinline__ float shx(float v, int m, int l) { return __builtin_bit_cast(float, __builtin_amdgcn_ds_bpermute((l ^ m) << 2, __builtin_bit_cast(int, v))); }
__device__ __forceinline__ int shx(int v, int m, int l) { return __builtin_amdgcn_ds_bpermute((l ^ m) << 2, v); }
#define WS_DPP(v, ctrl) __builtin_bit_cast(float, __builtin_amdgcn_update_dpp(0, __builtin_bit_cast(int, v), ctrl, 0xF, 0xF, false))
__device__ __forceinline__ float wave_sum(float v) {
    v += WS_DPP(v, 0xB1); v += WS_DPP(v, 0x4E); v += WS_DPP(v, 0x141); v += WS_DPP(v, 0x140);
    const int b = __builtin_bit_cast(int, v);
    const float r0 = __builtin_bit_cast(float, __builtin_amdgcn_readlane(b, 0)), r1 = __builtin_bit_cast(float, __builtin_amdgcn_readlane(b, 16));
    const float r2 = __builtin_bit_cast(float, __builtin_amdgcn_readlane(b, 32)), r3 = __builtin_bit_cast(float, __builtin_amdgcn_readlane(b, 48));
    return (r0 + r1) + (r2 + r3);
}
__device__ __forceinline__ float wave_max(float v) {
    v = fmaxf(v, WS_DPP(v, 0xB1)); v = fmaxf(v, WS_DPP(v, 0x4E)); v = fmaxf(v, WS_DPP(v, 0x141)); v = fmaxf(v, WS_DPP(v, 0x140));
    const int b = __builtin_bit_cast(int, v);
    const float r0 = __builtin_bit_cast(float, __builtin_amdgcn_readlane(b, 0)), r1 = __builtin_bit_cast(float, __builtin_amdgcn_readlane(b, 16));
    const float r2 = __builtin_bit_cast(float, __builtin_amdgcn_readlane(b, 32)), r3 = __builtin_bit_cast(float, __builtin_amdgcn_readlane(b, 48));
    return fmaxf(fmaxf(r0, r1), fmaxf(r2, r3));
}
__device__ __forceinline__ unsigned pk4_i8(float a, float b, float c, float d) {
    const unsigned q0 = (unsigned)__float2int_rn(a) & 0xFFu, q1 = (unsigned)__float2int_rn(b) & 0xFFu, q2 = (unsigned)__float2int_rn(c) & 0xFFu, q3 = (unsigned)__float2int_rn(d);
    return q0 | (q1 << 8) | (q2 << 16) | (q3 << 24);
}
__device__ __forceinline__ float dot2_bf16(unsigned w, unsigned x, float acc) { return __builtin_amdgcn_fdot2_f32_bf16(__builtin_bit_cast(bf16x2, w), __builtin_bit_cast(bf16x2, x), acc, false); }
#define LDS_WAIT() asm volatile("s_waitcnt lgkmcnt(0)" ::: "memory")

namespace pg8 {
typedef unsigned short bf16_t;
typedef unsigned u32x4 __attribute__((ext_vector_type(4)));
constexpr int BM = 256, BK = 64, HALF = 128, HTB = HALF * BK * 2, STAGE_BYTES = 8 * HTB, NXCD = 8, WGM = 8;
__host__ __device__ __forceinline__ int lds_byte(int r, int c) { const int st = (r >> 4) * 2 + (c >> 5), rr = r & 15, cc = c & 31, ob = rr * 64 + cc * 2; return st * 1024 + (ob ^ (((ob >> 9) & 1) << 5)); }
__host__ __device__ __forceinline__ void stage_rc(int b, int& R, int& C) { const int st = b / 1024, sb = b % 1024, swz = sb ^ (((sb >> 9) & 1) << 5); R = (st >> 1) * 16 + swz / 64; C = (st & 1) * 32 + (swz % 64) / 2; }
__host__ __device__ __forceinline__ int perm32(int rho) { const int n = rho >> 4, i = rho & 15; return 8 * (i >> 2) + 4 * n + (i & 3); }

struct Unit { int pm, pn, z; };
struct Gemm { const bf16_t* A; const bf16_t* Bt; const bf16_t* A2; const bf16_t* Bt2; int M, N, K; };

__host__ __device__ __forceinline__ void tile_of(int wgid, int nwg, int nM, int nN, Unit& u) {
    { const int q = nwg / NXCD, r = nwg % NXCD, xcd = wgid % NXCD, off = wgid / NXCD; wgid = (xcd < r ? xcd * (q + 1) : r * (q + 1) + (xcd - r) * q) + off; }
    const int nig = WGM * nN, gid = wgid / nig, fm = gid * WGM, gsz = (nM - fm) < WGM ? (nM - fm) : WGM;
    u.pm = fm + ((wgid % nig) % gsz); u.pn = (wgid % nig) / gsz;
}
struct StaticOrder {
    int nM, nN, nwg, G, c;
    __host__ __device__ void init(int M_, int N_, int G_, int c_) { nM = M_ / BM; nN = N_ / BM; nwg = nM * nN; G = G_; c = c_; }
    __host__ __device__ bool next(int i, Unit& u) const {
        const long L = (long)i * G + c; if (L >= nwg) return false;
        tile_of((int)L, nwg, nM, nN, u); u.z = 0; return true;
    }
    __device__ __forceinline__ void a_ready(const Unit&) const {}
    __device__ __forceinline__ void done(const Unit&) const {}
};
struct RowOrder {
    int nM, nN, G, c;
    __host__ __device__ void init(int M_, int N_, int G_, int c_) { nM = M_ / BM; nN = N_ / BM; G = G_; c = c_; }
    __host__ __device__ bool next(int i, Unit& u) const { const int pm = c + G * (i / nN); if (pm >= nM) return false; u.pm = pm; u.pn = i % nN; u.z = 0; return true; }
    __device__ __forceinline__ void a_ready(const Unit&) const {}
    __device__ __forceinline__ void done(const Unit&) const {}
};
struct DualOrder {
    int nM, nN, nwg, G, c;
    __host__ __device__ void init(int M_, int N_, int G_, int c_) { nM = M_ / BM; nN = N_ / BM; nwg = nM * nN; G = G_; c = c_; }
    __host__ __device__ bool next(int i, Unit& u) const {
        const long L = (long)(i >> 1) * G + c; if (L >= nwg) return false;
        tile_of((int)L, nwg, nM, nN, u); u.z = i & 1; return true;
    }
    __device__ __forceinline__ void a_ready(const Unit&) const {}
    __device__ __forceinline__ void done(const Unit&) const {}
};

typedef int v8i_t __attribute__((ext_vector_type(8)));
typedef int v4i_t __attribute__((ext_vector_type(4)));
__device__ __forceinline__ v8i_t cat8(bf16x8 a, bf16x8 b) { return __builtin_shufflevector(__builtin_bit_cast(v4i_t, a), __builtin_bit_cast(v4i_t, b), 0, 1, 2, 3, 4, 5, 6, 7); }
struct PanelDual {
    int pm;
    __host__ __device__ bool next(int i, Unit& u) const { if (i >= 8) return false; u.pm = pm; u.pn = i >> 1; u.z = i & 1; return true; }
    __device__ __forceinline__ void a_ready(const Unit&) const {}
    __device__ __forceinline__ void done(const Unit&) const {}
};
struct PanelOrder {
    int pm, nN;
    __host__ __device__ bool next(int i, Unit& u) const { if (i >= nN) return false; u.pm = pm; u.pn = i; u.z = 0; return true; }
    __device__ __forceinline__ void a_ready(const Unit&) const {}
    __device__ __forceinline__ void done(const Unit&) const {}
};
template <class Epi, class Sched, bool ALIGN_EPI = false, bool SP2 = false, int MODE = 0>
__device__ __forceinline__ void gemm_phase(PG8_LAS unsigned char* lds, const Gemm g, const Sched& S, const Epi& E, const int wid) {
    const int lane = lane_now(), tid = wid * 64 + lane, wr = wid >> 2, wc = wid & 3, fr = lane & 15, fq = lane >> 4;
    constexpr bool FP8 = (MODE == 1); constexpr int ES = MODE ? 1 : 2;
    const int K = g.K, nt = K * ES / (BK * 2);
    unsigned voffA[2], voffB[2];
#pragma unroll
    for (int i = 0; i < 2; ++i) { int R, C; stage_rc(tid * 16 + i * 8192, R, C); const int Rb = Epi::PERM ? ((R & ~31) + perm32(R & 31)) : R;
        voffA[i] = (unsigned)(R * K * ES + C * 2); voffB[i] = (unsigned)(Rb * K * ES + C * 2); }
    const size_t kstep = (size_t)(BK * 2);
    const size_t hstep = (size_t)HALF * K * ES;
    const size_t tstep = 2 * hstep;
    const unsigned ldsw = (unsigned)wid * 1024u;
    const int aoff = lds_byte(wr * 64 + fr, fq * 8), boff = lds_byte(wc * 32 + fr, fq * 8);
#define PG8_SA(b, h) (((b) * 2 + (h)) * HTB)
#define PG8_SB(b, h) ((4 + (b) * 2 + (h)) * HTB)
#define PG8_STAGE(bufoff, gbase, voff) do { _Pragma("unroll") for (int _i = 0; _i < 2; ++_i) { unsigned _v = (voff)[_i]; asm volatile("" : "+v"(_v));   \
        __builtin_amdgcn_global_load_lds((const unsigned*)((const char*)(gbase) + _v), (PG8_LAS unsigned*)(lds + (bufoff) + ldsw + _i * 8192), 16, 0, 0); } } while (0)
#define PG8_LDA(dst, b, h) do { _Pragma("unroll") for (int m = 0; m < 4; ++m) _Pragma("unroll") for (int k = 0; k < 2; ++k) dst[m][k] = *(const PG8_LAS bf16x8*)(lds + PG8_SA(b, h) + aoff + m * 2048 + k * 1024); } while (0)
#define PG8_LDB(dst, b, h) do { _Pragma("unroll") for (int n = 0; n < 2; ++n) _Pragma("unroll") for (int k = 0; k < 2; ++k) dst[n][k] = *(const PG8_LAS bf16x8*)(lds + PG8_SB(b, h) + boff + n * 2048 + k * 1024); } while (0)
#define PG8_MMA(ai, bj, At, Bt) do { __builtin_amdgcn_s_setprio(1); \
        if constexpr (FP8) { _Pragma("unroll") for (int m = 0; m < 4; ++m) _Pragma("unroll") for (int n = 0; n < 2; ++n) \
            asm volatile("v_mfma_f32_16x16x128_f8f6f4 %0, %1, %2, %0" : "+v"(acc[ai][bj][m][n]) : "v"(cat8(Bt[n][0], Bt[n][1])), "v"(cat8(At[m][0], At[m][1]))); } \
        else if constexpr (MODE == 2) { _Pragma("unroll") for (int m = 0; m < 4; ++m) _Pragma("unroll") for (int n = 0; n < 2; ++n) _Pragma("unroll") for (int k = 0; k < 2; ++k) \
            acc[ai][bj][m][n] = __builtin_bit_cast(f32x4, __builtin_amdgcn_mfma_i32_16x16x64_i8(__builtin_bit_cast(v4i_t, Bt[n][k]), __builtin_bit_cast(v4i_t, At[m][k]), __builtin_bit_cast(v4i_t, acc[ai][bj][m][n]), 0, 0, 0)); } \
        else { _Pragma("unroll") for (int m = 0; m < 4; ++m) _Pragma("unroll") for (int n = 0; n < 2; ++n) _Pragma("unroll") for (int k = 0; k < 2; ++k) \
            acc[ai][bj][m][n] = __builtin_amdgcn_mfma_f32_16x16x32_bf16(Bt[n][k], At[m][k], acc[ai][bj][m][n], 0, 0, 0); } \
        __builtin_amdgcn_s_setprio(0); } while (0)
#define PG8_WAIT_V(n) asm volatile("s_waitcnt vmcnt(" #n ")" ::: "memory")
#define PG8_WAIT_L(n) asm volatile("s_waitcnt lgkmcnt(" #n ")" ::: "memory")
#define PG8_BAR __builtin_amdgcn_s_barrier()
#define PG8_SCHED __builtin_amdgcn_sched_barrier(0)
#define PG8_ABASE(u) ((const char*)((u).z ? g.A2 : g.A) + (size_t)(u).pm * tstep)
#define PG8_BBASE(u) ((const char*)((u).z ? g.Bt2 : g.Bt) + (size_t)(u).pn * tstep)
    Unit cur, nxt; int ui = 0;
    if (!S.next(0, cur)) return;
    f32x4 acc[2][2][4][2];
#pragma unroll
    for (int a = 0; a < 2; ++a)
#pragma unroll
        for (int b = 0; b < 2; ++b)
#pragma unroll
            for (int m = 0; m < 4; ++m)
#pragma unroll
                for (int n = 0; n < 2; ++n) acc[a][b][m][n] = (f32x4){0.f, 0.f, 0.f, 0.f};
    bf16x8 At[4][2], B0[2][2], B1[2][2];
    const char* cA = PG8_ABASE(cur); const char* cB = PG8_BBASE(cur);
    S.a_ready(cur);
    if constexpr (SP2) {
        PG8_STAGE(PG8_SB(0, 0), cB, voffB); PG8_STAGE(PG8_SB(0, 1), cB + hstep, voffB); PG8_STAGE(PG8_SA(0, 0), cA, voffA); PG8_STAGE(PG8_SA(0, 1), cA + hstep, voffA);
        if (wr == 1) PG8_BAR;
        PG8_WAIT_V(2); PG8_BAR;
        PG8_STAGE(PG8_SB(1, 0), cB + kstep, voffB); PG8_STAGE(PG8_SA(1, 0), cA + kstep, voffA); PG8_STAGE(PG8_SB(1, 1), cB + hstep + kstep, voffB);
        PG8_WAIT_V(6); PG8_BAR;
    } else {
        PG8_STAGE(PG8_SB(0, 0), cB, voffB); PG8_STAGE(PG8_SA(0, 0), cA, voffA); PG8_STAGE(PG8_SB(0, 1), cB + hstep, voffB); PG8_STAGE(PG8_SA(0, 1), cA + hstep, voffA);
        if (wr == 1) PG8_BAR;
        PG8_WAIT_V(4); PG8_BAR;
        PG8_STAGE(PG8_SB(1, 0), cB + kstep, voffB); PG8_STAGE(PG8_SA(1, 0), cA + kstep, voffA); PG8_STAGE(PG8_SB(1, 1), cB + hstep + kstep, voffB);
        PG8_WAIT_V(6); PG8_BAR;
    }
    for (;;) {
        const bool has_next = S.next(ui + 1, nxt);
        const char* nA = has_next ? PG8_ABASE(nxt) : cA; const char* nB = has_next ? PG8_BBASE(nxt) : cB;
#pragma nounroll
        for (int t = 0; t < nt; t += 2) {
            const bool last = (t == nt - 2);
            const char* a1 = cA + (size_t)(t + 1) * kstep;
            const char* a2 = last ? nA : cA + (size_t)(t + 2) * kstep; const char* b2 = last ? nB : cB + (size_t)(t + 2) * kstep;
            const char* a3 = a2 + kstep; const char* b3 = b2 + kstep;
            if (last && has_next) S.a_ready(nxt);
            if constexpr (SP2) {
            PG8_LDB(B0, 0, 0); PG8_LDB(B1, 0, 1); PG8_SCHED; PG8_LDA(At, 0, 0); PG8_STAGE(PG8_SA(1, 1), a1 + hstep, voffA);
            PG8_WAIT_V(8); PG8_WAIT_L(0); PG8_BAR; PG8_MMA(0, 0, At, B0); PG8_MMA(0, 1, At, B1); PG8_BAR; PG8_SCHED;
            PG8_LDA(At, 0, 1); PG8_STAGE(PG8_SB(0, 0), b2, voffB); PG8_STAGE(PG8_SB(0, 1), b2 + hstep, voffB); PG8_STAGE(PG8_SA(0, 0), a2, voffA);
            PG8_WAIT_V(8); PG8_WAIT_L(0); PG8_BAR; PG8_MMA(1, 0, At, B0); PG8_MMA(1, 1, At, B1); PG8_BAR; PG8_SCHED;
            PG8_LDB(B0, 1, 0); PG8_LDB(B1, 1, 1); PG8_SCHED; PG8_LDA(At, 1, 0); PG8_STAGE(PG8_SA(0, 1), a2 + hstep, voffA);
            PG8_WAIT_V(8); PG8_WAIT_L(0); PG8_BAR; PG8_MMA(0, 0, At, B0); PG8_MMA(0, 1, At, B1); PG8_BAR; PG8_SCHED;
            PG8_LDA(At, 1, 1); PG8_STAGE(PG8_SB(1, 0), b3, voffB); PG8_STAGE(PG8_SB(1, 1), b3 + hstep, voffB); PG8_STAGE(PG8_SA(1, 0), a3, voffA);
            PG8_WAIT_V(8); PG8_WAIT_L(0); PG8_BAR; PG8_MMA(1, 0, At, B0); PG8_MMA(1, 1, At, B1); PG8_BAR; PG8_SCHED;
            } else {
            PG8_LDB(B0, 0, 0); PG8_SCHED; PG8_LDA(At, 0, 0); PG8_STAGE(PG8_SA(1, 1), a1 + hstep, voffA);
            PG8_WAIT_L(8); PG8_BAR; PG8_WAIT_L(0); PG8_MMA(0, 0, At, B0); PG8_BAR; PG8_SCHED;
            PG8_LDB(B1, 0, 1); PG8_STAGE(PG8_SB(0, 0), b2, voffB);
            PG8_BAR; PG8_WAIT_L(0); PG8_MMA(0, 1, At, B1); PG8_BAR;
            PG8_LDA(At, 0, 1); PG8_STAGE(PG8_SA(0, 0), a2, voffA);
            PG8_BAR; PG8_WAIT_L(0); PG8_MMA(1, 0, At, B0); PG8_BAR; PG8_SCHED;
            PG8_STAGE(PG8_SB(0, 1), b2 + hstep, voffB);
            PG8_WAIT_V(6); PG8_BAR; PG8_MMA(1, 1, At, B1); PG8_BAR;
            PG8_LDB(B0, 1, 0); PG8_SCHED; PG8_LDA(At, 1, 0); PG8_STAGE(PG8_SA(0, 1), a2 + hstep, voffA);
            PG8_WAIT_L(8); PG8_BAR; PG8_WAIT_L(0); PG8_MMA(0, 0, At, B0); PG8_BAR; PG8_SCHED;
            PG8_LDB(B1, 1, 1); PG8_STAGE(PG8_SB(1, 0), b3, voffB);
            PG8_BAR; PG8_WAIT_L(0); PG8_MMA(0, 1, At, B1); PG8_BAR;
            PG8_LDA(At, 1, 1); PG8_STAGE(PG8_SA(1, 0), a3, voffA);
            PG8_BAR; PG8_WAIT_L(0); PG8_MMA(1, 0, At, B0); PG8_BAR; PG8_SCHED;
            PG8_STAGE(PG8_SB(1, 1), b3 + hstep, voffB);
            PG8_WAIT_V(6); PG8_BAR; PG8_MMA(1, 1, At, B1); PG8_BAR;
            }
        }
        if constexpr (ALIGN_EPI) { if (wr == 0) PG8_BAR; }
        if constexpr (FP8) asm volatile("s_nop 7\n\ts_nop 7\n\ts_nop 7" ::: "memory");
        E(acc, cur, wr, wc, fr, fq);
        if (!has_next) break;
#pragma unroll
        for (int a = 0; a < 2; ++a)
#pragma unroll
            for (int b = 0; b < 2; ++b)
#pragma unroll
                for (int m = 0; m < 4; ++m)
#pragma unroll
                    for (int n = 0; n < 2; ++n) acc[a][b][m][n] = (f32x4){0.f, 0.f, 0.f, 0.f};
        cur = nxt; cA = nA; cB = nB; ++ui;
        if constexpr (ALIGN_EPI) { if (wr == 1) PG8_BAR; }
    }
    PG8_WAIT_V(0);
    if constexpr (!ALIGN_EPI) { if (wr == 0) PG8_BAR; }
    PG8_BAR;
#undef PG8_SA
#undef PG8_SB
#undef PG8_STAGE
#undef PG8_LDA
#undef PG8_LDB
#undef PG8_MMA
#undef PG8_WAIT_V
#undef PG8_WAIT_L
#undef PG8_BAR
#undef PG8_SCHED
#undef PG8_ABASE
#undef PG8_BBASE
}

__device__ __forceinline__ f32x4 cvt_i4(f32x4 a) { const v4i_t i = __builtin_bit_cast(v4i_t, a); return (f32x4){(float)i.x, (float)i.y, (float)i.z, (float)i.w}; }
struct EpiProj {
    static constexpr bool PERM = true;
    bf16_t* O; float* ST; const float* SH; const float* SW;
    __device__ __forceinline__ void operator()(const f32x4 (&acc)[2][2][4][2], const Unit& u, int wr, int wc, int fr, int fq) const {
        const int row0 = u.pm * BM + wr * 64 + fr;
        f32x4 cs[2][2]; float rsc[2][4];
#pragma unroll
        for (int bj = 0; bj < 2; ++bj)
#pragma unroll
            for (int n = 0; n < 2; ++n) cs[bj][n] = *(const f32x4*)(SW + u.pn * BM + bj * HALF + wc * 32 + 8 * fq + 4 * n);
#pragma unroll
        for (int ai = 0; ai < 2; ++ai)
#pragma unroll
            for (int m = 0; m < 4; ++m) rsc[ai][m] = SH[row0 + ai * HALF + m * 16];
#define PG8_DQ(ai, bj, m, n) (cvt_i4(acc[ai][bj][m][n]) * cs[bj][n] * rsc[ai][m])
        if (u.pn >= 12 && u.pn < 20) {
            bf16_t* base = O + (size_t)3 * SEG + (u.pn - 12) * 128 + wc * 32 + 8 * fq;
#pragma unroll
            for (int ai = 0; ai < 2; ++ai)
#pragma unroll
                for (int m = 0; m < 4; ++m) { const f32x4 v0 = PG8_DQ(ai, 0, m, 0) * PG8_DQ(ai, 1, m, 0), v1 = PG8_DQ(ai, 0, m, 1) * PG8_DQ(ai, 1, m, 1);
                    u32x4 w; w.x = pk_bf16(v0[0], v0[1]); w.y = pk_bf16(v0[2], v0[3]); w.z = pk_bf16(v1[0], v1[1]); w.w = pk_bf16(v1[2], v1[3]);
                    *(u32x4*)(base + (size_t)(row0 + ai * HALF + m * 16) * D) = w; }
            return;
        }
        const int s = (u.pn < 12) ? (u.pn >> 2) : 5 + ((u.pn - 20) >> 2), act = (s < 2) ? 1 : (s >= 5 ? 2 : 0);
        const int col0 = (u.pn & 3) * BM + wc * 32 + 8 * fq;
        bf16_t* base = O + (size_t)s * SEG;
#pragma unroll
        for (int ai = 0; ai < 2; ++ai)
#pragma unroll
            for (int m = 0; m < 4; ++m) { bf16_t* rowp = base + (size_t)(row0 + ai * HALF + m * 16) * D + col0; float rs = 0.f, rq = 0.f;
#pragma unroll
                for (int bj = 0; bj < 2; ++bj) { f32x4 v0 = PG8_DQ(ai, bj, m, 0), v1 = PG8_DQ(ai, bj, m, 1);
                    if (act == 1) {
#pragma unroll
                        for (int j = 0; j < 4; ++j) { v0[j] = gelu_tanh(v0[j]); v1[j] = gelu_tanh(v1[j]); } }
                    else if (act == 2) {
#pragma unroll
                        for (int j = 0; j < 4; ++j) { v0[j] = sigmoidf_(v0[j]); v1[j] = sigmoidf_(v1[j]); } }
                    u32x4 w; w.x = pk_bf16(v0[0], v0[1]); w.y = pk_bf16(v0[2], v0[3]); w.z = pk_bf16(v1[0], v1[1]); w.w = pk_bf16(v1[2], v1[3]);
                    *(u32x4*)(rowp + bj * HALF) = w;
                    if (s == 1) {
                        const float a0 = bf_lo(w.x), a1 = bf_hi(w.x), a2 = bf_lo(w.y), a3 = bf_hi(w.y), a4 = bf_lo(w.z), a5 = bf_hi(w.z), a6 = bf_lo(w.w), a7 = bf_hi(w.w);
                        const float ps = ((a0 + a1) + (a2 + a3)) + ((a4 + a5) + (a6 + a7)), pq = ((a0 * a0 + a1 * a1) + (a2 * a2 + a3 * a3)) + ((a4 * a4 + a5 * a5) + (a6 * a6 + a7 * a7));
                        if (bj == 0) { rs = ps; rq = pq; } else { rs += ps; rq += pq; } } }
                if (s == 1) {
                    rs += shx(rs, 16); rq += shx(rq, 16); rs += shx(rs, 32); rq += shx(rq, 32);
                    if (fq == 0) *(f32x2*)(ST + ((size_t)(row0 + ai * HALF + m * 16) * 16 + (u.pn - 4) * 4 + wc) * 2) = (f32x2){rs, rq}; } }
    }
};
#undef PG8_DQ
struct EpiDual {
    static constexpr bool PERM = true;
    bf16_t* Mo; const bf16_t* SA; const bf16_t* SB; const float* SH; const float* SW; PG8_LAS unsigned* RM;
    __device__ __forceinline__ void operator()(const f32x4 (&acc)[2][2][4][2], const Unit& u, int wr, int wc, int fr, int fq) const {
        const int row0 = u.pm * BM + wr * 64 + fr, col0 = u.pn * BM + wc * 32 + 8 * fq;
        const bf16_t* G = u.z ? SB : SA;
        const float* shz = SH + (u.z ? M : 0); const float* swz = SW + (u.z ? 1024 : 0);
        f32x4 cs[2][2];
#pragma unroll
        for (int bj = 0; bj < 2; ++bj)
#pragma unroll
            for (int n = 0; n < 2; ++n) cs[bj][n] = *(const f32x4*)(swz + col0 + bj * HALF + 4 * n);
#pragma unroll
        for (int aq = 0; aq < 4; ++aq) { const int ai = aq >> 1, m0 = (aq & 1) * 2;
            u32x4 gw[4][2], pw[4][2]; float rsc[4];
#pragma unroll
            for (int m = m0; m < m0 + 2; ++m) { const size_t ro = (size_t)(row0 + ai * HALF + m * 16) * D + col0; rsc[m] = shz[row0 + ai * HALF + m * 16];
#pragma unroll
                for (int bj = 0; bj < 2; ++bj) { gw[m][bj] = *(const u32x4*)(G + ro + bj * HALF); if (u.z) pw[m][bj] = *(const u32x4*)(Mo + ro + bj * HALF); } }
#pragma unroll
            for (int m = m0; m < m0 + 2; ++m) { const size_t ro = (size_t)(row0 + ai * HALF + m * 16) * D + col0; float rm = 0.f;
#pragma unroll
                for (int bj = 0; bj < 2; ++bj) { const u32x4 g = gw[m][bj];
                    f32x4 v0 = cvt_i4(acc[ai][bj][m][0]) * cs[bj][0] * rsc[m], v1 = cvt_i4(acc[ai][bj][m][1]) * cs[bj][1] * rsc[m];
                    v0[0] *= bf_lo(g.x); v0[1] *= bf_hi(g.x); v0[2] *= bf_lo(g.y); v0[3] *= bf_hi(g.y);
                    v1[0] *= bf_lo(g.z); v1[1] *= bf_hi(g.z); v1[2] *= bf_lo(g.w); v1[3] *= bf_hi(g.w);
                    if (u.z) { const u32x4 q = pw[m][bj];
                        v0[0] += bf_lo(q.x); v0[1] += bf_hi(q.x); v0[2] += bf_lo(q.y); v0[3] += bf_hi(q.y);
                        v1[0] += bf_lo(q.z); v1[1] += bf_hi(q.z); v1[2] += bf_lo(q.w); v1[3] += bf_hi(q.w); }
                    u32x4 w; w.x = pk_bf16(v0[0], v0[1]); w.y = pk_bf16(v0[2], v0[3]); w.z = pk_bf16(v1[0], v1[1]); w.w = pk_bf16(v1[2], v1[3]);
                    *(u32x4*)(Mo + ro + bj * HALF) = w;
                    rm = fmaxf(rm, fmaxf(fmaxf(fmaxf(fabsf(v0[0]), fabsf(v0[1])), fmaxf(fabsf(v0[2]), fabsf(v0[3]))), fmaxf(fmaxf(fabsf(v1[0]), fabsf(v1[1])), fmaxf(fabsf(v1[2]), fabsf(v1[3]))))); }
                if (u.z) { rm = fmaxf(rm, shx(rm, 16)); rm = fmaxf(rm, shx(rm, 32));
                    if (fq == 0) (void)__hip_atomic_fetch_max(RM + (ai * HALF + wr * 64 + m * 16 + fr), __float_as_uint(rm), __ATOMIC_RELAXED, __HIP_MEMORY_SCOPE_WORKGROUP); } }
        }
    }
};
struct EpiRes {
    static constexpr bool PERM = true;
    bf16_t* R; const float* X; const float* mod; const float* SH; const float* SW;
    __device__ __forceinline__ void operator()(const f32x4 (&acc)[2][2][4][2], const Unit& u, int wr, int wc, int fr, int fq) const {
        const int row0 = u.pm * BM + wr * 64 + fr, col0 = u.pn * BM + wc * 32 + 8 * fq;
        const int b = (u.pm * BM) >> 11;
        f32x4 g1[2][2];
#pragma unroll
        for (int bj = 0; bj < 2; ++bj)
#pragma unroll
            for (int n = 0; n < 2; ++n) g1[bj][n] = *(const f32x4*)(mod + (size_t)b * NMOD + 2048 + col0 + bj * HALF + 4 * n) * *(const f32x4*)(SW + col0 + bj * HALF + 4 * n);
#pragma unroll
        for (int aq = 0; aq < 4; ++aq) { const int ai = aq >> 1, m0 = (aq & 1) * 2;
            f32x4 xv[4][2][2]; float rsc[4];
#pragma unroll
            for (int m = m0; m < m0 + 2; ++m) { const size_t ro = (size_t)(row0 + ai * HALF + m * 16) * D + col0; rsc[m] = SH[row0 + ai * HALF + m * 16];
#pragma unroll
                for (int bj = 0; bj < 2; ++bj) { xv[m][bj][0] = *(const f32x4*)(X + ro + bj * HALF); xv[m][bj][1] = *(const f32x4*)(X + ro + bj * HALF + 4); } }
#pragma unroll
            for (int m = m0; m < m0 + 2; ++m) { const size_t ro = (size_t)(row0 + ai * HALF + m * 16) * D + col0;
#pragma unroll
                for (int bj = 0; bj < 2; ++bj) {
                    const f32x4 v0 = xv[m][bj][0] * ALPHA + g1[bj][0] * (cvt_i4(acc[ai][bj][m][0]) * rsc[m]), v1 = xv[m][bj][1] * ALPHA + g1[bj][1] * (cvt_i4(acc[ai][bj][m][1]) * rsc[m]);
                    u32x4 w; w.x = pk_bf16(v0[0], v0[1]); w.y = pk_bf16(v0[2], v0[3]); w.z = pk_bf16(v1[0], v1[1]); w.w = pk_bf16(v1[2], v1[3]);
                    *(u32x4*)(R + ro + bj * HALF) = w; } }
        }
    }
};
struct EpiPlainI8 {
    static constexpr bool PERM = true;
    bf16_t* O; bf16_t* O2; int ldc; const float* SH; const float* SW;
    __device__ __forceinline__ void operator()(const f32x4 (&acc)[2][2][4][2], const Unit& u, int wr, int wc, int fr, int fq) const {
        const int row0 = u.pm * BM + wr * 64 + fr, col0 = u.pn * BM + wc * 32 + 8 * fq;
        bf16_t* Oz = ((u.pn < 4) ? O : O2) + (u.pn & 3) * BM + wc * 32 + 8 * fq;
        f32x4 cs[2][2];
#pragma unroll
        for (int bj = 0; bj < 2; ++bj)
#pragma unroll
            for (int n = 0; n < 2; ++n) cs[bj][n] = *(const f32x4*)(SW + col0 + bj * HALF + 4 * n);
#pragma unroll
        for (int ai = 0; ai < 2; ++ai)
#pragma unroll
            for (int m = 0; m < 4; ++m) { bf16_t* rowp = Oz + (size_t)(row0 + ai * HALF + m * 16) * ldc; const float rsc = SH[row0 + ai * HALF + m * 16];
#pragma unroll
                for (int bj = 0; bj < 2; ++bj) { const f32x4 v0 = cvt_i4(acc[ai][bj][m][0]) * cs[bj][0] * rsc, v1 = cvt_i4(acc[ai][bj][m][1]) * cs[bj][1] * rsc;
                    u32x4 w; w.x = pk_bf16(v0[0], v0[1]); w.y = pk_bf16(v0[2], v0[3]); w.z = pk_bf16(v1[0], v1[1]); w.w = pk_bf16(v1[2], v1[3]);
                    *(u32x4*)(rowp + bj * HALF) = w; } }
    }
};
struct EpiPlain {
    static constexpr bool PERM = true;
    bf16_t* O; int ldc;
    __device__ __forceinline__ void operator()(const f32x4 (&acc)[2][2][4][2], const Unit& u, int wr, int wc, int fr, int fq) const {
        const int row0 = u.pm * BM + wr * 64 + fr, col0 = u.pn * BM + wc * 32 + 8 * fq;
#pragma unroll
        for (int ai = 0; ai < 2; ++ai)
#pragma unroll
            for (int m = 0; m < 4; ++m) { bf16_t* rowp = O + (size_t)(row0 + ai * HALF + m * 16) * ldc + col0;
#pragma unroll
                for (int bj = 0; bj < 2; ++bj) { const f32x4 v0 = acc[ai][bj][m][0], v1 = acc[ai][bj][m][1];
                    u32x4 w; w.x = pk_bf16(v0[0], v0[1]); w.y = pk_bf16(v0[2], v0[3]); w.z = pk_bf16(v1[0], v1[1]); w.w = pk_bf16(v1[2], v1[3]);
                    *(u32x4*)(rowp + bj * HALF) = w; } }
    }
};
}

#define XB_TMO      128
#define XB_XCNT(j)  (256  + 64 * (j))
#define XB_XSUB(j)  (1280 + 64 * (j))
#define XB_XGEN(j)  (2304 + 64 * (j))
#define XB_TOP      3328
#define XB_TOPGEN   3392
#define XCD_BAR_WORDS 3456
#define XB_SPIN_CAP (1u << 18)
__device__ __forceinline__ unsigned xb_ld(unsigned* p)              { return __hip_atomic_load(p, __ATOMIC_RELAXED, __HIP_MEMORY_SCOPE_AGENT); }
__device__ __forceinline__ unsigned xb_add(unsigned* p, unsigned v) { return __hip_atomic_fetch_add(p, v, __ATOMIC_RELAXED, __HIP_MEMORY_SCOPE_AGENT); }
__device__ __forceinline__ unsigned xb_xcc_id() { return (unsigned)__builtin_amdgcn_s_getreg((3 << 11) | 20) & 0xFu; }
#define XB_SPIN(cond, bar) do { unsigned _sp = 0; while (cond) { __builtin_amdgcn_s_sleep(1); \
    if ((++_sp & 255u) == 0u) { if (xb_ld(&(bar)[XB_TMO])) break; if (_sp > XB_SPIN_CAP) { atomicAdd(&(bar)[XB_TMO], 1u); break; } } } } while (0)
struct XcdBarrier { unsigned* bar; unsigned x; volatile LAS unsigned* st; int wave; };
__device__ __forceinline__ XcdBarrier xcd_barrier_post(unsigned* bar, volatile LAS unsigned* st, int wave) {
    XcdBarrier b; b.bar = bar; b.x = xb_xcc_id(); b.st = st; b.wave = wave;
    if (wave == 0 && lane_now() == 0) (void)xb_add(&bar[XB_XCNT(b.x)], 1u);
    return b;
}
__device__ __forceinline__ void xcd_barrier_complete(unsigned* bar, unsigned x, unsigned& nloc, unsigned& nx) {
    const unsigned G = gridDim.x * gridDim.y * gridDim.z;
    unsigned sum, cnt, mine, sp = 0u;
    for (;;) {
        sum = 0u; cnt = 0u; mine = 0u;
#pragma unroll
        for (unsigned j = 0; j < 16; ++j) { const unsigned c = xb_ld(&bar[XB_XCNT(j)]); sum += c; cnt += (c > 0u) ? 1u : 0u; mine = (j == x) ? c : mine; }
        if (sum == G) break;
        __builtin_amdgcn_s_sleep(1);
        if ((++sp & 255u) == 0u) { if (xb_ld(&bar[XB_TMO])) break; if (sp > XB_SPIN_CAP) { atomicAdd(&bar[XB_TMO], 1u); break; } }
    }
    nloc = mine > 0u ? mine : 1u; nx = cnt > 0u ? cnt : 1u;
}
__device__ __forceinline__ void xcd_barrier(const XcdBarrier& b) {
    asm volatile("s_waitcnt vmcnt(0)" ::: "memory");
    __syncthreads();
    if (b.wave == 0 && lane_now() == 0) {
        unsigned* bar = b.bar;
        __builtin_amdgcn_s_waitcnt(0);
        unsigned nloc = b.st[0], nx = b.st[1];
        if (nloc == 0u) { xcd_barrier_complete(bar, b.x, nloc, nx); b.st[0] = nloc; b.st[1] = nx; }
        const unsigned old = xb_add(&bar[XB_XSUB(b.x)], 1u);
        const unsigned gen = old / nloc;
        if (old + 1u == (gen + 1u) * nloc) {
            __builtin_amdgcn_fence(__ATOMIC_RELEASE, "agent");
            asm volatile("s_waitcnt vmcnt(0)" ::: "memory");
            const unsigned og = xb_add(&bar[XB_TOP], 1u);
            const unsigned tg = og / nx;
            if (og + 1u == (tg + 1u) * nx) xb_add(&bar[XB_TOPGEN], 1u);
            else XB_SPIN(xb_ld(&bar[XB_TOPGEN]) == tg, bar);
            __builtin_amdgcn_fence(__ATOMIC_ACQUIRE, "agent");
            xb_add(&bar[XB_XGEN(b.x)], 1u);
            asm volatile("s_waitcnt vmcnt(0)" ::: "memory");
        } else {
            XB_SPIN(xb_ld(&bar[XB_XGEN(b.x)]) == gen, bar);
            __builtin_amdgcn_fence(__ATOMIC_ACQUIRE, "agent");
            asm volatile("s_waitcnt vmcnt(0)" ::: "memory");
        }
    }
    __syncthreads();
}

struct Frame {
    LAS unsigned char* lds;
    int tid, lane, wave, G, gw, NGW;
    const float *x, *c, *w_cond, *b_cond, *w_in, *gln_g, *gln_b, *w_sp, *b_sp, *conv_w, *p_a, *p_b, *w_o, *ln1_g, *ln1_b, *w_q, *keys, *eu, *ev, *ln2_g, *ln2_b;
    float* out; float* mod;
    bf16 *Win_t, *Pa_t, *Pb_t, *Wo_t, *Wq_t, *Keys, *Wsp, *EU, *EV;
    unsigned* sel; const bf16* zrow; unsigned char *EU8, *EV8; float* SC; float* ST;
    unsigned* CM; float* SW; float* SH;
    float* TOPS; bf16* Rb; unsigned char* H2q; unsigned char* M8;
    bf16 *H, *B1, *B2, *B3, *B4, *B5, *B6;
};

constexpr float WSC8 = 256.0f;
__device__ __forceinline__ unsigned pk4_fp8(float a, float b, float c, float d) {
    a = fminf(fmaxf(a, -448.f), 448.f); b = fminf(fmaxf(b, -448.f), 448.f); c = fminf(fmaxf(c, -448.f), 448.f); d = fminf(fmaxf(d, -448.f), 448.f);
    int w = __builtin_amdgcn_cvt_pk_fp8_f32(a, b, 0, false); w = __builtin_amdgcn_cvt_pk_fp8_f32(c, d, w, true); return (unsigned)w;
}
template <bool PAIRED = false, bool FP8OUT = false>
__device__ __forceinline__ void p0_transpose_item(const float* W, int K, int N, bf16* WT, LAS float* scr, int item, int lane) {
    const int nblk = N / 32, kb = item / nblk, nb = item % nblk, k0 = 64 * kb, n0 = 32 * nb;
    int ns = n0;
    if (PAIRED && n0 >= 3072 && n0 < 5120) { const int q = n0 - 3072; ns = (((q >> 7) & 1) ? 4096 : 3072) + 128 * (q >> 8) + (q & 127); }
#pragma unroll 8
    for (int i = 0; i < 32; ++i) { const int kk = 2 * i + (lane >> 5); scr[kk * 33 + (lane & 31)] = W[(size_t)(k0 + kk) * N + ns + (lane & 31)]; }
    LDS_WAIT(); asm volatile("" ::: "memory");
    const int c = lane & 7;
#pragma unroll
    for (int j = 0; j < 4; ++j) { const int n = (lane >> 3) + 8 * j; const LAS float* s = scr + (8 * c) * 33 + n;
        if constexpr (FP8OUT) {
            v2u o8; o8.x = pk4_fp8(s[0 * 33] * WSC8, s[1 * 33] * WSC8, s[2 * 33] * WSC8, s[3 * 33] * WSC8); o8.y = pk4_fp8(s[4 * 33] * WSC8, s[5 * 33] * WSC8, s[6 * 33] * WSC8, s[7 * 33] * WSC8);
            *(GAS v2u*)((unsigned char*)WT + (size_t)(n0 + n) * K + k0 + 8 * c) = o8; continue; }
        v4u o; o.x = pk_bf16(s[0 * 33], s[1 * 33]); o.y = pk_bf16(s[2 * 33], s[3 * 33]); o.z = pk_bf16(s[4 * 33], s[5 * 33]); o.w = pk_bf16(s[6 * 33], s[7 * 33]);
        *(GAS v4u*)(WT + (size_t)(n0 + n) * K + k0 + 8 * c) = o; }
    LDS_WAIT(); asm volatile("" ::: "memory");
}
template <bool PAIRED = false>
__device__ __forceinline__ void p0_colmax_item(const float* W, int K, int N, unsigned* CM, int item, int lane) {
    const int nblk = N / 32, kb = item / nblk, nb = item % nblk, k0 = 64 * kb, n0 = 32 * nb;
    int ns = n0;
    if (PAIRED && n0 >= 3072 && n0 < 5120) { const int q = n0 - 3072; ns = (((q >> 7) & 1) ? 4096 : 3072) + 128 * (q >> 8) + (q & 127); }
    float mx = 0.f;
#pragma unroll 8
    for (int i = 0; i < 32; ++i) { const int kk = 2 * i + (lane >> 5); mx = fmaxf(mx, fabsf(W[(size_t)(k0 + kk) * N + ns + (lane & 31)])); }
    mx = fmaxf(mx, shx(mx, 32));
    if (lane < 32) (void)__hip_atomic_fetch_max(&CM[n0 + lane], __float_as_uint(mx), __ATOMIC_RELAXED, __HIP_MEMORY_SCOPE_AGENT);
}
template <bool PAIRED = false>
__device__ __forceinline__ void p1_quant_item(const float* W, int K, int N, unsigned char* WT8, const unsigned* CM, float* SW, LAS float* scr, int item, int lane) {
    const int nblk = N / 32, kb = item / nblk, nb = item % nblk, k0 = 64 * kb, n0 = 32 * nb;
    int ns = n0;
    if (PAIRED && n0 >= 3072 && n0 < 5120) { const int q = n0 - 3072; ns = (((q >> 7) & 1) ? 4096 : 3072) + 128 * (q >> 8) + (q & 127); }
#pragma unroll 8
    for (int i = 0; i < 32; ++i) { const int kk = 2 * i + (lane >> 5); scr[kk * 33 + (lane & 31)] = W[(size_t)(k0 + kk) * N + ns + (lane & 31)]; }
    LDS_WAIT(); asm volatile("" ::: "memory");
    const int c = lane & 7;
#pragma unroll
    for (int j = 0; j < 4; ++j) { const int n = (lane >> 3) + 8 * j; const LAS float* t = scr + (8 * c) * 33 + n;
        const float amax = __uint_as_float(CM[n0 + n]), inv = (amax > 0.f) ? 127.0f / amax : 0.f;
        v2u o8; o8.x = pk4_i8(t[0 * 33] * inv, t[1 * 33] * inv, t[2 * 33] * inv, t[3 * 33] * inv); o8.y = pk4_i8(t[4 * 33] * inv, t[5 * 33] * inv, t[6 * 33] * inv, t[7 * 33] * inv);
        *(GAS v2u*)(WT8 + (size_t)(n0 + n) * K + k0 + 8 * c) = o8;
        if (kb == 0 && c == 0) SW[n0 + n] = amax * (1.0f / 127.0f); }
    LDS_WAIT(); asm volatile("" ::: "memory");
}
__device__ __forceinline__ void p0_cond_item(Frame& F, int it) {
    LAS float* sc = (LAS float*)F.lds;
    for (int i0 = 0; i0 < 64; i0 += 8) {
        float v[8];
#pragma unroll
        for (int i = 0; i < 8; ++i) v[i] = F.c[F.tid + 512 * (i0 + i)];
#pragma unroll
        for (int i = 0; i < 8; ++i) { const int e = F.tid + 512 * (i0 + i), b = e >> 10, k = e & 1023; sc[k * 32 + b] = v[i] / (1.0f + __expf(-v[i])); }
    }
    __syncthreads();
    float acc[32];
#pragma unroll
    for (int b = 0; b < 32; ++b) acc[b] = 0.f;
    const float* W = F.w_cond + it * 64 + F.lane;
    for (int k0 = F.wave * 128; k0 < F.wave * 128 + 128; k0 += 16) {
        float wv[16];
#pragma unroll
        for (int i = 0; i < 16; ++i) wv[i] = W[(size_t)(k0 + i) * NMOD];
#pragma unroll
        for (int i = 0; i < 16; ++i) { const LAS f32x4* s4 = (const LAS f32x4*)(sc + (k0 + i) * 32);
#pragma unroll
            for (int q = 0; q < 8; ++q) { const f32x4 s = s4[q]; acc[4 * q + 0] += s.x * wv[i]; acc[4 * q + 1] += s.y * wv[i]; acc[4 * q + 2] += s.z * wv[i]; acc[4 * q + 3] += s.w * wv[i]; } }
    }
    __syncthreads();
    LAS float* red = (LAS float*)F.lds;
#pragma unroll
    for (int b = 0; b < 32; ++b) red[(F.wave * 32 + b) * 64 + F.lane] = acc[b];
    __syncthreads();
#pragma unroll
    for (int i = 0; i < 4; ++i) { const int e = F.tid + 512 * i, b = e >> 6, ln = e & 63; float s = F.b_cond[it * 64 + ln];
#pragma unroll
        for (int w = 0; w < 8; ++w) s += red[(w * 32 + b) * 64 + ln];
        F.mod[b * NMOD + it * 64 + ln] = s; }
    __syncthreads();
}
__device__ __forceinline__ void cvt8(const float* src, bf16* dst, size_t i8) {
    const f32x4 a = *(const GAS f32x4*)(src + i8 * 8), b = *(const GAS f32x4*)(src + i8 * 8 + 4);
    v4u o; o.x = pk_bf16(a.x, a.y); o.y = pk_bf16(a.z, a.w); o.z = pk_bf16(b.x, b.y); o.w = pk_bf16(b.z, b.w);
    *(GAS v4u*)(dst + i8 * 8) = o;
}
__device__ __forceinline__ void phase0(Frame& F) {
    for (int it = blockIdx.x; it < NMOD / 64; it += F.G) p0_cond_item(F, it);
    LAS float* scr = (LAS float*)(F.lds + F.wave * 16384);
    constexpr int I_IN = (D / 64) * (NIN / 32), I_SQ = (D / 64) * (D / 32), I_Q = (D / 64) * (NQ / 32);
    constexpr int NITEMS = I_IN + 3 * I_SQ + I_Q;
    for (int it = F.gw; it < NITEMS; it += F.NGW) {
        int r = it;
        if (r < I_IN) { p0_colmax_item<true>(F.w_in, D, NIN, F.CM, r, F.lane); continue; } r -= I_IN;
        if (r < I_SQ) { p0_colmax_item<false>(F.p_a, D, D, F.CM + NIN + NQ, r, F.lane); continue; } r -= I_SQ;
        if (r < I_SQ) { p0_colmax_item<false>(F.p_b, D, D, F.CM + NIN + NQ + D, r, F.lane); continue; } r -= I_SQ;
        if (r < I_SQ) { p0_colmax_item<false>(F.w_o, D, D, F.CM + NIN + NQ + 2 * D, r, F.lane); continue; } r -= I_SQ;
        p0_colmax_item<false>(F.w_q, D, NQ, F.CM + NIN, r, F.lane);
    }
    const size_t gt = (size_t)blockIdx.x * 512 + F.tid, NT = (size_t)F.G * 512;
    for (int e0 = 2 * F.gw; e0 < NE; e0 += 2 * F.NGW) {
        f32x4 ru[2][4], rv[2][4];
#pragma unroll
        for (int x = 0; x < 2; ++x) { const GAS f32x4* su = (const GAS f32x4*)(F.eu + (size_t)(e0 + x) * D) + 4 * F.lane; const GAS f32x4* sv = (const GAS f32x4*)(F.ev + (size_t)(e0 + x) * D) + 4 * F.lane;
#pragma unroll
            for (int i = 0; i < 4; ++i) { ru[x][i] = su[i]; rv[x][i] = sv[i]; } }
#pragma unroll
        for (int x = 0; x < 2; ++x) {
            const int e = e0 + x;
            float amu = 0.f, amv = 0.f;
#pragma unroll
            for (int i = 0; i < 4; ++i) { amu = fmaxf(amu, fmaxf(fmaxf(fabsf(ru[x][i].x), fabsf(ru[x][i].y)), fmaxf(fabsf(ru[x][i].z), fabsf(ru[x][i].w))));
                                          amv = fmaxf(amv, fmaxf(fmaxf(fabsf(rv[x][i].x), fabsf(rv[x][i].y)), fmaxf(fabsf(rv[x][i].z), fabsf(rv[x][i].w)))); }
            amu = wave_max(amu); amv = wave_max(amv);
            const int ex = (int)((__float_as_uint(amv) >> 23) & 0xFFu) - 127;
            const int k = (amv > 0.f) ? ((7 - ex) < 100 ? (7 - ex) : 100) : 0;
            const float sc = __uint_as_float((unsigned)(127 + k) << 23), iscv = __uint_as_float((unsigned)(127 - k) << 23);
            unsigned ov[4], ou[4];
#pragma unroll
            for (int i = 0; i < 4; ++i) { int w = __builtin_amdgcn_cvt_pk_fp8_f32(rv[x][i].x * sc, rv[x][i].y * sc, 0, false); w = __builtin_amdgcn_cvt_pk_fp8_f32(rv[x][i].z * sc, rv[x][i].w * sc, w, true); ov[i] = (unsigned)w; }
            const float inv = (amu > 0.f) ? 127.0f / amu : 0.f, iscu = amu * (1.0f / 127.0f);
#define Q8(v) ((unsigned)__float2int_rn((v) * inv) & 0xFFu)
#pragma unroll
            for (int i = 0; i < 4; ++i) ou[i] = Q8(ru[x][i].x) | (Q8(ru[x][i].y) << 8) | (Q8(ru[x][i].z) << 16) | (Q8(ru[x][i].w) << 24);
#undef Q8
            *((GAS v4u*)(F.EU8 + (size_t)e * D) + F.lane) = (v4u){ou[0], ou[1], ou[2], ou[3]};
            *((GAS v4u*)(F.EV8 + (size_t)e * D) + F.lane) = (v4u){ov[0], ov[1], ov[2], ov[3]};
            if (F.lane == 0) *(GAS f32x2*)(F.SC + 2 * e) = (f32x2){iscu, iscv};
        }
    }
    for (size_t i = gt; i < (size_t)8 * 2 * 128 * 128 / 8; i += NT) cvt8(F.keys, F.Keys, i);
    for (size_t i = gt; i < (size_t)8 * 128 * 128 / 8; i += NT) {
        const int e = (int)i * 8, j = e & 127, ii = (e >> 7) & 127;
        if ((j >> 6) <= (ii >> 6)) cvt8(F.w_sp, F.Wsp, i); else *(GAS v4u*)(F.Wsp + i * 8) = (v4u){0u, 0u, 0u, 0u};
    }
}

__device__ __forceinline__ void phase1(Frame& F) {
    {   LAS float* scr = (LAS float*)(F.lds + F.wave * 16384);
        constexpr int I_IN = (D / 64) * (NIN / 32), I_Q = (D / 64) * (NQ / 32), I_SQ = (D / 64) * (D / 32);
        for (int it = F.gw; it < I_IN + I_Q + 3 * I_SQ; it += F.NGW) {
            if (it < I_IN) p1_quant_item<true>(F.w_in, D, NIN, (unsigned char*)F.Win_t, F.CM, F.SW, scr, it, F.lane);
            else if (it < I_IN + I_Q) p1_quant_item<false>(F.w_q, D, NQ, (unsigned char*)F.Wq_t, F.CM + NIN, F.SW + 8192, scr, it - I_IN, F.lane);
            else if (it < I_IN + I_Q + I_SQ) p1_quant_item<false>(F.p_a, D, D, (unsigned char*)F.Pa_t, F.CM + NIN + NQ, F.SW + 10240, scr, it - I_IN - I_Q, F.lane);
            else if (it < I_IN + I_Q + 2 * I_SQ) p1_quant_item<false>(F.p_b, D, D, (unsigned char*)F.Pb_t, F.CM + NIN + NQ + D, F.SW + 11264, scr, it - I_IN - I_Q - I_SQ, F.lane);
            else p1_quant_item<false>(F.w_o, D, D, (unsigned char*)F.Wo_t, F.CM + NIN + NQ + 2 * D, F.SW + 12288, scr, it - I_IN - I_Q - 2 * I_SQ, F.lane);
        }
    }
    for (int blk = F.gw; blk < M / 32; blk += F.NGW) {
        const int r0 = blk * 32, b = r0 >> 11;
        const GAS f32x4* mp = (const GAS f32x4*)(F.mod + (size_t)b * NMOD) + F.lane;
        f32x4 sh[4], sc[4];
#pragma unroll
        for (int j = 0; j < 4; ++j) { sh[j] = mp[64 * j]; sc[j] = mp[256 + 64 * j] + 1.0f; }
#pragma unroll 2
        for (int r = 0; r < 32; ++r) {
            const GAS f32x4* xr = (const GAS f32x4*)(F.x + (size_t)(r0 + r) * D) + F.lane;
            f32x4 v[4]; float s = 0.f;
#pragma unroll
            for (int j = 0; j < 4; ++j) { v[j] = xr[64 * j]; s += (v[j].x + v[j].y) + (v[j].z + v[j].w); }
            const float mean = wave_sum(s) * (1.f / D); float s2 = 0.f;
#pragma unroll
            for (int j = 0; j < 4; ++j) { v[j] = v[j] - mean; s2 += (v[j].x * v[j].x + v[j].y * v[j].y) + (v[j].z * v[j].z + v[j].w * v[j].w); }
            const float rstd = 1.f / sqrtf(wave_sum(s2) * (1.f / D) + LN_EPS);
            GAS unsigned* o8 = (GAS unsigned*)((unsigned char*)F.H + (size_t)(r0 + r) * D) + F.lane;
            float mx = 0.f;
#pragma unroll
            for (int j = 0; j < 4; ++j) { v[j] = v[j] * rstd * sc[j] + sh[j]; mx = fmaxf(mx, fmaxf(fmaxf(fabsf(v[j].x), fabsf(v[j].y)), fmaxf(fabsf(v[j].z), fabsf(v[j].w)))); }
            mx = wave_max(mx);
            const float inv = (mx > 0.f) ? 127.0f / mx : 0.f;
#pragma unroll
            for (int j = 0; j < 4; ++j) o8[64 * j] = pk4_i8(v[j].x * inv, v[j].y * inv, v[j].z * inv, v[j].w * inv);
            if (F.lane == 0) F.SH[r0 + r] = mx * (1.0f / 127.0f);
        }
    }
}

__device__ __forceinline__ unsigned off_b(unsigned row, unsigned ch) { return 256u * row + 16u * (ch ^ (((row & 3) << 2) | ((row >> 2) & 3))); }
__device__ __forceinline__ unsigned tr_read_addr_16(unsigned lane, unsigned c, unsigned ks, unsigned t) {
    const unsigned g = lane >> 4, q = (lane & 15) >> 2, p = lane & 3;
    return off_b(32 * ks + 8 * g + 4 * t + q, 2 * c + (p >> 1)) + 8 * (p & 1);
}
typedef short v4i16_t __attribute__((ext_vector_type(4)));
__device__ __forceinline__ s16x4 lds_tr(LAS unsigned char* p) { return __builtin_bit_cast(s16x4, __builtin_amdgcn_ds_read_tr16_b64_v4i16((LAS v4i16_t*)p)); }

__device__ __forceinline__ void phase3_panel(Frame& F, const int pm) {
    LAS f32x2* stat = (LAS f32x2*)(F.lds + 65536);
    const int fr = F.lane & 15, fq = F.lane >> 4;
    for (int blk = 2 * pm; blk < 2 * pm + 2; ++blk) {
        const size_t T0 = (size_t)blk * 128;
        if (F.tid < 128) {
            const GAS f32x4* sp = (const GAS f32x4*)(F.ST + (T0 + F.tid) * 32);
            float sm = 0.f, sq = 0.f;
#pragma unroll
            for (int i = 0; i < 8; ++i) { const f32x4 v = sp[i]; sm += v.x + v.z; sq += v.y + v.w; }
            const float mean = sm * (1.f / D), var = fmaxf(sq * (1.f / D) - mean * mean, 0.f);
            stat[F.tid] = (f32x2){mean, 1.f / sqrtf(var + LN_EPS)};
        }
        __syncthreads();
        float rmx = 0.f;
        for (int g = 0; g < 8; ++g) {
            LAS unsigned char* img = F.lds + (g & 1) * 32768;
            {
                const int ch = F.tid & 15;
                const GAS f32x4* lg = (const GAS f32x4*)(F.gln_g + g * 128 + 8 * ch); const GAS f32x4* lb = (const GAS f32x4*)(F.gln_b + g * 128 + 8 * ch);
                const f32x4 g0 = lg[0], g1 = lg[1], b0 = lb[0], b1 = lb[1];
#pragma unroll
                for (int i = 0; i < 4; ++i) { const int q = F.tid + 512 * i, j = q >> 4;
                    const v4u w = *(const GAS v4u*)(F.B2 + (T0 + j) * D + g * 128 + 8 * ch);
                    const f32x2 st = stat[j];
                    v4u o;
                    o.x = pk_bf16((bf_lo(w.x) - st.x) * st.y * g0.x + b0.x, (bf_hi(w.x) - st.x) * st.y * g0.y + b0.y);
                    o.y = pk_bf16((bf_lo(w.y) - st.x) * st.y * g0.z + b0.z, (bf_hi(w.y) - st.x) * st.y * g0.w + b0.w);
                    o.z = pk_bf16((bf_lo(w.z) - st.x) * st.y * g1.x + b1.x, (bf_hi(w.z) - st.x) * st.y * g1.y + b1.y);
                    o.w = pk_bf16((bf_lo(w.w) - st.x) * st.y * g1.z + b1.z, (bf_hi(w.w) - st.x) * st.y * g1.w + b1.w);
                    *(LAS v4u*)(img + off_b(j, ch)) = o; }
            }
            __syncthreads();
            f32x4 acc[8];
#pragma unroll
            for (int ct = 0; ct < 8; ++ct) acc[ct] = (f32x4){0.f, 0.f, 0.f, 0.f};
#pragma unroll
            for (int ks = 0; ks < 4; ++ks) {
                const bf16x8 wf = *(const GAS bf16x8*)(F.Wsp + ((size_t)(g * 128 + 16 * F.wave + fr)) * 128 + 32 * ks + 8 * fq);
#pragma unroll
                for (int ct = 0; ct < 8; ++ct) {
                    const s16x4 t0 = lds_tr(img + tr_read_addr_16(F.lane, ct, ks, 0)), t1 = lds_tr(img + tr_read_addr_16(F.lane, ct, ks, 1));
                    const bf16x8 vf = {t0[0], t0[1], t0[2], t0[3], t1[0], t1[1], t1[2], t1[3]};
                    acc[ct] = __builtin_amdgcn_mfma_f32_16x16x32_bf16(vf, wf, acc[ct], 0, 0, 0);
                }
            }
            const int i = 16 * F.wave + fr;
            const float bias = F.b_sp[g * 128 + i];
            GAS v2u* up = (GAS v2u*)(F.B1 + (T0 + i) * D + g * 128 + 4 * fq);
#pragma unroll
            for (int ct = 0; ct < 8; ++ct) { const v2u uu = up[4 * ct];
                const float y0 = bf_lo(uu.x) * (acc[ct][0] + bias), y1 = bf_hi(uu.x) * (acc[ct][1] + bias), y2 = bf_lo(uu.y) * (acc[ct][2] + bias), y3 = bf_hi(uu.y) * (acc[ct][3] + bias);
                rmx = fmaxf(rmx, fmaxf(fmaxf(fabsf(y0), fabsf(y1)), fmaxf(fabsf(y2), fabsf(y3))));
                v2u o; o.x = pk_bf16(y0, y1); o.y = pk_bf16(y2, y3);
                up[4 * ct] = o; }
        }
        {
            rmx = fmaxf(rmx, shx(rmx, 16)); rmx = fmaxf(rmx, shx(rmx, 32));
            const float inv = (rmx > 0.f) ? 127.0f / rmx : 0.f;
            const int i = 16 * F.wave + fr;
            asm volatile("s_waitcnt vmcnt(0)" ::: "memory");
            for (int g = 0; g < 8; ++g) {
                const GAS v2u* up = (const GAS v2u*)(F.B1 + (T0 + i) * D + g * 128 + 4 * fq);
                GAS unsigned* qp = (GAS unsigned*)((unsigned char*)F.B5 + (T0 + i) * D + g * 128 + 4 * fq);
                v2u uu[8];
#pragma unroll
                for (int ct = 0; ct < 8; ++ct) uu[ct] = up[4 * ct];
#pragma unroll
                for (int ct = 0; ct < 8; ++ct) qp[4 * ct] = pk4_i8(bf_lo(uu[ct].x) * inv, bf_hi(uu[ct].x) * inv, bf_lo(uu[ct].y) * inv, bf_hi(uu[ct].y) * inv);
            }
            if (fq == 0) F.SH[2 * M + T0 + i] = rmx * (1.0f / 127.0f);
        }
        __syncthreads();
    }
    {   const int it = pm * 8 + F.wave;
        const int t0 = it * 32;
        float w0[16], w1[16], w2[16], p1[16], p2[16];
#pragma unroll
        for (int h = 0; h < 2; ++h)
#pragma unroll
            for (int e = 0; e < 8; ++e) { const int col = h * 512 + F.lane * 8 + e; w0[8 * h + e] = F.conv_w[col]; w1[8 * h + e] = F.conv_w[D + col]; w2[8 * h + e] = F.conv_w[2 * D + col]; p1[8 * h + e] = 0.f; p2[8 * h + e] = 0.f; }
        if ((t0 & (SEQ - 1)) != 0) {
#pragma unroll
            for (int h = 0; h < 2; ++h) { const int col = h * 512 + F.lane * 8;
                const v4u c1 = *(const GAS v4u*)(F.B4 + (size_t)(t0 - 1) * D + col), c2 = *(const GAS v4u*)(F.B4 + (size_t)(t0 - 2) * D + col);
                p1[8 * h + 0] = bf_lo(c1.x); p1[8 * h + 1] = bf_hi(c1.x); p1[8 * h + 2] = bf_lo(c1.y); p1[8 * h + 3] = bf_hi(c1.y); p1[8 * h + 4] = bf_lo(c1.z); p1[8 * h + 5] = bf_hi(c1.z); p1[8 * h + 6] = bf_lo(c1.w); p1[8 * h + 7] = bf_hi(c1.w);
                p2[8 * h + 0] = bf_lo(c2.x); p2[8 * h + 1] = bf_hi(c2.x); p2[8 * h + 2] = bf_lo(c2.y); p2[8 * h + 3] = bf_hi(c2.y); p2[8 * h + 4] = bf_lo(c2.z); p2[8 * h + 5] = bf_hi(c2.z); p2[8 * h + 6] = bf_lo(c2.w); p2[8 * h + 7] = bf_hi(c2.w); }
        }
#pragma unroll 2
        for (int t = t0; t < t0 + 32; ++t) {
            float y[16]; float mx = 0.f;
#pragma unroll
            for (int h = 0; h < 2; ++h) {
                const size_t o = (size_t)t * D + h * 512 + F.lane * 8;
                const v4u gb = *(const GAS v4u*)(F.B3 + o), pc = *(const GAS v4u*)(F.B4 + o);
                float p[8], gbv[8];
                p[0] = bf_lo(pc.x); p[1] = bf_hi(pc.x); p[2] = bf_lo(pc.y); p[3] = bf_hi(pc.y); p[4] = bf_lo(pc.z); p[5] = bf_hi(pc.z); p[6] = bf_lo(pc.w); p[7] = bf_hi(pc.w);
                gbv[0] = bf_lo(gb.x); gbv[1] = bf_hi(gb.x); gbv[2] = bf_lo(gb.y); gbv[3] = bf_hi(gb.y); gbv[4] = bf_lo(gb.z); gbv[5] = bf_hi(gb.z); gbv[6] = bf_lo(gb.w); gbv[7] = bf_hi(gb.w);
#pragma unroll
                for (int e = 0; e < 8; ++e) { const int k = 8 * h + e; y[k] = gbv[e] * (w0[k] * p2[k] + w1[k] * p1[k] + w2[k] * p[e]); p2[k] = p1[k]; p1[k] = p[e]; mx = fmaxf(mx, fabsf(y[k])); }
            }
            mx = wave_max(mx);
            const float inv = (mx > 0.f) ? 127.0f / mx : 0.f;
            GAS v2u* o8 = (GAS v2u*)((unsigned char*)F.B5 + (size_t)64 * MiB + (size_t)t * D) + F.lane;
            o8[0] = (v2u){pk4_i8(y[0] * inv, y[1] * inv, y[2] * inv, y[3] * inv), pk4_i8(y[4] * inv, y[5] * inv, y[6] * inv, y[7] * inv)};
            o8[64] = (v2u){pk4_i8(y[8] * inv, y[9] * inv, y[10] * inv, y[11] * inv), pk4_i8(y[12] * inv, y[13] * inv, y[14] * inv, y[15] * inv)};
            if (F.lane == 0) F.SH[3 * M + t] = mx * (1.0f / 127.0f);
        }
    }
}

__device__ __forceinline__ void unpack16(const v4u a, const v4u b, float (&v)[16]) {
    v[0] = bf_lo(a.x); v[1] = bf_hi(a.x); v[2] = bf_lo(a.y); v[3] = bf_hi(a.y); v[4] = bf_lo(a.z); v[5] = bf_hi(a.z); v[6] = bf_lo(a.w); v[7] = bf_hi(a.w);
    v[8] = bf_lo(b.x); v[9] = bf_hi(b.x); v[10] = bf_lo(b.y); v[11] = bf_hi(b.y); v[12] = bf_lo(b.z); v[13] = bf_hi(b.z); v[14] = bf_lo(b.w); v[15] = bf_hi(b.w);
}
__device__ __forceinline__ void load16f(const float* p, int lane, float (&v)[16]) {
    const f32x4 a = *(const GAS f32x4*)(p + 8 * lane), b = *(const GAS f32x4*)(p + 8 * lane + 4), c = *(const GAS f32x4*)(p + 512 + 8 * lane), d = *(const GAS f32x4*)(p + 512 + 8 * lane + 4);
    v[0] = a.x; v[1] = a.y; v[2] = a.z; v[3] = a.w; v[4] = b.x; v[5] = b.y; v[6] = b.z; v[7] = b.w; v[8] = c.x; v[9] = c.y; v[10] = c.z; v[11] = c.w; v[12] = d.x; v[13] = d.y; v[14] = d.z; v[15] = d.w;
}
__device__ __forceinline__ void ln16(float (&v)[16]) {
    float s = 0.f;
#pragma unroll
    for (int e = 0; e < 16; ++e) s += v[e];
    const float mean = wave_sum(s) * (1.f / D); float s2 = 0.f;
#pragma unroll
    for (int e = 0; e < 16; ++e) { v[e] -= mean; s2 += v[e] * v[e]; }
    const float rstd = 1.f / sqrtf(wave_sum(s2) * (1.f / D) + LN_EPS);
#pragma unroll
    for (int e = 0; e < 16; ++e) v[e] *= rstd;
}
__device__ __forceinline__ void store16bf(bf16* p, int lane, const float (&v)[16]) {
    v4u a, b; a.x = pk_bf16(v[0], v[1]); a.y = pk_bf16(v[2], v[3]); a.z = pk_bf16(v[4], v[5]); a.w = pk_bf16(v[6], v[7]);
    b.x = pk_bf16(v[8], v[9]); b.y = pk_bf16(v[10], v[11]); b.z = pk_bf16(v[12], v[13]); b.w = pk_bf16(v[14], v[15]);
    ((GAS v4u*)p)[lane] = a; ((GAS v4u*)p)[lane + 64] = b;
}
__device__ __forceinline__ void phase6_panel(Frame& F, const int pm) {
    float g1[16], b1[16];
    load16f(F.ln1_g, F.lane, g1); load16f(F.ln1_b, F.lane, b1);
    {   const int blk = pm * 8 + F.wave;
        const int r0 = blk * 32, b = r0 >> 11;
        float sh[16], sc[16];
        load16f(F.mod + (size_t)b * NMOD + 3072, F.lane, sh); load16f(F.mod + (size_t)b * NMOD + 4096, F.lane, sc);
#pragma unroll 2
        for (int r = 0; r < 32; ++r) {
            const GAS v4u* rr = (const GAS v4u*)(F.Rb + (size_t)(r0 + r) * D);
            float v[16]; unpack16(rr[F.lane], rr[F.lane + 64], v);
            ln16(v);
#pragma unroll
            for (int e = 0; e < 16; ++e) v[e] = v[e] * g1[e] + b1[e];
            ln16(v);
#pragma unroll
            for (int e = 0; e < 16; ++e) v[e] = v[e] * (1.0f + sc[e]) + sh[e];
            float mx = 0.f;
#pragma unroll
            for (int e = 0; e < 16; ++e) mx = fmaxf(mx, fabsf(v[e]));
            mx = wave_max(mx);
            const float inv = (mx > 0.f) ? 127.0f / mx : 0.f;
            GAS v2u* o8 = (GAS v2u*)(F.H2q + (size_t)(r0 + r) * D) + F.lane;
            o8[0] = (v2u){pk4_i8(v[0] * inv, v[1] * inv, v[2] * inv, v[3] * inv), pk4_i8(v[4] * inv, v[5] * inv, v[6] * inv, v[7] * inv)};
            o8[64] = (v2u){pk4_i8(v[8] * inv, v[9] * inv, v[10] * inv, v[11] * inv), pk4_i8(v[12] * inv, v[13] * inv, v[14] * inv, v[15] * inv)};
            if (F.lane == 0) F.SH[M + r0 + r] = mx * (1.0f / 127.0f);
        }
    }
}

#define CE_DESC(a, b) do { const float _x = vmaxf(a, b), _y = vminf(a, b); a = _x; b = _y; } while (0)
template <int N> __device__ __forceinline__ void bitonic_merge_desc(float (&v)[N]) {
#pragma unroll
    for (int j = N / 2; j > 0; j >>= 1) {
#pragma unroll
        for (int i = 0; i < N; ++i) { const int l = i ^ j; if (l > i) CE_DESC(v[i], v[l]); } }
}
template <int N> __device__ __forceinline__ void bitonic_sort_desc(float (&v)[N]) {
#pragma unroll
    for (int k = 2; k <= N; k <<= 1) {
#pragma unroll
        for (int j = k >> 1; j > 0; j >>= 1) {
#pragma unroll
            for (int i = 0; i < N; ++i) { const int l = i ^ j; if (l > i) { if ((i & k) == 0) CE_DESC(v[i], v[l]); else CE_DESC(v[l], v[i]); } } } }
}
__device__ __forceinline__ void top16_merge(float (&a)[16], const float (&b)[16]) {
#pragma unroll
    for (int i = 0; i < 16; ++i) a[i] = vmaxf(a[i], b[15 - i]);
    bitonic_merge_desc<16>(a);
}
__device__ __forceinline__ void top16_merge_lane(float (&a)[16], int mask) {
    float p[16]; const int l = lane_now();
#pragma unroll
    for (int i = 0; i < 16; ++i) p[i] = shx(a[i], mask, l);
    top16_merge(a, p);
}
typedef float f32x16 __attribute__((ext_vector_type(16)));
__device__ __forceinline__ void phase8b_block(Frame& F, size_t T0) {
    float* TOPS = F.TOPS;
    LAS float* scr = (LAS float*)F.lds;
    for (int k4 = 0; k4 < 4; ++k4) {
        const size_t gid = T0 * 8 + (size_t)k4 * 512 + F.tid;
        const GAS f32x4* t1 = (const GAS f32x4*)(TOPS + gid * 32);
        float L1[16], L2[16];
#pragma unroll
        for (int i = 0; i < 4; ++i) { const f32x4 x = t1[i], y = t1[4 + i];
            L1[4 * i] = x.x; L1[4 * i + 1] = x.y; L1[4 * i + 2] = x.z; L1[4 * i + 3] = x.w; L2[4 * i] = y.x; L2[4 * i + 1] = y.y; L2[4 * i + 2] = y.z; L2[4 * i + 3] = y.w; }
#pragma unroll
        for (int i = 0; i < 16; ++i) { scr[i * 512 + F.tid] = L1[i]; scr[(16 + i) * 512 + F.tid] = L2[i]; }
#define P8_CAND(a, b) __uint_as_float((__float_as_uint(L1[a] + L2[b]) & ~0xFFu) | (unsigned)(255 - ((a) * 16 + (b))))
        float top[16], g1[16], g2[16], g3[16];
#pragma unroll
        for (int b = 0; b < 16; ++b) top[b] = P8_CAND(0, b);
        {
            int n = 0;
#pragma unroll
            for (int i = 0; i < 16; ++i) { g1[i] = -__builtin_inff(); g2[i] = -__builtin_inff(); g3[i] = -__builtin_inff(); }
#pragma unroll
            for (int a = 1; a < 16; ++a)
#pragma unroll
                for (int b = 0; b < 16; ++b) if ((a + 1) * (b + 1) <= 16) { const float cv = P8_CAND(a, b);
                    if (n < 16) g1[n] = cv; else if (n < 32) g2[n - 16] = cv; else g3[n - 32] = cv; ++n; }
        }
#undef P8_CAND
        bitonic_sort_desc<16>(g1); bitonic_sort_desc<16>(g2); CE_DESC(g3[0], g3[1]);
        top16_merge(top, g1); top16_merge(top, g2); top16_merge(top, g3);
        float sv[16]; unsigned ex[16]; float mx = -__builtin_inff();
#pragma unroll
        for (int k = 0; k < 16; ++k) { const unsigned code = 255u - (__float_as_uint(top[k]) & 0xFFu); const float f1 = scr[(code >> 4) * 512 + F.tid], f2 = scr[(16 + (code & 15)) * 512 + F.tid];
            const unsigned i1 = 127u - (__float_as_uint(f1) & 0x7Fu), i2 = 127u - (__float_as_uint(f2) & 0x7Fu);
            sv[k] = f1 + f2; ex[k] = i1 * 128u + i2; mx = fmaxf(mx, sv[k]); }
        float den = 0.f;
#pragma unroll
        for (int k = 0; k < 16; ++k) { sv[k] = __builtin_amdgcn_exp2f((sv[k] - mx) * 1.4426950408889634f); den += sv[k]; }
        const float inv = 1.0f / den;
        GAS v4u* sp = (GAS v4u*)(F.sel + gid * 16);
#pragma unroll
        for (int i = 0; i < 4; ++i) { v4u o;
            o.x = (ex[4 * i + 0] << 18) | (__float_as_uint(sv[4 * i + 0] * inv) >> 13); o.y = (ex[4 * i + 1] << 18) | (__float_as_uint(sv[4 * i + 1] * inv) >> 13);
            o.z = (ex[4 * i + 2] << 18) | (__float_as_uint(sv[4 * i + 2] * inv) >> 13); o.w = (ex[4 * i + 3] << 18) | (__float_as_uint(sv[4 * i + 3] * inv) >> 13);
            sp[i] = o; }
    }
}

__device__ __forceinline__ void phase8_panel(Frame& F, const int blk) {
    const int lane = F.lane, c32 = lane & 31, hh = lane >> 5;
    float* TOPS = F.TOPS;
    {
        const size_t T0 = (size_t)blk * 256;
        for (int h = 0; h < 8; ++h) {
            const bf16* Q = ((h < 4) ? F.B1 : F.B2) + (h & 3) * 256;
            __syncthreads();
            {
                v4u kreg[8];
#pragma unroll
                for (int i = 0; i < 8; ++i) { const int q = F.tid + 512 * i; kreg[i] = *(const GAS v4u*)(F.Keys + (size_t)h * 32768 + (size_t)q * 8); }
#pragma unroll
                for (int i = 0; i < 8; ++i) { const int q = F.tid + 512 * i, pp = q >> 11, key = (q >> 4) & 127, c = q & 15;
                    *(LAS v4u*)(F.lds + pp * 32768 + key * 256 + 16 * (c ^ (key & 15))) = kreg[i]; }
            }
            __syncthreads();
            LAS unsigned char* qimg = F.lds + 65536 + F.wave * 8192;
            v4u qn[8];
            { const int tile0 = F.wave >> 1, p0 = F.wave & 1;
#pragma unroll
              for (int i = 0; i < 8; ++i) qn[i] = *(const GAS v4u*)(Q + (T0 + 32 * tile0 + 4 * i + (lane >> 4)) * D + p0 * 128 + 8 * (lane & 15)); }
#pragma unroll 1
            for (int j = 0; j < 2; ++j) {
                const int task = F.wave + 8 * j, tile = task >> 1, p = task & 1;
                const size_t tok = T0 + 32 * tile + c32;
#pragma unroll
                for (int i = 0; i < 8; ++i) { const int row = 4 * i + (lane >> 4); *(LAS v4u*)(qimg + row * 256 + 16 * ((lane & 15) ^ (row & 15))) = qn[i]; }
                if (j == 0) { const int task1 = F.wave + 8, tile1 = task1 >> 1, p1 = task1 & 1;
#pragma unroll
                    for (int i = 0; i < 8; ++i) qn[i] = *(const GAS v4u*)(Q + (T0 + 32 * tile1 + 4 * i + (lane >> 4)) * D + p1 * 128 + 8 * (lane & 15)); }
                bf16x8 bq[8];
#pragma unroll
                for (int ks = 0; ks < 8; ++ks) bq[ks] = *(const LAS bf16x8*)(qimg + c32 * 256 + 16 * ((2 * ks + hh) ^ (c32 & 15)));
#define P8_CHAIN(dst, kt) do { _Pragma("unroll") for (int r = 0; r < 16; ++r) dst[r] = 0.f; \
        _Pragma("unroll") for (int ks = 0; ks < 8; ++ks) { const int key = 32 * (kt) + c32; \
            const bf16x8 ak = *(const LAS bf16x8*)(F.lds + p * 32768 + key * 256 + 16 * ((2 * ks + hh) ^ (key & 15))); \
            dst = __builtin_amdgcn_mfma_f32_32x32x16_bf16(ak, bq[ks], dst, 0, 0, 0); } } while (0)
                float t[16], g[16];
                f32x16 accC, accN;
                unsigned hh4 = 4u * (unsigned)hh; asm volatile("" : "+v"(hh4));
                P8_CHAIN(accC, 0);
#pragma unroll
                for (int kt = 0; kt < 4; ++kt) {
                    if (kt < 3) P8_CHAIN(accN, kt + 1);
#pragma unroll
                    for (int r = 0; r < 16; ++r) { const int key0 = 32 * kt + (r & 3) + 8 * (r >> 2);
                        const unsigned bits = ((__float_as_uint(accC[r]) & ~0x7Fu) | (unsigned)(127 - key0)) - hh4;
                        if (kt == 0) t[r] = __uint_as_float(bits); else g[r] = __uint_as_float(bits); }
                    if (kt == 0) bitonic_sort_desc<16>(t); else { bitonic_sort_desc<16>(g); top16_merge(t, g); }
                    accC = accN;
                }
#undef P8_CHAIN
                top16_merge_lane(t, 32);
                if (hh == 0) { GAS f32x4* tp = (GAS f32x4*)(TOPS + ((tok * 8 + h) * 2 + p) * 16);
#pragma unroll
                    for (int i = 0; i < 4; ++i) tp[i] = (f32x4){t[4 * i], t[4 * i + 1], t[4 * i + 2], t[4 * i + 3]}; }
            }
        }
        asm volatile("s_waitcnt vmcnt(0)" ::: "memory");
        __syncthreads();
        F.lane = lane_now(); F.tid = F.wave * 64 + F.lane;
        phase8b_block(F, T0);
    }
}
constexpr int P9_NT = 8;
constexpr int P9_SRT = 0, P9_CF = 2048, P9_WB = 4096;
constexpr int P9_CH = 8;
template <class T> __device__ __forceinline__ T reduce8(const T (&p)[8], int lane) {
    const bool b5 = (lane & 32) != 0, b4 = (lane & 16) != 0, b3 = (lane & 8) != 0;
    T q[4], r[2], t;
#pragma unroll
    for (int i = 0; i < 4; ++i) { const T keep = b5 ? p[i + 4] : p[i], send = b5 ? p[i] : p[i + 4]; q[i] = keep + shx(send, 32, lane); }
#pragma unroll
    for (int i = 0; i < 2; ++i) { const T keep = b4 ? q[i + 2] : q[i], send = b4 ? q[i] : q[i + 2]; r[i] = keep + shx(send, 16, lane); }
    { const T keep = b3 ? r[1] : r[0], send = b3 ? r[0] : r[1]; t = keep + shx(send, 8, lane); }
    t += shx(t, 4, lane); t += shx(t, 2, lane); t += shx(t, 1, lane);
    return t;
}
__device__ __forceinline__ void p9_issue(const __amdgpu_buffer_rsrc_t rs, const LAS unsigned* srt, int pos, int lane, v4u (&rows)[P9_CH]) {
    const int ro = (int)((srt[pos + (lane & (P9_CH - 1))] >> 18) * 1024u), l16 = lane * 16;
#pragma unroll
    for (int e = 0; e < P9_CH; ++e) rows[e] = __builtin_amdgcn_raw_buffer_load_b128(rs, l16, __builtin_amdgcn_readlane(ro, e), 0);
}
__device__ __forceinline__ void p9_issue_sc(Frame& F, const LAS unsigned* srt, int pos, int lane, unsigned& wg, f32x2& scv) {
    wg = srt[pos + (lane >> 3)];
    scv = *(const GAS f32x2*)(F.SC + 2 * (size_t)(wg >> 18));
}
__device__ __forceinline__ void fp8x16_to_f32(const v4u w, f32x2 (&f)[8]) {
    f[0] = __builtin_amdgcn_cvt_pk_f32_fp8((int)w.x, false); f[1] = __builtin_amdgcn_cvt_pk_f32_fp8((int)w.x, true);
    f[2] = __builtin_amdgcn_cvt_pk_f32_fp8((int)w.y, false); f[3] = __builtin_amdgcn_cvt_pk_f32_fp8((int)w.y, true);
    f[4] = __builtin_amdgcn_cvt_pk_f32_fp8((int)w.z, false); f[5] = __builtin_amdgcn_cvt_pk_f32_fp8((int)w.z, true);
    f[6] = __builtin_amdgcn_cvt_pk_f32_fp8((int)w.w, false); f[7] = __builtin_amdgcn_cvt_pk_f32_fp8((int)w.w, true);
}
__device__ __forceinline__ void p9_compute_u(const v4u (&rows)[P9_CH], const unsigned wg, const f32x2 scv, const v4u xq, const float sx, LAS float* cf, int pos, int lane) {
    int p[P9_CH];
#pragma unroll
    for (int e = 0; e < P9_CH; ++e) { int a = __builtin_amdgcn_sdot4((int)rows[e].x, (int)xq.x, 0, false); a = __builtin_amdgcn_sdot4((int)rows[e].y, (int)xq.y, a, false);
        a = __builtin_amdgcn_sdot4((int)rows[e].z, (int)xq.z, a, false); p[e] = __builtin_amdgcn_sdot4((int)rows[e].w, (int)xq.w, a, false); }
    const float tot = (float)reduce8<int>(p, lane) * (scv.x * sx);
    const float coef = __uint_as_float((wg & 0x3FFFFu) << 13) * gelu_tanh(tot) * scv.y;
    if ((lane & 7) == 0) cf[pos + (lane >> 3)] = coef;
}
__device__ __forceinline__ void p9_compute_v(const v4u (&rows)[P9_CH], f32x2 (&acc)[8], const LAS float* cf, int pos, int lane) {
    const float cl = cf[pos + (lane & (P9_CH - 1))];
#pragma unroll
    for (int e = 0; e < P9_CH; ++e) {
        const float c = __uint_as_float((unsigned)__builtin_amdgcn_readlane((int)__float_as_uint(cl), e));
        f32x2 f[8]; fp8x16_to_f32(rows[e], f);
#pragma unroll
        for (int q = 0; q < 8; ++q) acc[q] += f[q] * c; }
}
#ifdef PROBE_PHASE
#define P9P_START(k) unsigned long long p9t_##k = 0; if ((k) == PROBE_PHASE) p9t_##k = __builtin_amdgcn_s_memrealtime();
#define P9P_END(k) if ((k) == PROBE_PHASE) { const unsigned long long t1 = __builtin_amdgcn_s_memrealtime(), dt = (t1 - p9t_##k) * PROBE_MULT; while (__builtin_amdgcn_s_memrealtime() - t1 < dt) __builtin_amdgcn_s_sleep(8); }
#else
#define P9P_START(k)
#define P9P_END(k)
#endif
constexpr int P9_TU = 16;
__device__ __forceinline__ void phase9(Frame& F, const XcdBarrier& bar) {
    LAS unsigned* srt = (LAS unsigned*)(F.lds + F.wave * 16384);
    LAS float* cf = (LAS float*)(F.lds + F.wave * 16384 + 8192);
    LAS float* sxl = (LAS float*)(F.lds + 131072 + F.wave * 64);
    const __amdgpu_buffer_rsrc_t rsU = __builtin_amdgcn_make_buffer_rsrc((void*)F.EU8, 0, NE * D, 0x00020000);
    const __amdgpu_buffer_rsrc_t rsV = __builtin_amdgcn_make_buffer_rsrc((void*)F.EV8, 0, NE * D, 0x00020000);
    constexpr int NJ = 128 / P9_CH;
    for (int blk = blockIdx.x; blk < M / 128; blk += F.G) {
#ifdef P9_ROUND_BARRIER
        if (MK_N_LAUNCHES == 1 && blk != (int)blockIdx.x && (M / 128) % F.G == 0) xcd_barrier(bar);
#endif
        P9P_START(90)
        int lane; asm volatile("v_mbcnt_lo_u32_b32 %0, -1, 0\n\tv_mbcnt_hi_u32_b32 %0, -1, %0" : "=v"(lane));
        const unsigned long long lt_mask = (1ull << lane) - 1ull;
        const size_t tb = (size_t)blk * 128 + F.wave * P9_TU;
        for (int t = 0; t < P9_TU; ++t) {
            const unsigned w0 = F.sel[(tb + t) * 128 + lane], w1 = F.sel[(tb + t) * 128 + 64 + lane];
            const unsigned b0 = w0 >> 28, b1 = w1 >> 28;
            unsigned base = 0, pos0 = 0, pos1 = 0;
#pragma unroll
            for (unsigned b = 0; b < 16u; ++b) {
                const unsigned long long m0 = __ballot(b0 == b), m1 = __ballot(b1 == b);
                const unsigned c0 = (unsigned)__popcll(m0), c1 = (unsigned)__popcll(m1);
                if (b0 == b) pos0 = base + (unsigned)__popcll(m0 & lt_mask);
                if (b1 == b) pos1 = base + c0 + (unsigned)__popcll(m1 & lt_mask);
                base += c0 + c1;
            }
            srt[t * 128 + pos0] = w0; srt[t * 128 + pos1] = w1;
        }
        v4u xq[P9_TU];
#pragma unroll
        for (int t = 0; t < P9_TU; ++t) xq[t] = *((const GAS v4u*)(F.H2q + (tb + t) * D) + lane);
        if (lane < P9_TU) sxl[lane] = F.SH[M + tb + lane];
        P9P_END(90)
        P9P_START(91)
        {
            v4u r0[P9_CH], r1[P9_CH]; unsigned w0_, w1_; f32x2 s0, s1;
            p9_issue_sc(F, srt, 0, lane, w0_, s0); p9_issue(rsU, srt, 0, lane, r0);
            for (int j = 0; j < NJ; ++j) {
                __builtin_amdgcn_s_barrier();
                const int pj = P9_CH * j, pn = P9_CH * ((j < NJ - 1) ? j + 1 : NJ - 1);
#define P9_USTEP(t, RI, WI, SI, RC, WC, SC_) { const int ti = (t) + 1; const int ip = (ti < P9_TU) ? (ti * 128 + pj) : ((ti - P9_TU) * 128 + pn); \
                    p9_issue_sc(F, srt, ip, lane, WI, SI); p9_issue(rsU, srt, ip, lane, RI); p9_compute_u(RC, WC, SC_, xq[t], sxl[t], cf, (t) * 128 + pj, lane); }
                P9_USTEP(0, r1, w1_, s1, r0, w0_, s0)  P9_USTEP(1, r0, w0_, s0, r1, w1_, s1)  P9_USTEP(2, r1, w1_, s1, r0, w0_, s0)  P9_USTEP(3, r0, w0_, s0, r1, w1_, s1)
                P9_USTEP(4, r1, w1_, s1, r0, w0_, s0)  P9_USTEP(5, r0, w0_, s0, r1, w1_, s1)  P9_USTEP(6, r1, w1_, s1, r0, w0_, s0)  P9_USTEP(7, r0, w0_, s0, r1, w1_, s1)
                P9_USTEP(8, r1, w1_, s1, r0, w0_, s0)  P9_USTEP(9, r0, w0_, s0, r1, w1_, s1)  P9_USTEP(10, r1, w1_, s1, r0, w0_, s0) P9_USTEP(11, r0, w0_, s0, r1, w1_, s1)
                P9_USTEP(12, r1, w1_, s1, r0, w0_, s0) P9_USTEP(13, r0, w0_, s0, r1, w1_, s1) P9_USTEP(14, r1, w1_, s1, r0, w0_, s0) P9_USTEP(15, r0, w0_, s0, r1, w1_, s1)
#undef P9_USTEP
            }
        }
        P9P_END(91)
        for (int sub = 0; sub < P9_TU / P9_NT; ++sub) {
            P9P_START(92)
            const LAS unsigned* srs = srt + sub * (P9_NT * 128); const LAS float* cfs = cf + sub * (P9_NT * 128);
            f32x2 acc[P9_NT][8];
#pragma unroll
            for (int tt = 0; tt < P9_NT; ++tt)
#pragma unroll
                for (int q = 0; q < 8; ++q) acc[tt][q] = (f32x2){0.f, 0.f};
            {
                v4u r0[P9_CH], r1[P9_CH];
                p9_issue(rsV, srs, 0, lane, r0);
                for (int j = 0; j < NJ; ++j) {
                    __builtin_amdgcn_s_barrier();
                    const int pj = P9_CH * j, pn = P9_CH * ((j < NJ - 1) ? j + 1 : NJ - 1);
                    p9_issue(rsV, srs, 128 + pj, lane, r1); p9_compute_v(r0, acc[0], cfs, pj, lane);
                    p9_issue(rsV, srs, 256 + pj, lane, r0); p9_compute_v(r1, acc[1], cfs, 128 + pj, lane);
                    p9_issue(rsV, srs, 384 + pj, lane, r1); p9_compute_v(r0, acc[2], cfs, 256 + pj, lane);
                    p9_issue(rsV, srs, 512 + pj, lane, r0); p9_compute_v(r1, acc[3], cfs, 384 + pj, lane);
                    p9_issue(rsV, srs, 640 + pj, lane, r1); p9_compute_v(r0, acc[4], cfs, 512 + pj, lane);
                    p9_issue(rsV, srs, 768 + pj, lane, r0); p9_compute_v(r1, acc[5], cfs, 640 + pj, lane);
                    p9_issue(rsV, srs, 896 + pj, lane, r1); p9_compute_v(r0, acc[6], cfs, 768 + pj, lane);
                    p9_issue(rsV, srs, pn, lane, r0);       p9_compute_v(r1, acc[7], cfs, 896 + pj, lane);
                }
            }
            P9P_END(92)
            P9P_START(93)
            {
                const size_t tb4 = tb + (size_t)sub * P9_NT;
                const int b = (int)(tb4 >> 11);
                float g2[16], l2g[16], l2b[16];
                {
                    const GAS f32x4* pg = (const GAS f32x4*)(F.mod + (size_t)b * NMOD + 5120) + 4 * lane; const GAS f32x4* pl = (const GAS f32x4*)F.ln2_g + 4 * lane; const GAS f32x4* pb = (const GAS f32x4*)F.ln2_b + 4 * lane;
#pragma unroll
                    for (int i = 0; i < 4; ++i) { const f32x4 a = pg[i], c = pl[i], e = pb[i];
                        g2[4 * i] = a.x; g2[4 * i + 1] = a.y; g2[4 * i + 2] = a.z; g2[4 * i + 3] = a.w; l2g[4 * i] = c.x; l2g[4 * i + 1] = c.y; l2g[4 * i + 2] = c.z; l2g[4 * i + 3] = c.w;
                        l2b[4 * i] = e.x; l2b[4 * i + 1] = e.y; l2b[4 * i + 2] = e.z; l2b[4 * i + 3] = e.w; }
                }
#pragma unroll
                for (int tt = 0; tt < P9_NT; ++tt) {
                    const size_t tok = tb4 + tt;
                    const GAS v4u* xr = (const GAS v4u*)(F.Rb + tok * D) + 2 * lane;
                    float y[16]; unpack16(xr[0], xr[1], y);
                    ln16(y);
                    {
                        const GAS f32x4* p1g = (const GAS f32x4*)F.ln1_g + 4 * lane; const GAS f32x4* p1b = (const GAS f32x4*)F.ln1_b + 4 * lane;
#pragma unroll
                        for (int i = 0; i < 4; ++i) { const f32x4 gg = p1g[i], bb = p1b[i];
                            y[4 * i] = y[4 * i] * gg.x + bb.x; y[4 * i + 1] = y[4 * i + 1] * gg.y + bb.y; y[4 * i + 2] = y[4 * i + 2] * gg.z + bb.z; y[4 * i + 3] = y[4 * i + 3] * gg.w + bb.w; }
                    }
#pragma unroll
                    for (int e = 0; e < 8; ++e) { y[2 * e] = ALPHA * y[2 * e] + g2[2 * e] * acc[tt][e].x; y[2 * e + 1] = ALPHA * y[2 * e + 1] + g2[2 * e + 1] * acc[tt][e].y; }
                    ln16(y);
#pragma unroll
                    for (int e = 0; e < 16; ++e) y[e] = y[e] * l2g[e] + l2b[e];
                    GAS f32x4* op = (GAS f32x4*)(F.out + tok * D) + 4 * lane;
                    op[0] = (f32x4){y[0], y[1], y[2], y[3]}; op[1] = (f32x4){y[4], y[5], y[6], y[7]}; op[2] = (f32x4){y[8], y[9], y[10], y[11]}; op[3] = (f32x4){y[12], y[13], y[14], y[15]};
                }
            }
            P9P_END(93)
        }
    }
}

struct Args { const float* in[21]; float* out; unsigned char* ws; int ph_lo, ph_hi, li, pad; };
__global__ void __launch_bounds__(512, 2) fwd(Args args) {
    extern __shared__ __attribute__((aligned(16))) unsigned char lds[];
    Frame F;
    F.lds = (LAS unsigned char*)lds;
    volatile LAS unsigned* MISC = (volatile LAS unsigned*)(F.lds + MISC_OFF);
    F.tid = threadIdx.x; F.lane = F.tid & 63; F.wave = __builtin_amdgcn_readfirstlane(F.tid >> 6);
    F.G = gridDim.x; F.gw = blockIdx.x * 8 + F.wave; F.NGW = F.G * 8;
    unsigned char* ws = args.ws;
    gu32* ctl = (gu32*)(ws + WS_CTL);
    F.x = args.in[0]; F.c = args.in[1]; F.w_cond = args.in[2]; F.b_cond = args.in[3]; F.w_in = args.in[4]; F.gln_g = args.in[5]; F.gln_b = args.in[6];
    F.w_sp = args.in[7]; F.b_sp = args.in[8]; F.conv_w = args.in[9]; F.p_a = args.in[10]; F.p_b = args.in[11]; F.w_o = args.in[12]; F.ln1_g = args.in[13]; F.ln1_b = args.in[14];
    F.w_q = args.in[15]; F.keys = args.in[16]; F.eu = args.in[17]; F.ev = args.in[18]; F.ln2_g = args.in[19]; F.ln2_b = args.in[20];
    F.out = args.out; F.mod = (float*)(ws + WS_MOD);
    F.Win_t = (bf16*)(ws + WS_WIN); F.Pa_t = (bf16*)(ws + WS_PA); F.Pb_t = (bf16*)(ws + WS_PB); F.Wo_t = (bf16*)(ws + WS_WO); F.Wq_t = (bf16*)(ws + WS_WQ);
    F.Keys = (bf16*)(ws + WS_KEYS); F.Wsp = (bf16*)(ws + WS_WSP); F.EU = (bf16*)(ws + WS_EU); F.EV = (bf16*)(ws + WS_EV); F.sel = (unsigned*)(ws + WS_SEL); F.zrow = (const bf16*)(ws + WS_CTL + 512 * 1024); F.EU8 = ws + WS_EU; F.EV8 = ws + WS_EV; F.SC = (float*)(ws + 28 * MiB); F.ST = (float*)(ws + 48 * MiB);
    F.CM = (unsigned*)(ws + WS_CM); F.SW = (float*)(ws + WS_SW); F.SH = (float*)(ws + WS_SH);
    F.H = (bf16*)args.out;
    F.TOPS = (float*)args.out; F.M8 = (unsigned char*)args.out + (size_t)64 * MiB;
    F.Rb = (bf16*)(ws + 3 * WS_U); F.H2q = ws + 5 * WS_U;
    F.B1 = (bf16*)(ws + 1 * WS_U); F.B2 = (bf16*)(ws + 2 * WS_U); F.B3 = (bf16*)(ws + 3 * WS_U); F.B4 = (bf16*)(ws + 4 * WS_U); F.B5 = (bf16*)(ws + 5 * WS_U); F.B6 = (bf16*)(ws + 6 * WS_U);
    for (int u = F.tid; u < (LDS_BYTES - LDSCTL_OFF) / 4; u += 512) ((LAS unsigned*)(F.lds + LDSCTL_OFF))[u] = 0u;
    __syncthreads();
    XcdBarrier bar; bar.bar = (unsigned*)(ctl + CW_BAR); bar.x = 0; bar.st = nullptr; bar.wave = F.wave;
    if (MK_N_LAUNCHES == 1) bar = xcd_barrier_post((unsigned*)(ctl + CW_BAR), MISC + 8, F.wave);
    const int lo = args.ph_lo, hi = args.ph_hi;
#define IN(k) (lo <= (k) && (k) < hi)
#ifdef PROBE_PHASE
    unsigned long long pr_t0 = 0;
#define PSTART(k) do { if ((k) == PROBE_PHASE) pr_t0 = __builtin_amdgcn_s_memrealtime(); } while (0)
#define PEND(k) do { if ((k) == PROBE_PHASE) { const unsigned long long t1 = __builtin_amdgcn_s_memrealtime(), dt = (t1 - pr_t0) * PROBE_MULT; while (__builtin_amdgcn_s_memrealtime() - t1 < dt) __builtin_amdgcn_s_sleep(8); } } while (0)
#else
#define PSTART(k) do {} while (0)
#define PEND(k) do {} while (0)
#endif
#define SEAM(k) do { PEND(k); if (IN(k) && IN((k) + 1)) xcd_barrier(bar); PSTART((k) + 1); } while (0)

    PSTART(0);
    if (IN(0)) { phase0(F); SEAM(0); }
    if (IN(1)) { phase1(F); SEAM(1); }
    if (IN(2)) {
        pg8::Gemm g{F.H, F.Win_t, nullptr, nullptr, M, NIN, D}; pg8::StaticOrder S; S.init(M, NIN, F.G, (int)blockIdx.x);
        pg8::EpiProj E{F.B1, F.ST, F.SH, F.SW};
        pg8::gemm_phase<pg8::EpiProj, pg8::StaticOrder, true, true, 2>(F.lds, g, S, E, F.wave);
        SEAM(2);
    }
    if (IN(3)) {
        LAS unsigned* RM = (LAS unsigned*)(F.lds + 131072);
        float* SHm = (float*)((unsigned char*)F.SH + MiB);
#define OPQ() do { F.lane = lane_now(); F.tid = F.wave * 64 + F.lane; } while (0)
        for (int pm = blockIdx.x; pm < M / 256; pm += F.G) {
            OPQ();
            phase3_panel(F, pm);
            asm volatile("s_waitcnt vmcnt(0)" ::: "memory");
            __syncthreads();
            PEND(3); PSTART(4); OPQ();
            if (F.tid < 256) RM[F.tid] = 0u;
            __syncthreads();
            {   pg8::Gemm g{F.B5, F.Pa_t, (const pg8::bf16_t*)((const unsigned char*)F.B5 + (size_t)64 * MiB), F.Pb_t, M, D, D}; pg8::PanelDual S{pm};
                pg8::EpiDual E{F.B2, F.B6, F.B6 + SEG, F.SH + 2 * M, F.SW + 10240, RM};
                pg8::gemm_phase<pg8::EpiDual, pg8::PanelDual, true, true, 2>(F.lds, g, S, E, F.wave); }
            __syncthreads();
#pragma unroll 4
            for (int r = 0; r < 32; ++r) {
                const int pr = 32 * F.wave + r; const size_t row = (size_t)pm * 256 + pr;
                const float mx = __uint_as_float(RM[pr]), inv = (mx > 0.f) ? 127.0f / mx : 0.f;
                const GAS v4u* mp = (const GAS v4u*)(F.B2 + row * D) + F.lane;
                const v4u a = mp[0], b = mp[64];
                GAS v2u* o8 = (GAS v2u*)(F.M8 + row * D) + F.lane;
                o8[0] = (v2u){pk4_i8(bf_lo(a.x) * inv, bf_hi(a.x) * inv, bf_lo(a.y) * inv, bf_hi(a.y) * inv), pk4_i8(bf_lo(a.z) * inv, bf_hi(a.z) * inv, bf_lo(a.w) * inv, bf_hi(a.w) * inv)};
                o8[64] = (v2u){pk4_i8(bf_lo(b.x) * inv, bf_hi(b.x) * inv, bf_lo(b.y) * inv, bf_hi(b.y) * inv), pk4_i8(bf_lo(b.z) * inv, bf_hi(b.z) * inv, bf_lo(b.w) * inv, bf_hi(b.w) * inv)};
                if (F.lane == 0) SHm[row] = mx * (1.0f / 127.0f);
            }
            asm volatile("s_waitcnt vmcnt(0)" ::: "memory");
            __syncthreads();
            PEND(4); PSTART(5); OPQ();
            {   pg8::Gemm g{(const pg8::bf16_t*)F.M8, F.Wo_t, nullptr, nullptr, M, D, D}; pg8::PanelOrder S{pm, 4};
                pg8::EpiRes E{F.Rb, F.x, F.mod, SHm, F.SW + 12288};
                pg8::gemm_phase<pg8::EpiRes, pg8::PanelOrder, true, true, 2>(F.lds, g, S, E, F.wave); }
            __syncthreads();
            PEND(5); PSTART(6); OPQ();
            phase6_panel(F, pm);
            asm volatile("s_waitcnt vmcnt(0)" ::: "memory");
            __syncthreads();
            PEND(6); PSTART(7); OPQ();
            {   pg8::Gemm g{(const pg8::bf16_t*)F.H2q, F.Wq_t, nullptr, nullptr, M, NQ, D}; pg8::PanelOrder S{pm, 8};
                pg8::EpiPlainI8 E{F.B1, F.B2, D, F.SH + M, F.SW + 8192};
                pg8::gemm_phase<pg8::EpiPlainI8, pg8::PanelOrder, true, true, 2>(F.lds, g, S, E, F.wave); }
            __syncthreads();
            PEND(7); PSTART(8); OPQ();
            phase8_panel(F, pm);
            __syncthreads();
            PEND(8); PSTART(3);
        }
        if (IN(8) && IN(9)) xcd_barrier(bar);
        PSTART(9);
    }
    if (IN(9)) { OPQ(); phase9(F, bar); PEND(9); }
#undef IN
#undef SEAM
}

extern "C" void kernel_launch(void* const* d_in, const int* in_sizes, int n_in, void* d_out, int out_size, void* d_ws, size_t ws_size, hipStream_t stream) {
    static int grid = 0;
    if (grid == 0) {
        if (n_in != 21 || in_sizes[0] != M * D || out_size != M * D || ws_size < WS_END) { fprintf(stderr, "kernel_launch: unexpected shapes (n_in %d, in0 %d, out %d, ws %zu); nothing launched\n", n_in, n_in > 0 ? in_sizes[0] : -1, out_size, ws_size); grid = -1; return; }
        int dev = 0, cus = 0, per_cu = 0;
        if (hipGetDevice(&dev) != hipSuccess || hipDeviceGetAttribute(&cus, hipDeviceAttributeMultiprocessorCount, dev) != hipSuccess) { grid = -1; return; }
        if (hipFuncSetAttribute((const void*)fwd, hipFuncAttributeMaxDynamicSharedMemorySize, LDS_BYTES) != hipSuccess) { fprintf(stderr, "kernel_launch: hipFuncSetAttribute failed\n"); grid = -1; return; }
        if (hipOccupancyMaxActiveBlocksPerMultiprocessor(&per_cu, (const void*)fwd, 512, LDS_BYTES) != hipSuccess || per_cu < 1) { fprintf(stderr, "kernel_launch: occupancy query reports %d workgroups per CU\n", per_cu); }
        (void)hipGetLastError();
        grid = cus;
    }
    if (grid < 0) return;
    if (hipMemsetAsync((char*)d_ws + WS_CTL, 0, CTL_ZERO_BYTES, stream) != hipSuccess) return;
    Args a{};
    for (int i = 0; i < 21; ++i) a.in[i] = (const float*)d_in[i];
    a.out = (float*)d_out; a.ws = (unsigned char*)d_ws;
    for (int li = 0; li < MK_N_LAUNCHES; ++li) {
        a.ph_lo = (MK_N_LAUNCHES == 1) ? 0 : li; a.ph_hi = (MK_N_LAUNCHES == 1) ? NPHASE : li + 1; a.li = li;
        hipLaunchKernelGGL(fwd, dim3(grid), dim3(512), LDS_BYTES, stream, a);
    }
}
```

```cpp
#include <hip/hip_runtime.h>
#include <cstdio>
#include <cstdint>

#define P9_ROUND_BARRIER 1
#ifndef MK_N_LAUNCHES
#define MK_N_LAUNCHES 1
#endif

#define GAS __attribute__((address_space(1)))
#define LAS __attribute__((address_space(3)))
#define PG8_LAS __attribute__((address_space(3)))
typedef unsigned short bf16;
typedef unsigned v4u __attribute__((ext_vector_type(4)));
typedef unsigned v2u __attribute__((ext_vector_type(2)));
typedef float f32x4 __attribute__((ext_vector_type(4)));
typedef float f32x2 __attribute__((ext_vector_type(2)));
typedef short bf16x8 __attribute__((ext_vector_type(8)));
typedef short s16x4 __attribute__((ext_vector_type(4)));
typedef __bf16 bf16x2 __attribute__((ext_vector_type(2)));
typedef GAS unsigned gu32;

constexpr int D = 1024, BATCH = 32, SEQ = 2048, M = BATCH * SEQ;
constexpr int NIN = 7168, NQ = 2048, NE = 16384, NMOD = 6144;
constexpr float LN_EPS = 1e-5f, ALPHA = 1.189207115002721f;
constexpr int NPHASE = 10;

constexpr size_t MiB = 1u << 20;
constexpr size_t WS_CTL = 0, CTL_ZERO_BYTES = 1 * MiB;
constexpr size_t WS_MOD = 1 * MiB;
constexpr size_t WS_WIN = 2 * MiB, WS_PA = 16 * MiB, WS_PB = 18 * MiB, WS_WO = 20 * MiB, WS_WQ = 22 * MiB, WS_KEYS = 26 * MiB, WS_WSP = 26 * MiB + 512 * 1024;
constexpr size_t WS_CM = WS_CTL + 768 * 1024;
constexpr size_t WS_SW = 29 * MiB, WS_SH = 30 * MiB;
constexpr size_t WS_EU = 32 * MiB, WS_EV = 64 * MiB, WS_SEL = 96 * MiB;
constexpr size_t WS_U = 128 * MiB;
constexpr size_t WS_END = 1024 * MiB;
constexpr size_t SEG = (size_t)M * D;
constexpr int CW_TMO = 0, CW_BAR = 4096;

constexpr int RING_BYTES = 131072;
constexpr int LDSCTL_OFF = 155648, MISC_OFF = LDSCTL_OFF + 320;
constexpr int LDS_BYTES = 156672;

__device__ __forceinline__ int lane_now() { int l; asm volatile("v_mbcnt_lo_u32_b32 %0, -1, 0\n\tv_mbcnt_hi_u32_b32 %0, -1, %0" : "=v"(l)); return l; }
__device__ __forceinline__ float bf_lo(unsigned w) { return __uint_as_float(w << 16); }
__device__ __forceinline__ float bf_hi(unsigned w) { return __uint_as_float(w & 0xffff0000u); }
__device__ __forceinline__ unsigned pk_bf16(float lo, float hi) { unsigned r; asm("v_cvt_pk_bf16_f32 %0, %1, %2" : "=v"(r) : "v"(lo), "v"(hi)); return r; }
__device__ __forceinline__ float vmaxf(float a, float b) { float r; asm("v_max_f32 %0, %1, %2" : "=v"(r) : "v"(a), "v"(b)); return r; }
__device__ __forceinline__ float vminf(float a, float b) { float r; asm("v_min_f32 %0, %1, %2" : "=v"(r) : "v"(a), "v"(b)); return r; }
__device__ __forceinline__ float gelu_tanh(float x) {
    const float u = x * (1.5957691216057308f + 0.07135481627260025f * x * x);
    return x * __builtin_amdgcn_rcpf(1.0f + __builtin_amdgcn_exp2f(-1.4426950408889634f * u));
}
__device__ __forceinline__ float sigmoidf_(float x) { return __builtin_amdgcn_rcpf(1.0f + __builtin_amdgcn_exp2f(-1.4426950408889634f * x)); }
__device__ __forceinline__ float shx(float v, int m) { const int l = lane_now(); return __builtin_bit_cast(float, __builtin_amdgcn_ds_bpermute((l ^ m) << 2, __builtin_bit_cast(int, v))); }
__device__ __forceinline__ float shx(float v, int m, int l) { return __builtin_bit_cast(float, __builtin_amdgcn_ds_bpermute((l ^ m) << 2, __builtin_bit_cast(int, v))); }
__device__ __forceinline__ int shx(int v, int m, int l) { return __builtin_amdgcn_ds_bpermute((l ^ m) << 2, v); }
#define WS_DPP(v, ctrl) __builtin_bit_cast(float, __builtin_amdgcn_update_dpp(0, __builtin_bit_cast(int, v), ctrl, 0xF, 0xF, false))
__device__ __forceinline__ float wave_sum(float v) {
    v += WS_DPP(v, 0xB1); v += WS_DPP(v, 0x4E); v += WS_DPP(v, 0x141); v += WS_DPP(v, 0x140);
    const int b = __builtin_bit_cast(int, v);
    const float r0 = __builtin_bit_cast(float, __builtin_amdgcn_readlane(b, 0)), r1 = __builtin_bit_cast(float, __builtin_amdgcn_readlane(b, 16));
    const float r2 = __builtin_bit_cast(float, __builtin_amdgcn_readlane(b, 32)), r3 = __builtin_bit_cast(float, __builtin_amdgcn_readlane(b, 48));
    return (r0 + r1) + (r2 + r3);
}
__device__ __forceinline__ float wave_max(float v) {
    v = fmaxf(v, WS_DPP(v, 0xB1)); v = fmaxf(v, WS_DPP(v, 0x4E)); v = fmaxf(v, WS_DPP(v, 0x141)); v = fmaxf(v, WS_DPP(v, 0x140));
    const int b = __builtin_bit_cast(int, v);
    const float r0 = __builtin_bit_cast(float, __builtin_amdgcn_readlane(b, 0)), r1 = __builtin_bit_cast(float, __builtin_amdgcn_readlane(b, 16));
    const float r2 = __builtin_bit_cast(float, __builtin_amdgcn_readlane(b, 32)), r3 = __builtin_bit_cast(float, __builtin_amdgcn_readlane(b, 48));
    return fmaxf(fmaxf(r0, r1), fmaxf(r2, r3));
}
__device__ __forceinline__ unsigned pk4_i8(float a, float b, float c, float d) {
    const unsigned q0 = (unsigned)__float2int_rn(a) & 0xFFu, q1 = (unsigned)__float2int_rn(b) & 0xFFu, q2 = (unsigned)__float2int_rn(c) & 0xFFu, q3 = (unsigned)__float2int_rn(d);
    return q0 | (q1 << 8) | (q2 << 16) | (q3 << 24);
}
__device__ __forceinline__ float dot2_bf16(unsigned w, unsigned x, float acc) { return __builtin_amdgcn_fdot2_f32_bf16(__builtin_bit_cast(bf16x2, w), __builtin_bit_cast(bf16x2, x), acc, false); }
#define LDS_WAIT() asm volatile("s_waitcnt lgkmcnt(0)" ::: "memory")

namespace pg8 {
typedef unsigned short bf16_t;
typedef unsigned u32x4 __attribute__((ext_vector_type(4)));
constexpr int BM = 256, BK = 64, HALF = 128, HTB = HALF * BK * 2, STAGE_BYTES = 8 * HTB, NXCD = 8, WGM = 8;
__host__ __device__ __forceinline__ int lds_byte(int r, int c) { const int st = (r >> 4) * 2 + (c >> 5), rr = r & 15, cc = c & 31, ob = rr * 64 + cc * 2; return st * 1024 + (ob ^ (((ob >> 9) & 1) << 5)); }
__host__ __device__ __forceinline__ void stage_rc(int b, int& R, int& C) { const int st = b / 1024, sb = b % 1024, swz = sb ^ (((sb >> 9) & 1) << 5); R = (st >> 1) * 16 + swz / 64; C = (st & 1) * 32 + (swz % 64) / 2; }
__host__ __device__ __forceinline__ int perm32(int rho) { const int n = rho >> 4, i = rho & 15; return 8 * (i >> 2) + 4 * n + (i & 3); }

struct Unit { int pm, pn, z; };
struct Gemm { const bf16_t* A; const bf16_t* Bt; const bf16_t* A2; const bf16_t* Bt2; int M, N, K; };

__host__ __device__ __forceinline__ void tile_of(int wgid, int nwg, int nM, int nN, Unit& u) {
    { const int q = nwg / NXCD, r = nwg % NXCD, xcd = wgid % NXCD, off = wgid / NXCD; wgid = (xcd < r ? xcd * (q + 1) : r * (q + 1) + (xcd - r) * q) + off; }
    const int nig = WGM * nN, gid = wgid / nig, fm = gid * WGM, gsz = (nM - fm) < WGM ? (nM - fm) : WGM;
    u.pm = fm + ((wgid % nig) % gsz); u.pn = (wgid % nig) / gsz;
}
struct StaticOrder {
    int nM, nN, nwg, G, c;
    __host__ __device__ void init(int M_, int N_, int G_, int c_) { nM = M_ / BM; nN = N_ / BM; nwg = nM * nN; G = G_; c = c_; }
    __host__ __device__ bool next(int i, Unit& u) const {
        const long L = (long)i * G + c; if (L >= nwg) return false;
        tile_of((int)L, nwg, nM, nN, u); u.z = 0; return true;
    }
    __device__ __forceinline__ void a_ready(const Unit&) const {}
    __device__ __forceinline__ void done(const Unit&) const {}
};
struct RowOrder {
    int nM, nN, G, c;
    __host__ __device__ void init(int M_, int N_, int G_, int c_) { nM = M_ / BM; nN = N_ / BM; G = G_; c = c_; }
    __host__ __device__ bool next(int i, Unit& u) const { const int pm = c + G * (i / nN); if (pm >= nM) return false; u.pm = pm; u.pn = i % nN; u.z = 0; return true; }
    __device__ __forceinline__ void a_ready(const Unit&) const {}
    __device__ __forceinline__ void done(const Unit&) const {}
};
struct DualOrder {
    int nM, nN, nwg, G, c;
    __host__ __device__ void init(int M_, int N_, int G_, int c_) { nM = M_ / BM; nN = N_ / BM; nwg = nM * nN; G = G_; c = c_; }
    __host__ __device__ bool next(int i, Unit& u) const {
        const long L = (long)(i >> 1) * G + c; if (L >= nwg) return false;
        tile_of((int)L, nwg, nM, nN, u); u.z = i & 1; return true;
    }
    __device__ __forceinline__ void a_ready(const Unit&) const {}
    __device__ __forceinline__ void done(const Unit&) const {}
};

typedef int v8i_t __attribute__((ext_vector_type(8)));
typedef int v4i_t __attribute__((ext_vector_type(4)));
__device__ __forceinline__ v8i_t cat8(bf16x8 a, bf16x8 b) { return __builtin_shufflevector(__builtin_bit_cast(v4i_t, a), __builtin_bit_cast(v4i_t, b), 0, 1, 2, 3, 4, 5, 6, 7); }
struct PanelDual {
    int pm, rot;
    __host__ __device__ bool next(int i, Unit& u) const { if (i >= 8) return false; u.pm = pm; u.pn = ((i >> 1) + rot) & 3; u.z = i & 1; return true; }
    __device__ __forceinline__ void a_ready(const Unit&) const {}
    __device__ __forceinline__ void done(const Unit&) const {}
};
struct PanelOrder {
    int pm, nN, rot;
    __host__ __device__ bool next(int i, Unit& u) const { if (i >= nN) return false; u.pm = pm; u.pn = (i + rot) & (nN - 1); u.z = 0; return true; }
    __device__ __forceinline__ void a_ready(const Unit&) const {}
    __device__ __forceinline__ void done(const Unit&) const {}
};
template <class Epi, class Sched, bool ALIGN_EPI = false, bool SP2 = false, int MODE = 0>
__device__ __forceinline__ void gemm_phase(PG8_LAS unsigned char* lds, const Gemm g, const Sched& S, const Epi& E, const int wid) {
    const int lane = lane_now(), tid = wid * 64 + lane, wr = wid >> 2, wc = wid & 3, fr = lane & 15, fq = lane >> 4;
    constexpr bool FP8 = (MODE == 1); constexpr int ES = MODE ? 1 : 2;
    const int K = g.K, nt = K * ES / (BK * 2);
    unsigned voffA[2], voffB[2];
#pragma unroll
    for (int i = 0; i < 2; ++i) { int R, C; stage_rc(tid * 16 + i * 8192, R, C); const int Rb = Epi::PERM ? ((R & ~31) + perm32(R & 31)) : R;
        voffA[i] = (unsigned)(R * K * ES + C * 2); voffB[i] = (unsigned)(Rb * K * ES + C * 2); }
    const size_t kstep = (size_t)(BK * 2);
    const size_t hstep = (size_t)HALF * K * ES;
    const size_t tstep = 2 * hstep;
    const unsigned ldsw = (unsigned)wid * 1024u;
    const int aoff = lds_byte(wr * 64 + fr, fq * 8), boff = lds_byte(wc * 32 + fr, fq * 8);
#define PG8_SA(b, h) (((b) * 2 + (h)) * HTB)
#define PG8_SB(b, h) ((4 + (b) * 2 + (h)) * HTB)
#define PG8_STAGE(bufoff, gbase, voff) do { _Pragma("unroll") for (int _i = 0; _i < 2; ++_i) { unsigned _v = (voff)[_i]; asm volatile("" : "+v"(_v));   \
        __builtin_amdgcn_global_load_lds((const unsigned*)((const char*)(gbase) + _v), (PG8_LAS unsigned*)(lds + (bufoff) + ldsw + _i * 8192), 16, 0, 0); } } while (0)
#define PG8_LDA(dst, b, h) do { _Pragma("unroll") for (int m = 0; m < 4; ++m) _Pragma("unroll") for (int k = 0; k < 2; ++k) dst[m][k] = *(const PG8_LAS bf16x8*)(lds + PG8_SA(b, h) + aoff + m * 2048 + k * 1024); } while (0)
#define PG8_LDB(dst, b, h) do { _Pragma("unroll") for (int n = 0; n < 2; ++n) _Pragma("unroll") for (int k = 0; k < 2; ++k) dst[n][k] = *(const PG8_LAS bf16x8*)(lds + PG8_SB(b, h) + boff + n * 2048 + k * 1024); } while (0)
#define PG8_MMA(ai, bj, At, Bt) do { __builtin_amdgcn_s_setprio(1); \
        if constexpr (FP8) { _Pragma("unroll") for (int m = 0; m < 4; ++m) _Pragma("unroll") for (int n = 0; n < 2; ++n) \
            asm volatile("v_mfma_f32_16x16x128_f8f6f4 %0, %1, %2, %0" : "+v"(acc[ai][bj][m][n]) : "v"(cat8(Bt[n][0], Bt[n][1])), "v"(cat8(At[m][0], At[m][1]))); } \
        else if constexpr (MODE == 2) { _Pragma("unroll") for (int m = 0; m < 4; ++m) _Pragma("unroll") for (int n = 0; n < 2; ++n) _Pragma("unroll") for (int k = 0; k < 2; ++k) \
            acc[ai][bj][m][n] = __builtin_bit_cast(f32x4, __builtin_amdgcn_mfma_i32_16x16x64_i8(__builtin_bit_cast(v4i_t, Bt[n][k]), __builtin_bit_cast(v4i_t, At[m][k]), __builtin_bit_cast(v4i_t, acc[ai][bj][m][n]), 0, 0, 0)); } \
        else { _Pragma("unroll") for (int m = 0; m < 4; ++m) _Pragma("unroll") for (int n = 0; n < 2; ++n) _Pragma("unroll") for (int k = 0; k < 2; ++k) \
            acc[ai][bj][m][n] = __builtin_amdgcn_mfma_f32_16x16x32_bf16(Bt[n][k], At[m][k], acc[ai][bj][m][n], 0, 0, 0); } \
        __builtin_amdgcn_s_setprio(0); } while (0)
#define PG8_WAIT_V(n) asm volatile("s_waitcnt vmcnt(" #n ")" ::: "memory")
#define PG8_WAIT_L(n) asm volatile("s_waitcnt lgkmcnt(" #n ")" ::: "memory")
#define PG8_BAR __builtin_amdgcn_s_barrier()
#define PG8_SCHED __builtin_amdgcn_sched_barrier(0)
#define PG8_ABASE(u) ((const char*)((u).z ? g.A2 : g.A) + (size_t)(u).pm * tstep)
#define PG8_BBASE(u) ((const char*)((u).z ? g.Bt2 : g.Bt) + (size_t)(u).pn * tstep)
    Unit cur, nxt; int ui = 0;
    if (!S.next(0, cur)) return;
    f32x4 acc[2][2][4][2];
#pragma unroll
    for (int a = 0; a < 2; ++a)
#pragma unroll
        for (int b = 0; b < 2; ++b)
#pragma unroll
            for (int m = 0; m < 4; ++m)
#pragma unroll
                for (int n = 0; n < 2; ++n) acc[a][b][m][n] = (f32x4){0.f, 0.f, 0.f, 0.f};
    bf16x8 At[4][2], B0[2][2], B1[2][2];
    const char* cA = PG8_ABASE(cur); const char* cB = PG8_BBASE(cur);
    S.a_ready(cur);
    if constexpr (SP2) {
        PG8_STAGE(PG8_SB(0, 0), cB, voffB); PG8_STAGE(PG8_SB(0, 1), cB + hstep, voffB); PG8_STAGE(PG8_SA(0, 0), cA, voffA); PG8_STAGE(PG8_SA(0, 1), cA + hstep, voffA);
        if (wr == 1) PG8_BAR;
        PG8_WAIT_V(2); PG8_BAR;
        PG8_STAGE(PG8_SB(1, 0), cB + kstep, voffB); PG8_STAGE(PG8_SA(1, 0), cA + kstep, voffA); PG8_STAGE(PG8_SB(1, 1), cB + hstep + kstep, voffB);
        PG8_WAIT_V(6); PG8_BAR;
    } else {
        PG8_STAGE(PG8_SB(0, 0), cB, voffB); PG8_STAGE(PG8_SA(0, 0), cA, voffA); PG8_STAGE(PG8_SB(0, 1), cB + hstep, voffB); PG8_STAGE(PG8_SA(0, 1), cA + hstep, voffA);
        if (wr == 1) PG8_BAR;
        PG8_WAIT_V(4); PG8_BAR;
        PG8_STAGE(PG8_SB(1, 0), cB + kstep, voffB); PG8_STAGE(PG8_SA(1, 0), cA + kstep, voffA); PG8_STAGE(PG8_SB(1, 1), cB + hstep + kstep, voffB);
        PG8_WAIT_V(6); PG8_BAR;
    }
    for (;;) {
        const bool has_next = S.next(ui + 1, nxt);
        const char* nA = has_next ? PG8_ABASE(nxt) : cA; const char* nB = has_next ? PG8_BBASE(nxt) : cB;
#pragma nounroll
        for (int t = 0; t < nt; t += 2) {
            const bool last = (t == nt - 2);
            const char* a1 = cA + (size_t)(t + 1) * kstep;
            const char* a2 = last ? nA : cA + (size_t)(t + 2) * kstep; const char* b2 = last ? nB : cB + (size_t)(t + 2) * kstep;
            const char* a3 = a2 + kstep; const char* b3 = b2 + kstep;
            if (last && has_next) S.a_ready(nxt);
            if constexpr (SP2) {
            PG8_LDB(B0, 0, 0); PG8_LDB(B1, 0, 1); PG8_SCHED; PG8_LDA(At, 0, 0); PG8_STAGE(PG8_SA(1, 1), a1 + hstep, voffA);
            PG8_WAIT_V(8); PG8_WAIT_L(0); PG8_BAR; PG8_MMA(0, 0, At, B0); PG8_MMA(0, 1, At, B1); PG8_BAR; PG8_SCHED;
            PG8_LDA(At, 0, 1); PG8_STAGE(PG8_SB(0, 0), b2, voffB); PG8_STAGE(PG8_SB(0, 1), b2 + hstep, voffB); PG8_STAGE(PG8_SA(0, 0), a2, voffA);
            PG8_WAIT_V(8); PG8_WAIT_L(0); PG8_BAR; PG8_MMA(1, 0, At, B0); PG8_MMA(1, 1, At, B1); PG8_BAR; PG8_SCHED;
            PG8_LDB(B0, 1, 0); PG8_LDB(B1, 1, 1); PG8_SCHED; PG8_LDA(At, 1, 0); PG8_STAGE(PG8_SA(0, 1), a2 + hstep, voffA);
            PG8_WAIT_V(8); PG8_WAIT_L(0); PG8_BAR; PG8_MMA(0, 0, At, B0); PG8_MMA(0, 1, At, B1); PG8_BAR; PG8_SCHED;
            PG8_LDA(At, 1, 1); PG8_STAGE(PG8_SB(1, 0), b3, voffB); PG8_STAGE(PG8_SB(1, 1), b3 + hstep, voffB); PG8_STAGE(PG8_SA(1, 0), a3, voffA);
            PG8_WAIT_V(8); PG8_WAIT_L(0); PG8_BAR; PG8_MMA(1, 0, At, B0); PG8_MMA(1, 1, At, B1); PG8_BAR; PG8_SCHED;
            } else {
            PG8_LDB(B0, 0, 0); PG8_SCHED; PG8_LDA(At, 0, 0); PG8_STAGE(PG8_SA(1, 1), a1 + hstep, voffA);
            PG8_WAIT_L(8); PG8_BAR; PG8_WAIT_L(0); PG8_MMA(0, 0, At, B0); PG8_BAR; PG8_SCHED;
            PG8_LDB(B1, 0, 1); PG8_STAGE(PG8_SB(0, 0), b2, voffB);
            PG8_BAR; PG8_WAIT_L(0); PG8_MMA(0, 1, At, B1); PG8_BAR;
            PG8_LDA(At, 0, 1); PG8_STAGE(PG8_SA(0, 0), a2, voffA);
            PG8_BAR; PG8_WAIT_L(0); PG8_MMA(1, 0, At, B0); PG8_BAR; PG8_SCHED;
            PG8_STAGE(PG8_SB(0, 1), b2 + hstep, voffB);
            PG8_WAIT_V(6); PG8_BAR; PG8_MMA(1, 1, At, B1); PG8_BAR;
            PG8_LDB(B0, 1, 0); PG8_SCHED; PG8_LDA(At, 1, 0); PG8_STAGE(PG8_SA(0, 1), a2 + hstep, voffA);
            PG8_WAIT_L(8); PG8_BAR; PG8_WAIT_L(0); PG8_MMA(0, 0, At, B0); PG8_BAR; PG8_SCHED;
            PG8_LDB(B1, 1, 1); PG8_STAGE(PG8_SB(1, 0), b3, voffB);
            PG8_BAR; PG8_WAIT_L(0); PG8_MMA(0, 1, At, B1); PG8_BAR;
            PG8_LDA(At, 1, 1); PG8_STAGE(PG8_SA(1, 0), a3, voffA);
            PG8_BAR; PG8_WAIT_L(0); PG8_MMA(1, 0, At, B0); PG8_BAR; PG8_SCHED;
            PG8_STAGE(PG8_SB(1, 1), b3 + hstep, voffB);
            PG8_WAIT_V(6); PG8_BAR; PG8_MMA(1, 1, At, B1); PG8_BAR;
            }
        }
        if constexpr (ALIGN_EPI) { if (wr == 0) PG8_BAR; }
        if constexpr (FP8) asm volatile("s_nop 7\n\ts_nop 7\n\ts_nop 7" ::: "memory");
        E(acc, cur, wr, wc, fr, fq);
        if (!has_next) break;
#pragma unroll
        for (int a = 0; a < 2; ++a)
#pragma unroll
            for (int b = 0; b < 2; ++b)
#pragma unroll
                for (int m = 0; m < 4; ++m)
#pragma unroll
                    for (int n = 0; n < 2; ++n) acc[a][b][m][n] = (f32x4){0.f, 0.f, 0.f, 0.f};
        cur = nxt; cA = nA; cB = nB; ++ui;
        if constexpr (ALIGN_EPI) { if (wr == 1) PG8_BAR; }
    }
    PG8_WAIT_V(0);
    if constexpr (!ALIGN_EPI) { if (wr == 0) PG8_BAR; }
    PG8_BAR;
#undef PG8_SA
#undef PG8_SB
#undef PG8_STAGE
#undef PG8_LDA
#undef PG8_LDB
#undef PG8_MMA
#undef PG8_WAIT_V
#undef PG8_WAIT_L
#undef PG8_BAR
#undef PG8_SCHED
#undef PG8_ABASE
#undef PG8_BBASE
}

typedef unsigned v2u_t __attribute__((ext_vector_type(2)));
__device__ __forceinline__ unsigned pk4_u8(float a, float b, float c, float d) { return (unsigned)__float2int_rn(a) | ((unsigned)__float2int_rn(b) << 8) | ((unsigned)__float2int_rn(c) << 16) | ((unsigned)__float2int_rn(d) << 24); }
__device__ __forceinline__ f32x4 cvt_u8x4(unsigned w) { return (f32x4){(float)(w & 0xFFu), (float)((w >> 8) & 0xFFu), (float)((w >> 16) & 0xFFu), (float)(w >> 24)}; }
__device__ __forceinline__ f32x4 cvt_i4(f32x4 a) { const v4i_t i = __builtin_bit_cast(v4i_t, a); return (f32x4){(float)i.x, (float)i.y, (float)i.z, (float)i.w}; }
struct EpiProj {
    static constexpr bool PERM = true;
    bf16_t* O; float* ST; const float* SH; const float* SW;
    __device__ __forceinline__ void operator()(const f32x4 (&acc)[2][2][4][2], const Unit& u, int wr, int wc, int fr, int fq) const {
        const int row0 = u.pm * BM + wr * 64 + fr;
        f32x4 cs[2][2]; float rsc[2][4];
#pragma unroll
        for (int bj = 0; bj < 2; ++bj)
#pragma unroll
            for (int n = 0; n < 2; ++n) cs[bj][n] = *(const f32x4*)(SW + u.pn * BM + bj * HALF + wc * 32 + 8 * fq + 4 * n);
#pragma unroll
        for (int ai = 0; ai < 2; ++ai)
#pragma unroll
            for (int m = 0; m < 4; ++m) rsc[ai][m] = SH[row0 + ai * HALF + m * 16];
#define PG8_DQ(ai, bj, m, n) (cvt_i4(acc[ai][bj][m][n]) * cs[bj][n] * rsc[ai][m])
        if (u.pn >= 12 && u.pn < 20) {
            bf16_t* base = O + (size_t)3 * SEG + (u.pn - 12) * 128 + wc * 32 + 8 * fq;
#pragma unroll
            for (int ai = 0; ai < 2; ++ai)
#pragma unroll
                for (int m = 0; m < 4; ++m) { const f32x4 v0 = PG8_DQ(ai, 0, m, 0) * PG8_DQ(ai, 1, m, 0), v1 = PG8_DQ(ai, 0, m, 1) * PG8_DQ(ai, 1, m, 1);
                    u32x4 w; w.x = pk_bf16(v0[0], v0[1]); w.y = pk_bf16(v0[2], v0[3]); w.z = pk_bf16(v1[0], v1[1]); w.w = pk_bf16(v1[2], v1[3]);
                    *(u32x4*)(base + (size_t)(row0 + ai * HALF + m * 16) * D) = w; }
            return;
        }
        const int s = (u.pn < 12) ? (u.pn >> 2) : 5 + ((u.pn - 20) >> 2), act = (s < 2) ? 1 : (s >= 5 ? 2 : 0);
        const int col0 = (u.pn & 3) * BM + wc * 32 + 8 * fq;
        bf16_t* base = O + (size_t)s * SEG;
#pragma unroll
        for (int ai = 0; ai < 2; ++ai)
#pragma unroll
            for (int m = 0; m < 4; ++m) { bf16_t* rowp = base + (size_t)(row0 + ai * HALF + m * 16) * D + col0; float rs = 0.f, rq = 0.f;
#pragma unroll
                for (int bj = 0; bj < 2; ++bj) { f32x4 v0 = PG8_DQ(ai, bj, m, 0), v1 = PG8_DQ(ai, bj, m, 1);
                    if (act == 1) {
#pragma unroll
                        for (int j = 0; j < 4; ++j) { v0[j] = gelu_tanh(v0[j]); v1[j] = gelu_tanh(v1[j]); } }
                    else if (act == 2) {
#pragma unroll
                        for (int j = 0; j < 4; ++j) { v0[j] = sigmoidf_(v0[j]) * 255.0f; v1[j] = sigmoidf_(v1[j]) * 255.0f; }
                        unsigned char* g8 = (unsigned char*)(O + (size_t)5 * SEG) + (size_t)(s - 5) * ((size_t)64 << 20) + (size_t)(row0 + ai * HALF + m * 16) * D + col0 + bj * HALF;
                        *(v2u_t*)g8 = (v2u_t){pk4_u8(v0[0], v0[1], v0[2], v0[3]), pk4_u8(v1[0], v1[1], v1[2], v1[3])};
                        continue; }
                    u32x4 w; w.x = pk_bf16(v0[0], v0[1]); w.y = pk_bf16(v0[2], v0[3]); w.z = pk_bf16(v1[0], v1[1]); w.w = pk_bf16(v1[2], v1[3]);
                    *(u32x4*)(rowp + bj * HALF) = w;
                    if (s == 1) {
                        const float a0 = bf_lo(w.x), a1 = bf_hi(w.x), a2 = bf_lo(w.y), a3 = bf_hi(w.y), a4 = bf_lo(w.z), a5 = bf_hi(w.z), a6 = bf_lo(w.w), a7 = bf_hi(w.w);
                        const float ps = ((a0 + a1) + (a2 + a3)) + ((a4 + a5) + (a6 + a7)), pq = ((a0 * a0 + a1 * a1) + (a2 * a2 + a3 * a3)) + ((a4 * a4 + a5 * a5) + (a6 * a6 + a7 * a7));
                        if (bj == 0) { rs = ps; rq = pq; } else { rs += ps; rq += pq; } } }
                if (s == 1) {
                    rs += shx(rs, 16); rq += shx(rq, 16); rs += shx(rs, 32); rq += shx(rq, 32);
                    if (fq == 0) *(f32x2*)(ST + ((size_t)(row0 + ai * HALF + m * 16) * 16 + (u.pn - 4) * 4 + wc) * 2) = (f32x2){rs, rq}; } }
    }
};
#undef PG8_DQ
struct EpiDual {
    static constexpr bool PERM = true;
    bf16_t* Mo; const unsigned char* SA; const unsigned char* SB; const float* SH; const float* SW; PG8_LAS unsigned* RM;
    __device__ __forceinline__ void operator()(const f32x4 (&acc)[2][2][4][2], const Unit& u, int wr, int wc, int fr, int fq) const {
        const int row0 = u.pm * BM + wr * 64 + fr, col0 = u.pn * BM + wc * 32 + 8 * fq;
        const unsigned char* G = u.z ? SB : SA;
        const float* shz = SH + (u.z ? M : 0); const float* swz = SW + (u.z ? 1024 : 0);
        f32x4 cs[2][2];
#pragma unroll
        for (int bj = 0; bj < 2; ++bj)
#pragma unroll
            for (int n = 0; n < 2; ++n) cs[bj][n] = *(const f32x4*)(swz + col0 + bj * HALF + 4 * n) * (1.0f / 255.0f);
#pragma unroll
        for (int aq = 0; aq < 4; ++aq) { const int ai = aq >> 1, m0 = (aq & 1) * 2;
            v2u_t gw[4][2]; u32x4 pw[4][2]; float rsc[4];
#pragma unroll
            for (int m = m0; m < m0 + 2; ++m) { const size_t ro = (size_t)(row0 + ai * HALF + m * 16) * D + col0; rsc[m] = shz[row0 + ai * HALF + m * 16];
#pragma unroll
                for (int bj = 0; bj < 2; ++bj) { gw[m][bj] = *(const v2u_t*)(G + ro + bj * HALF); if (u.z) pw[m][bj] = *(const u32x4*)(Mo + ro + bj * HALF); } }
#pragma unroll
            for (int m = m0; m < m0 + 2; ++m) { const size_t ro = (size_t)(row0 + ai * HALF + m * 16) * D + col0; float rm = 0.f;
#pragma unroll
                for (int bj = 0; bj < 2; ++bj) { const v2u_t g = gw[m][bj];
                    f32x4 v0 = cvt_i4(acc[ai][bj][m][0]) * cs[bj][0] * rsc[m] * cvt_u8x4(g.x), v1 = cvt_i4(acc[ai][bj][m][1]) * cs[bj][1] * rsc[m] * cvt_u8x4(g.y);
                    if (u.z) { const u32x4 q = pw[m][bj];
                        v0[0] += bf_lo(q.x); v0[1] += bf_hi(q.x); v0[2] += bf_lo(q.y); v0[3] += bf_hi(q.y);
                        v1[0] += bf_lo(q.z); v1[1] += bf_hi(q.z); v1[2] += bf_lo(q.w); v1[3] += bf_hi(q.w); }
                    u32x4 w; w.x = pk_bf16(v0[0], v0[1]); w.y = pk_bf16(v0[2], v0[3]); w.z = pk_bf16(v1[0], v1[1]); w.w = pk_bf16(v1[2], v1[3]);
                    *(u32x4*)(Mo + ro + bj * HALF) = w;
                    rm = fmaxf(rm, fmaxf(fmaxf(fmaxf(fabsf(v0[0]), fabsf(v0[1])), fmaxf(fabsf(v0[2]), fabsf(v0[3]))), fmaxf(fmaxf(fabsf(v1[0]), fabsf(v1[1])), fmaxf(fabsf(v1[2]), fabsf(v1[3]))))); }
                if (u.z) { rm = fmaxf(rm, shx(rm, 16)); rm = fmaxf(rm, shx(rm, 32));
                    if (fq == 0) (void)__hip_atomic_fetch_max(RM + (ai * HALF + wr * 64 + m * 16 + fr), __float_as_uint(rm), __ATOMIC_RELAXED, __HIP_MEMORY_SCOPE_WORKGROUP); } }
        }
    }
};
struct EpiRes {
    static constexpr bool PERM = true;
    bf16_t* R; const float* X; const float* mod; const float* SH; const float* SW;
    __device__ __forceinline__ void operator()(const f32x4 (&acc)[2][2][4][2], const Unit& u, int wr, int wc, int fr, int fq) const {
        const int row0 = u.pm * BM + wr * 64 + fr, col0 = u.pn * BM + wc * 32 + 8 * fq;
        const int b = (u.pm * BM) >> 11;
        f32x4 g1[2][2];
#pragma unroll
        for (int bj = 0; bj < 2; ++bj)
#pragma unroll
            for (int n = 0; n < 2; ++n) g1[bj][n] = *(const f32x4*)(mod + (size_t)b * NMOD + 2048 + col0 + bj * HALF + 4 * n) * *(const f32x4*)(SW + col0 + bj * HALF + 4 * n);
#pragma unroll
        for (int aq = 0; aq < 4; ++aq) { const int ai = aq >> 1, m0 = (aq & 1) * 2;
            f32x4 xv[4][2][2]; float rsc[4];
#pragma unroll
            for (int m = m0; m < m0 + 2; ++m) { const size_t ro = (size_t)(row0 + ai * HALF + m * 16) * D + col0; rsc[m] = SH[row0 + ai * HALF + m * 16];
#pragma unroll
                for (int bj = 0; bj < 2; ++bj) { xv[m][bj][0] = *(const f32x4*)(X + ro + bj * HALF); xv[m][bj][1] = *(const f32x4*)(X + ro + bj * HALF + 4); } }
#pragma unroll
            for (int m = m0; m < m0 + 2; ++m) { const size_t ro = (size_t)(row0 + ai * HALF + m * 16) * D + col0;
#pragma unroll
                for (int bj = 0; bj < 2; ++bj) {
                    const f32x4 v0 = xv[m][bj][0] * ALPHA + g1[bj][0] * (cvt_i4(acc[ai][bj][m][0]) * rsc[m]), v1 = xv[m][bj][1] * ALPHA + g1[bj][1] * (cvt_i4(acc[ai][bj][m][1]) * rsc[m]);
                    u32x4 w; w.x = pk_bf16(v0[0], v0[1]); w.y = pk_bf16(v0[2], v0[3]); w.z = pk_bf16(v1[0], v1[1]); w.w = pk_bf16(v1[2], v1[3]);
                    *(u32x4*)(R + ro + bj * HALF) = w; } }
        }
    }
};
struct EpiPlainI8 {
    static constexpr bool PERM = true;
    bf16_t* O; bf16_t* O2; int ldc; const float* SH; const float* SW;
    __device__ __forceinline__ void operator()(const f32x4 (&acc)[2][2][4][2], const Unit& u, int wr, int wc, int fr, int fq) const {
        const int row0 = u.pm * BM + wr * 64 + fr, col0 = u.pn * BM + wc * 32 + 8 * fq;
        bf16_t* Oz = ((u.pn < 4) ? O : O2) + (u.pn & 3) * BM + wc * 32 + 8 * fq;
        f32x4 cs[2][2];
#pragma unroll
        for (int bj = 0; bj < 2; ++bj)
#pragma unroll
            for (int n = 0; n < 2; ++n) cs[bj][n] = *(const f32x4*)(SW + col0 + bj * HALF + 4 * n);
#pragma unroll
        for (int ai = 0; ai < 2; ++ai)
#pragma unroll
            for (int m = 0; m < 4; ++m) { bf16_t* rowp = Oz + (size_t)(row0 + ai * HALF + m * 16) * ldc; const float rsc = SH[row0 + ai * HALF + m * 16];
#pragma unroll
                for (int bj = 0; bj < 2; ++bj) { const f32x4 v0 = cvt_i4(acc[ai][bj][m][0]) * cs[bj][0] * rsc, v1 = cvt_i4(acc[ai][bj][m][1]) * cs[bj][1] * rsc;
                    u32x4 w; w.x = pk_bf16(v0[0], v0[1]); w.y = pk_bf16(v0[2], v0[3]); w.z = pk_bf16(v1[0], v1[1]); w.w = pk_bf16(v1[2], v1[3]);
                    *(u32x4*)(rowp + bj * HALF) = w; } }
    }
};
struct EpiPlain {
    static constexpr bool PERM = true;
    bf16_t* O; int ldc;
    __device__ __forceinline__ void operator()(const f32x4 (&acc)[2][2][4][2], const Unit& u, int wr, int wc, int fr, int fq) const {
        const int row0 = u.pm * BM + wr * 64 + fr, col0 = u.pn * BM + wc * 32 + 8 * fq;
#pragma unroll
        for (int ai = 0; ai < 2; ++ai)
#pragma unroll
            for (int m = 0; m < 4; ++m) { bf16_t* rowp = O + (size_t)(row0 + ai * HALF + m * 16) * ldc + col0;
#pragma unroll
                for (int bj = 0; bj < 2; ++bj) { const f32x4 v0 = acc[ai][bj][m][0], v1 = acc[ai][bj][m][1];
                    u32x4 w; w.x = pk_bf16(v0[0], v0[1]); w.y = pk_bf16(v0[2], v0[3]); w.z = pk_bf16(v1[0], v1[1]); w.w = pk_bf16(v1[2], v1[3]);
                    *(u32x4*)(rowp + bj * HALF) = w; } }
    }
};
}

#define XB_TMO      128
#define XB_XCNT(j)  (256  + 64 * (j))
#define XB_XSUB(j)  (1280 + 64 * (j))
#define XB_XGEN(j)  (2304 + 64 * (j))
#define XB_TOP      3328
#define XB_TOPGEN   3392
#define XCD_BAR_WORDS 3456
#define XB_SPIN_CAP (1u << 18)
__device__ __forceinline__ unsigned xb_ld(unsigned* p)              { return __hip_atomic_load(p, __ATOMIC_RELAXED, __HIP_MEMORY_SCOPE_AGENT); }
__device__ __forceinline__ unsigned xb_add(unsigned* p, unsigned v) { return __hip_atomic_fetch_add(p, v, __ATOMIC_RELAXED, __HIP_MEMORY_SCOPE_AGENT); }
__device__ __forceinline__ unsigned xb_xcc_id() { return (unsigned)__builtin_amdgcn_s_getreg((3 << 11) | 20) & 0xFu; }
#define XB_SPIN(cond, bar) do { unsigned _sp = 0; while (cond) { __builtin_amdgcn_s_sleep(1); \
    if ((++_sp & 255u) == 0u) { if (xb_ld(&(bar)[XB_TMO])) break; if (_sp > XB_SPIN_CAP) { atomicAdd(&(bar)[XB_TMO], 1u); break; } } } } while (0)
struct XcdBarrier { unsigned* bar; unsigned x; volatile LAS unsigned* st; int wave; };
__device__ __forceinline__ XcdBarrier xcd_barrier_post(unsigned* bar, volatile LAS unsigned* st, int wave) {
    XcdBarrier b; b.bar = bar; b.x = xb_xcc_id(); b.st = st; b.wave = wave;
    if (wave == 0 && lane_now() == 0) (void)xb_add(&bar[XB_XCNT(b.x)], 1u);
    return b;
}
__device__ __forceinline__ void xcd_barrier_complete(unsigned* bar, unsigned x, unsigned& nloc, unsigned& nx) {
    const unsigned G = gridDim.x * gridDim.y * gridDim.z;
    unsigned sum, cnt, mine, sp = 0u;
    for (;;) {
        sum = 0u; cnt = 0u; mine = 0u;
#pragma unroll
        for (unsigned j = 0; j < 16; ++j) { const unsigned c = xb_ld(&bar[XB_XCNT(j)]); sum += c; cnt += (c > 0u) ? 1u : 0u; mine = (j == x) ? c : mine; }
        if (sum == G) break;
        __builtin_amdgcn_s_sleep(1);
        if ((++sp & 255u) == 0u) { if (xb_ld(&bar[XB_TMO])) break; if (sp > XB_SPIN_CAP) { atomicAdd(&bar[XB_TMO], 1u); break; } }
    }
    nloc = mine > 0u ? mine : 1u; nx = cnt > 0u ? cnt : 1u;
}
__device__ __forceinline__ void xcd_barrier(const XcdBarrier& b) {
    asm volatile("s_waitcnt vmcnt(0)" ::: "memory");
    __syncthreads();
    if (b.wave == 0 && lane_now() == 0) {
        unsigned* bar = b.bar;
        __builtin_amdgcn_s_waitcnt(0);
        unsigned nloc = b.st[0], nx = b.st[1];
        if (nloc == 0u) { xcd_barrier_complete(bar, b.x, nloc, nx); b.st[0] = nloc; b.st[1] = nx; }
        const unsigned old = xb_add(&bar[XB_XSUB(b.x)], 1u);
        const unsigned gen = old / nloc;
        if (old + 1u == (gen + 1u) * nloc) {
            __builtin_amdgcn_fence(__ATOMIC_RELEASE, "agent");
            asm volatile("s_waitcnt vmcnt(0)" ::: "memory");
            const unsigned og = xb_add(&bar[XB_TOP], 1u);
            const unsigned tg = og / nx;
            if (og + 1u == (tg + 1u) * nx) xb_add(&bar[XB_TOPGEN], 1u);
            else XB_SPIN(xb_ld(&bar[XB_TOPGEN]) == tg, bar);
            __builtin_amdgcn_fence(__ATOMIC_ACQUIRE, "agent");
            xb_add(&bar[XB_XGEN(b.x)], 1u);
            asm volatile("s_waitcnt vmcnt(0)" ::: "memory");
        } else {
            XB_SPIN(xb_ld(&bar[XB_XGEN(b.x)]) == gen, bar);
            __builtin_amdgcn_fence(__ATOMIC_ACQUIRE, "agent");
            asm volatile("s_waitcnt vmcnt(0)" ::: "memory");
        }
    }
    __syncthreads();
}

struct Frame {
    LAS unsigned char* lds;
    int tid, lane, wave, G, gw, NGW;
    const float *x, *c, *w_cond, *b_cond, *w_in, *gln_g, *gln_b, *w_sp, *b_sp, *conv_w, *p_a, *p_b, *w_o, *ln1_g, *ln1_b, *w_q, *keys, *eu, *ev, *ln2_g, *ln2_b;
    float* out; float* mod;
    bf16 *Win_t, *Pa_t, *Pb_t, *Wo_t, *Wq_t, *Keys, *Wsp, *EU, *EV;
    unsigned* sel; const bf16* zrow; unsigned char *EU8, *EV8; float* SC; float* ST;
    unsigned* CM; float* SW; float* SH;
    float* TOPS; bf16* Rb; unsigned char* H2q; unsigned char* M8;
    bf16 *H, *B1, *B2, *B3, *B4, *B5, *B6;
};

constexpr float WSC8 = 256.0f;
__device__ __forceinline__ unsigned pk4_fp8(float a, float b, float c, float d) {
    a = fminf(fmaxf(a, -448.f), 448.f); b = fminf(fmaxf(b, -448.f), 448.f); c = fminf(fmaxf(c, -448.f), 448.f); d = fminf(fmaxf(d, -448.f), 448.f);
    int w = __builtin_amdgcn_cvt_pk_fp8_f32(a, b, 0, false); w = __builtin_amdgcn_cvt_pk_fp8_f32(c, d, w, true); return (unsigned)w;
}
template <bool PAIRED = false, bool FP8OUT = false>
__device__ __forceinline__ void p0_transpose_item(const float* W, int K, int N, bf16* WT, LAS float* scr, int item, int lane) {
    const int nblk = N / 32, kb = item / nblk, nb = item % nblk, k0 = 64 * kb, n0 = 32 * nb;
    int ns = n0;
    if (PAIRED && n0 >= 3072 && n0 < 5120) { const int q = n0 - 3072; ns = (((q >> 7) & 1) ? 4096 : 3072) + 128 * (q >> 8) + (q & 127); }
#pragma unroll 8
    for (int i = 0; i < 32; ++i) { const int kk = 2 * i + (lane >> 5); scr[kk * 33 + (lane & 31)] = W[(size_t)(k0 + kk) * N + ns + (lane & 31)]; }
    LDS_WAIT(); asm volatile("" ::: "memory");
    const int c = lane & 7;
#pragma unroll
    for (int j = 0; j < 4; ++j) { const int n = (lane >> 3) + 8 * j; const LAS float* s = scr + (8 * c) * 33 + n;
        if constexpr (FP8OUT) {
            v2u o8; o8.x = pk4_fp8(s[0 * 33] * WSC8, s[1 * 33] * WSC8, s[2 * 33] * WSC8, s[3 * 33] * WSC8); o8.y = pk4_fp8(s[4 * 33] * WSC8, s[5 * 33] * WSC8, s[6 * 33] * WSC8, s[7 * 33] * WSC8);
            *(GAS v2u*)((unsigned char*)WT + (size_t)(n0 + n) * K + k0 + 8 * c) = o8; continue; }
        v4u o; o.x = pk_bf16(s[0 * 33], s[1 * 33]); o.y = pk_bf16(s[2 * 33], s[3 * 33]); o.z = pk_bf16(s[4 * 33], s[5 * 33]); o.w = pk_bf16(s[6 * 33], s[7 * 33]);
        *(GAS v4u*)(WT + (size_t)(n0 + n) * K + k0 + 8 * c) = o; }
    LDS_WAIT(); asm volatile("" ::: "memory");
}
template <bool PAIRED = false>
__device__ __forceinline__ void p0_colmax_item(const float* W, int K, int N, unsigned* CM, int item, int lane) {
    const int nblk = N / 32, kb = item / nblk, nb = item % nblk, k0 = 64 * kb, n0 = 32 * nb;
    int ns = n0;
    if (PAIRED && n0 >= 3072 && n0 < 5120) { const int q = n0 - 3072; ns = (((q >> 7) & 1) ? 4096 : 3072) + 128 * (q >> 8) + (q & 127); }
    float mx = 0.f;
#pragma unroll 8
    for (int i = 0; i < 32; ++i) { const int kk = 2 * i + (lane >> 5); mx = fmaxf(mx, fabsf(W[(size_t)(k0 + kk) * N + ns + (lane & 31)])); }
    mx = fmaxf(mx, shx(mx, 32));
    if (lane < 32) (void)__hip_atomic_fetch_max(&CM[n0 + lane], __float_as_uint(mx), __ATOMIC_RELAXED, __HIP_MEMORY_SCOPE_AGENT);
}
template <bool PAIRED = false>
__device__ __forceinline__ void p1_quant_item(const float* W, int K, int N, unsigned char* WT8, const unsigned* CM, float* SW, LAS float* scr, int item, int lane) {
    const int nblk = N / 32, kb = item / nblk, nb = item % nblk, k0 = 64 * kb, n0 = 32 * nb;
    int ns = n0;
    if (PAIRED && n0 >= 3072 && n0 < 5120) { const int q = n0 - 3072; ns = (((q >> 7) & 1) ? 4096 : 3072) + 128 * (q >> 8) + (q & 127); }
#pragma unroll 8
    for (int i = 0; i < 32; ++i) { const int kk = 2 * i + (lane >> 5); scr[kk * 33 + (lane & 31)] = W[(size_t)(k0 + kk) * N + ns + (lane & 31)]; }
    LDS_WAIT(); asm volatile("" ::: "memory");
    const int c = lane & 7;
#pragma unroll
    for (int j = 0; j < 4; ++j) { const int n = (lane >> 3) + 8 * j; const LAS float* t = scr + (8 * c) * 33 + n;
        const float amax = __uint_as_float(CM[n0 + n]), inv = (amax > 0.f) ? 127.0f / amax : 0.f;
        v2u o8; o8.x = pk4_i8(t[0 * 33] * inv, t[1 * 33] * inv, t[2 * 33] * inv, t[3 * 33] * inv); o8.y = pk4_i8(t[4 * 33] * inv, t[5 * 33] * inv, t[6 * 33] * inv, t[7 * 33] * inv);
        *(GAS v2u*)(WT8 + (size_t)(n0 + n) * K + k0 + 8 * c) = o8;
        if (kb == 0 && c == 0) SW[n0 + n] = amax * (1.0f / 127.0f); }
    LDS_WAIT(); asm volatile("" ::: "memory");
}
__device__ __forceinline__ void p0_cond_item(Frame& F, int it) {
    LAS float* sc = (LAS float*)F.lds;
    for (int i0 = 0; i0 < 64; i0 += 8) {
        float v[8];
#pragma unroll
        for (int i = 0; i < 8; ++i) v[i] = F.c[F.tid + 512 * (i0 + i)];
#pragma unroll
        for (int i = 0; i < 8; ++i) { const int e = F.tid + 512 * (i0 + i), b = e >> 10, k = e & 1023; sc[k * 32 + b] = v[i] / (1.0f + __expf(-v[i])); }
    }
    __syncthreads();
    float acc[32];
#pragma unroll
    for (int b = 0; b < 32; ++b) acc[b] = 0.f;
    const float* W = F.w_cond + it * 64 + F.lane;
    for (int k0 = F.wave * 128; k0 < F.wave * 128 + 128; k0 += 16) {
        float wv[16];
#pragma unroll
        for (int i = 0; i < 16; ++i) wv[i] = W[(size_t)(k0 + i) * NMOD];
#pragma unroll
        for (int i = 0; i < 16; ++i) { const LAS f32x4* s4 = (const LAS f32x4*)(sc + (k0 + i) * 32);
#pragma unroll
            for (int q = 0; q < 8; ++q) { const f32x4 s = s4[q]; acc[4 * q + 0] += s.x * wv[i]; acc[4 * q + 1] += s.y * wv[i]; acc[4 * q + 2] += s.z * wv[i]; acc[4 * q + 3] += s.w * wv[i]; } }
    }
    __syncthreads();
    LAS float* red = (LAS float*)F.lds;
#pragma unroll
    for (int b = 0; b < 32; ++b) red[(F.wave * 32 + b) * 64 + F.lane] = acc[b];
    __syncthreads();
#pragma unroll
    for (int i = 0; i < 4; ++i) { const int e = F.tid + 512 * i, b = e >> 6, ln = e & 63; float s = F.b_cond[it * 64 + ln];
#pragma unroll
        for (int w = 0; w < 8; ++w) s += red[(w * 32 + b) * 64 + ln];
        F.mod[b * NMOD + it * 64 + ln] = s; }
    __syncthreads();
}
__device__ __forceinline__ void cvt8(const float* src, bf16* dst, size_t i8) {
    const f32x4 a = *(const GAS f32x4*)(src + i8 * 8), b = *(const GAS f32x4*)(src + i8 * 8 + 4);
    v4u o; o.x = pk_bf16(a.x, a.y); o.y = pk_bf16(a.z, a.w); o.z = pk_bf16(b.x, b.y); o.w = pk_bf16(b.z, b.w);
    *(GAS v4u*)(dst + i8 * 8) = o;
}
__device__ __forceinline__ void phase0(Frame& F) {
    for (int it = blockIdx.x; it < NMOD / 64; it += F.G) p0_cond_item(F, it);
    LAS float* scr = (LAS float*)(F.lds + F.wave * 16384);
    constexpr int I_IN = (D / 64) * (NIN / 32), I_SQ = (D / 64) * (D / 32), I_Q = (D / 64) * (NQ / 32);
    constexpr int NITEMS = I_IN + 3 * I_SQ + I_Q;
    for (int it = F.gw; it < NITEMS; it += F.NGW) {
        int r = it;
        if (r < I_IN) { p0_colmax_item<true>(F.w_in, D, NIN, F.CM, r, F.lane); continue; } r -= I_IN;
        if (r < I_SQ) { p0_colmax_item<false>(F.p_a, D, D, F.CM + NIN + NQ, r, F.lane); continue; } r -= I_SQ;
        if (r < I_SQ) { p0_colmax_item<false>(F.p_b, D, D, F.CM + NIN + NQ + D, r, F.lane); continue; } r -= I_SQ;
        if (r < I_SQ) { p0_colmax_item<false>(F.w_o, D, D, F.CM + NIN + NQ + 2 * D, r, F.lane); continue; } r -= I_SQ;
        p0_colmax_item<false>(F.w_q, D, NQ, F.CM + NIN, r, F.lane);
    }
    const size_t gt = (size_t)blockIdx.x * 512 + F.tid, NT = (size_t)F.G * 512;
    for (int e0 = 2 * F.gw; e0 < NE; e0 += 2 * F.NGW) {
        f32x4 ru[2][4], rv[2][4];
#pragma unroll
        for (int x = 0; x < 2; ++x) { const GAS f32x4* su = (const GAS f32x4*)(F.eu + (size_t)(e0 + x) * D) + 4 * F.lane; const GAS f32x4* sv = (const GAS f32x4*)(F.ev + (size_t)(e0 + x) * D) + 4 * F.lane;
#pragma unroll
            for (int i = 0; i < 4; ++i) { ru[x][i] = su[i]; rv[x][i] = sv[i]; } }
#pragma unroll
        for (int x = 0; x < 2; ++x) {
            const int e = e0 + x;
            float amu = 0.f, amv = 0.f;
#pragma unroll
            for (int i = 0; i < 4; ++i) { amu = fmaxf(amu, fmaxf(fmaxf(fabsf(ru[x][i].x), fabsf(ru[x][i].y)), fmaxf(fabsf(ru[x][i].z), fabsf(ru[x][i].w))));
                                          amv = fmaxf(amv, fmaxf(fmaxf(fabsf(rv[x][i].x), fabsf(rv[x][i].y)), fmaxf(fabsf(rv[x][i].z), fabsf(rv[x][i].w)))); }
            amu = wave_max(amu); amv = wave_max(amv);
            const int ex = (int)((__float_as_uint(amv) >> 23) & 0xFFu) - 127;
            const int k = (amv > 0.f) ? ((7 - ex) < 100 ? (7 - ex) : 100) : 0;
            const float sc = __uint_as_float((unsigned)(127 + k) << 23), iscv = __uint_as_float((unsigned)(127 - k) << 23);
            unsigned ov[4], ou[4];
#pragma unroll
            for (int i = 0; i < 4; ++i) { int w = __builtin_amdgcn_cvt_pk_fp8_f32(rv[x][i].x * sc, rv[x][i].y * sc, 0, false); w = __builtin_amdgcn_cvt_pk_fp8_f32(rv[x][i].z * sc, rv[x][i].w * sc, w, true); ov[i] = (unsigned)w; }
            const float inv = (amu > 0.f) ? 127.0f / amu : 0.f, iscu = amu * (1.0f / 127.0f);
#define Q8(v) ((unsigned)__float2int_rn((v) * inv) & 0xFFu)
#pragma unroll
            for (int i = 0; i < 4; ++i) ou[i] = Q8(ru[x][i].x) | (Q8(ru[x][i].y) << 8) | (Q8(ru[x][i].z) << 16) | (Q8(ru[x][i].w) << 24);
#undef Q8
            *((GAS v4u*)(F.EU8 + (size_t)e * D) + F.lane) = (v4u){ou[0], ou[1], ou[2], ou[3]};
            *((GAS v4u*)(F.EV8 + (size_t)e * D) + F.lane) = (v4u){ov[0], ov[1], ov[2], ov[3]};
            if (F.lane == 0) *(GAS f32x2*)(F.SC + 2 * e) = (f32x2){iscu, iscv};
        }
    }
    for (size_t i = gt; i < (size_t)8 * 2 * 128 * 128 / 8; i += NT) cvt8(F.keys, F.Keys, i);
    for (size_t i = gt; i < (size_t)8 * 128 * 128 / 8; i += NT) {
        const int e = (int)i * 8, j = e & 127, ii = (e >> 7) & 127;
        if ((j >> 6) <= (ii >> 6)) cvt8(F.w_sp, F.Wsp, i); else *(GAS v4u*)(F.Wsp + i * 8) = (v4u){0u, 0u, 0u, 0u};
    }
}

__device__ __forceinline__ void phase1(Frame& F) {
    {   LAS float* scr = (LAS float*)(F.lds + F.wave * 16384);
        constexpr int I_IN = (D / 64) * (NIN / 32), I_Q = (D / 64) * (NQ / 32), I_SQ = (D / 64) * (D / 32);
        for (int it = F.gw; it < I_IN + I_Q + 3 * I_SQ; it += F.NGW) {
            if (it < I_IN) p1_quant_item<true>(F.w_in, D, NIN, (unsigned char*)F.Win_t, F.CM, F.SW, scr, it, F.lane);
            else if (it < I_IN + I_Q) p1_quant_item<false>(F.w_q, D, NQ, (unsigned char*)F.Wq_t, F.CM + NIN, F.SW + 8192, scr, it - I_IN, F.lane);
            else if (it < I_IN + I_Q + I_SQ) p1_quant_item<false>(F.p_a, D, D, (unsigned char*)F.Pa_t, F.CM + NIN + NQ, F.SW + 10240, scr, it - I_IN - I_Q, F.lane);
            else if (it < I_IN + I_Q + 2 * I_SQ) p1_quant_item<false>(F.p_b, D, D, (unsigned char*)F.Pb_t, F.CM + NIN + NQ + D, F.SW + 11264, scr, it - I_IN - I_Q - I_SQ, F.lane);
            else p1_quant_item<false>(F.w_o, D, D, (unsigned char*)F.Wo_t, F.CM + NIN + NQ + 2 * D, F.SW + 12288, scr, it - I_IN - I_Q - 2 * I_SQ, F.lane);
        }
    }
    for (int blk = F.gw; blk < M / 32; blk += F.NGW) {
        const int r0 = blk * 32, b = r0 >> 11;
        const GAS f32x4* mp = (const GAS f32x4*)(F.mod + (size_t)b * NMOD) + F.lane;
        f32x4 sh[4], sc[4];
#pragma unroll
        for (int j = 0; j < 4; ++j) { sh[j] = mp[64 * j]; sc[j] = mp[256 + 64 * j] + 1.0f; }
#pragma unroll 2
        for (int r = 0; r < 32; ++r) {
            const GAS f32x4* xr = (const GAS f32x4*)(F.x + (size_t)(r0 + r) * D) + F.lane;
            f32x4 v[4]; float s = 0.f;
#pragma unroll
            for (int j = 0; j < 4; ++j) { v[j] = xr[64 * j]; s += (v[j].x + v[j].y) + (v[j].z + v[j].w); }
            const float mean = wave_sum(s) * (1.f / D); float s2 = 0.f;
#pragma unroll
            for (int j = 0; j < 4; ++j) { v[j] = v[j] - mean; s2 += (v[j].x * v[j].x + v[j].y * v[j].y) + (v[j].z * v[j].z + v[j].w * v[j].w); }
            const float rstd = 1.f / sqrtf(wave_sum(s2) * (1.f / D) + LN_EPS);
            GAS unsigned* o8 = (GAS unsigned*)((unsigned char*)F.H + (size_t)(r0 + r) * D) + F.lane;
            float mx = 0.f;
#pragma unroll
            for (int j = 0; j < 4; ++j) { v[j] = v[j] * rstd * sc[j] + sh[j]; mx = fmaxf(mx, fmaxf(fmaxf(fabsf(v[j].x), fabsf(v[j].y)), fmaxf(fabsf(v[j].z), fabsf(v[j].w)))); }
            mx = wave_max(mx);
            const float inv = (mx > 0.f) ? 127.0f / mx : 0.f;
#pragma unroll
            for (int j = 0; j < 4; ++j) o8[64 * j] = pk4_i8(v[j].x * inv, v[j].y * inv, v[j].z * inv, v[j].w * inv);
            if (F.lane == 0) F.SH[r0 + r] = mx * (1.0f / 127.0f);
        }
    }
}

__device__ __forceinline__ unsigned off_b(unsigned row, unsigned ch) { return 256u * row + 16u * (ch ^ (((row & 3) << 2) | ((row >> 2) & 3))); }
__device__ __forceinline__ unsigned tr_read_addr_16(unsigned lane, unsigned c, unsigned ks, unsigned t) {
    const unsigned g = lane >> 4, q = (lane & 15) >> 2, p = lane & 3;
    return off_b(32 * ks + 8 * g + 4 * t + q, 2 * c + (p >> 1)) + 8 * (p & 1);
}
typedef short v4i16_t __attribute__((ext_vector_type(4)));
__device__ __forceinline__ s16x4 lds_tr(LAS unsigned char* p) { return __builtin_bit_cast(s16x4, __builtin_amdgcn_ds_read_tr16_b64_v4i16((LAS v4i16_t*)p)); }

__device__ __forceinline__ void phase3_panel(Frame& F, const int pm) {
    LAS f32x2* stat = (LAS f32x2*)(F.lds + 65536);
    const int fr = F.lane & 15, fq = F.lane >> 4;
    for (int blk = 2 * pm; blk < 2 * pm + 2; ++blk) {
        const size_t T0 = (size_t)blk * 128;
        if (F.tid < 128) {
            const GAS f32x4* sp = (const GAS f32x4*)(F.ST + (T0 + F.tid) * 32);
            float sm = 0.f, sq = 0.f;
#pragma unroll
            for (int i = 0; i < 8; ++i) { const f32x4 v = sp[i]; sm += v.x + v.z; sq += v.y + v.w; }
            const float mean = sm * (1.f / D), var = fmaxf(sq * (1.f / D) - mean * mean, 0.f);
            stat[F.tid] = (f32x2){mean, 1.f / sqrtf(var + LN_EPS)};
        }
        __syncthreads();
        float rmx = 0.f;
        for (int g = 0; g < 8; ++g) {
            LAS unsigned char* img = F.lds + (g & 1) * 32768;
            {
                const int ch = F.tid & 15;
                const GAS f32x4* lg = (const GAS f32x4*)(F.gln_g + g * 128 + 8 * ch); const GAS f32x4* lb = (const GAS f32x4*)(F.gln_b + g * 128 + 8 * ch);
                const f32x4 g0 = lg[0], g1 = lg[1], b0 = lb[0], b1 = lb[1];
#pragma unroll
                for (int i = 0; i < 4; ++i) { const int q = F.tid + 512 * i, j = q >> 4;
                    const v4u w = *(const GAS v4u*)(F.B2 + (T0 + j) * D + g * 128 + 8 * ch);
                    const f32x2 st = stat[j];
                    v4u o;
                    o.x = pk_bf16((bf_lo(w.x) - st.x) * st.y * g0.x + b0.x, (bf_hi(w.x) - st.x) * st.y * g0.y + b0.y);
                    o.y = pk_bf16((bf_lo(w.y) - st.x) * st.y * g0.z + b0.z, (bf_hi(w.y) - st.x) * st.y * g0.w + b0.w);
                    o.z = pk_bf16((bf_lo(w.z) - st.x) * st.y * g1.x + b1.x, (bf_hi(w.z) - st.x) * st.y * g1.y + b1.y);
                    o.w = pk_bf16((bf_lo(w.w) - st.x) * st.y * g1.z + b1.z, (bf_hi(w.w) - st.x) * st.y * g1.w + b1.w);
                    *(LAS v4u*)(img + off_b(j, ch)) = o; }
            }
            __syncthreads();
            f32x4 acc[8];
#pragma unroll
            for (int ct = 0; ct < 8; ++ct) acc[ct] = (f32x4){0.f, 0.f, 0.f, 0.f};
#pragma unroll
            for (int ks = 0; ks < 4; ++ks) {
                const bf16x8 wf = *(const GAS bf16x8*)(F.Wsp + ((size_t)(g * 128 + 16 * F.wave + fr)) * 128 + 32 * ks + 8 * fq);
#pragma unroll
                for (int ct = 0; ct < 8; ++ct) {
                    const s16x4 t0 = lds_tr(img + tr_read_addr_16(F.lane, ct, ks, 0)), t1 = lds_tr(img + tr_read_addr_16(F.lane, ct, ks, 1));
                    const bf16x8 vf = {t0[0], t0[1], t0[2], t0[3], t1[0], t1[1], t1[2], t1[3]};
                    acc[ct] = __builtin_amdgcn_mfma_f32_16x16x32_bf16(vf, wf, acc[ct], 0, 0, 0);
                }
            }
            const int i = 16 * F.wave + fr;
            const float bias = F.b_sp[g * 128 + i];
            GAS v2u* up = (GAS v2u*)(F.B1 + (T0 + i) * D + g * 128 + 4 * fq);
#pragma unroll
            for (int ct = 0; ct < 8; ++ct) { const v2u uu = up[4 * ct];
                const float y0 = bf_lo(uu.x) * (acc[ct][0] + bias), y1 = bf_hi(uu.x) * (acc[ct][1] + bias), y2 = bf_lo(uu.y) * (acc[ct][2] + bias), y3 = bf_hi(uu.y) * (acc[ct][3] + bias);
                rmx = fmaxf(rmx, fmaxf(fmaxf(fabsf(y0), fabsf(y1)), fmaxf(fabsf(y2), fabsf(y3))));
                v2u o; o.x = pk_bf16(y0, y1); o.y = pk_bf16(y2, y3);
                up[4 * ct] = o; }
        }
        {
            rmx = fmaxf(rmx, shx(rmx, 16)); rmx = fmaxf(rmx, shx(rmx, 32));
            const float inv = (rmx > 0.f) ? 127.0f / rmx : 0.f;
            const int i = 16 * F.wave + fr;
            asm volatile("s_waitcnt vmcnt(0)" ::: "memory");
            for (int g = 0; g < 8; ++g) {
                const GAS v2u* up = (const GAS v2u*)(F.B1 + (T0 + i) * D + g * 128 + 4 * fq);
                GAS unsigned* qp = (GAS unsigned*)((unsigned char*)F.B5 + (T0 + i) * D + g * 128 + 4 * fq);
                v2u uu[8];
#pragma unroll
                for (int ct = 0; ct < 8; ++ct) uu[ct] = up[4 * ct];
#pragma unroll
                for (int ct = 0; ct < 8; ++ct) qp[4 * ct] = pk4_i8(bf_lo(uu[ct].x) * inv, bf_hi(uu[ct].x) * inv, bf_lo(uu[ct].y) * inv, bf_hi(uu[ct].y) * inv);
            }
            if (fq == 0) F.SH[2 * M + T0 + i] = rmx * (1.0f / 127.0f);
        }
        __syncthreads();
    }
    {   const int it = pm * 8 + F.wave;
        const int t0 = it * 32;
        float w0[16], w1[16], w2[16], p1[16], p2[16];
#pragma unroll
        for (int h = 0; h < 2; ++h)
#pragma unroll
            for (int e = 0; e < 8; ++e) { const int col = h * 512 + F.lane * 8 + e; w0[8 * h + e] = F.conv_w[col]; w1[8 * h + e] = F.conv_w[D + col]; w2[8 * h + e] = F.conv_w[2 * D + col]; p1[8 * h + e] = 0.f; p2[8 * h + e] = 0.f; }
        if ((t0 & (SEQ - 1)) != 0) {
#pragma unroll
            for (int h = 0; h < 2; ++h) { const int col = h * 512 + F.lane * 8;
                const v4u c1 = *(const GAS v4u*)(F.B4 + (size_t)(t0 - 1) * D + col), c2 = *(const GAS v4u*)(F.B4 + (size_t)(t0 - 2) * D + col);
                p1[8 * h + 0] = bf_lo(c1.x); p1[8 * h + 1] = bf_hi(c1.x); p1[8 * h + 2] = bf_lo(c1.y); p1[8 * h + 3] = bf_hi(c1.y); p1[8 * h + 4] = bf_lo(c1.z); p1[8 * h + 5] = bf_hi(c1.z); p1[8 * h + 6] = bf_lo(c1.w); p1[8 * h + 7] = bf_hi(c1.w);
                p2[8 * h + 0] = bf_lo(c2.x); p2[8 * h + 1] = bf_hi(c2.x); p2[8 * h + 2] = bf_lo(c2.y); p2[8 * h + 3] = bf_hi(c2.y); p2[8 * h + 4] = bf_lo(c2.z); p2[8 * h + 5] = bf_hi(c2.z); p2[8 * h + 6] = bf_lo(c2.w); p2[8 * h + 7] = bf_hi(c2.w); }
        }
#pragma unroll 2
        for (int t = t0; t < t0 + 32; ++t) {
            float y[16]; float mx = 0.f;
#pragma unroll
            for (int h = 0; h < 2; ++h) {
                const size_t o = (size_t)t * D + h * 512 + F.lane * 8;
                const v4u gb = *(const GAS v4u*)(F.B3 + o), pc = *(const GAS v4u*)(F.B4 + o);
                float p[8], gbv[8];
                p[0] = bf_lo(pc.x); p[1] = bf_hi(pc.x); p[2] = bf_lo(pc.y); p[3] = bf_hi(pc.y); p[4] = bf_lo(pc.z); p[5] = bf_hi(pc.z); p[6] = bf_lo(pc.w); p[7] = bf_hi(pc.w);
                gbv[0] = bf_lo(gb.x); gbv[1] = bf_hi(gb.x); gbv[2] = bf_lo(gb.y); gbv[3] = bf_hi(gb.y); gbv[4] = bf_lo(gb.z); gbv[5] = bf_hi(gb.z); gbv[6] = bf_lo(gb.w); gbv[7] = bf_hi(gb.w);
#pragma unroll
                for (int e = 0; e < 8; ++e) { const int k = 8 * h + e; y[k] = gbv[e] * (w0[k] * p2[k] + w1[k] * p1[k] + w2[k] * p[e]); p2[k] = p1[k]; p1[k] = p[e]; mx = fmaxf(mx, fabsf(y[k])); }
            }
            mx = wave_max(mx);
            const float inv = (mx > 0.f) ? 127.0f / mx : 0.f;
            GAS v2u* o8 = (GAS v2u*)((unsigned char*)F.B5 + (size_t)64 * MiB + (size_t)t * D) + F.lane;
            o8[0] = (v2u){pk4_i8(y[0] * inv, y[1] * inv, y[2] * inv, y[3] * inv), pk4_i8(y[4] * inv, y[5] * inv, y[6] * inv, y[7] * inv)};
            o8[64] = (v2u){pk4_i8(y[8] * inv, y[9] * inv, y[10] * inv, y[11] * inv), pk4_i8(y[12] * inv, y[13] * inv, y[14] * inv, y[15] * inv)};
            if (F.lane == 0) F.SH[3 * M + t] = mx * (1.0f / 127.0f);
        }
    }
}

__device__ __forceinline__ void unpack16(const v4u a, const v4u b, float (&v)[16]) {
    v[0] = bf_lo(a.x); v[1] = bf_hi(a.x); v[2] = bf_lo(a.y); v[3] = bf_hi(a.y); v[4] = bf_lo(a.z); v[5] = bf_hi(a.z); v[6] = bf_lo(a.w); v[7] = bf_hi(a.w);
    v[8] = bf_lo(b.x); v[9] = bf_hi(b.x); v[10] = bf_lo(b.y); v[11] = bf_hi(b.y); v[12] = bf_lo(b.z); v[13] = bf_hi(b.z); v[14] = bf_lo(b.w); v[15] = bf_hi(b.w);
}
__device__ __forceinline__ void load16f(const float* p, int lane, float (&v)[16]) {
    const f32x4 a = *(const GAS f32x4*)(p + 8 * lane), b = *(const GAS f32x4*)(p + 8 * lane + 4), c = *(const GAS f32x4*)(p + 512 + 8 * lane), d = *(const GAS f32x4*)(p + 512 + 8 * lane + 4);
    v[0] = a.x; v[1] = a.y; v[2] = a.z; v[3] = a.w; v[4] = b.x; v[5] = b.y; v[6] = b.z; v[7] = b.w; v[8] = c.x; v[9] = c.y; v[10] = c.z; v[11] = c.w; v[12] = d.x; v[13] = d.y; v[14] = d.z; v[15] = d.w;
}
__device__ __forceinline__ void ln16(float (&v)[16]) {
    float s = 0.f;
#pragma unroll
    for (int e = 0; e < 16; ++e) s += v[e];
    const float mean = wave_sum(s) * (1.f / D); float s2 = 0.f;
#pragma unroll
    for (int e = 0; e < 16; ++e) { v[e] -= mean; s2 += v[e] * v[e]; }
    const float rstd = 1.f / sqrtf(wave_sum(s2) * (1.f / D) + LN_EPS);
#pragma unroll
    for (int e = 0; e < 16; ++e) v[e] *= rstd;
}
__device__ __forceinline__ void store16bf(bf16* p, int lane, const float (&v)[16]) {
    v4u a, b; a.x = pk_bf16(v[0], v[1]); a.y = pk_bf16(v[2], v[3]); a.z = pk_bf16(v[4], v[5]); a.w = pk_bf16(v[6], v[7]);
    b.x = pk_bf16(v[8], v[9]); b.y = pk_bf16(v[10], v[11]); b.z = pk_bf16(v[12], v[13]); b.w = pk_bf16(v[14], v[15]);
    ((GAS v4u*)p)[lane] = a; ((GAS v4u*)p)[lane + 64] = b;
}
__device__ __forceinline__ void phase6_panel(Frame& F, const int pm) {
    float g1[16], b1[16];
    load16f(F.ln1_g, F.lane, g1); load16f(F.ln1_b, F.lane, b1);
    {   const int blk = pm * 8 + F.wave;
        const int r0 = blk * 32, b = r0 >> 11;
        float sh[16], sc[16];
        load16f(F.mod + (size_t)b * NMOD + 3072, F.lane, sh); load16f(F.mod + (size_t)b * NMOD + 4096, F.lane, sc);
#pragma unroll 2
        for (int r = 0; r < 32; ++r) {
            const GAS v4u* rr = (const GAS v4u*)(F.Rb + (size_t)(r0 + r) * D);
            float v[16]; unpack16(rr[F.lane], rr[F.lane + 64], v);
            ln16(v);
#pragma unroll
            for (int e = 0; e < 16; ++e) v[e] = v[e] * g1[e] + b1[e];
            ln16(v);
#pragma unroll
            for (int e = 0; e < 16; ++e) v[e] = v[e] * (1.0f + sc[e]) + sh[e];
            float mx = 0.f;
#pragma unroll
            for (int e = 0; e < 16; ++e) mx = fmaxf(mx, fabsf(v[e]));
            mx = wave_max(mx);
            const float inv = (mx > 0.f) ? 127.0f / mx : 0.f;
            GAS v2u* o8 = (GAS v2u*)(F.H2q + (size_t)(r0 + r) * D) + F.lane;
            o8[0] = (v2u){pk4_i8(v[0] * inv, v[1] * inv, v[2] * inv, v[3] * inv), pk4_i8(v[4] * inv, v[5] * inv, v[6] * inv, v[7] * inv)};
            o8[64] = (v2u){pk4_i8(v[8] * inv, v[9] * inv, v[10] * inv, v[11] * inv), pk4_i8(v[12] * inv, v[13] * inv, v[14] * inv, v[15] * inv)};
            if (F.lane == 0) F.SH[M + r0 + r] = mx * (1.0f / 127.0f);
        }
    }
}

#define CE_DESC(a, b) do { const float _x = vmaxf(a, b), _y = vminf(a, b); a = _x; b = _y; } while (0)
template <int N> __device__ __forceinline__ void bitonic_merge_desc(float (&v)[N]) {
#pragma unroll
    for (int j = N / 2; j > 0; j >>= 1) {
#pragma unroll
        for (int i = 0; i < N; ++i) { const int l = i ^ j; if (l > i) CE_DESC(v[i], v[l]); } }
}
template <int N> __device__ __forceinline__ void bitonic_sort_desc(float (&v)[N]) {
#pragma unroll
    for (int k = 2; k <= N; k <<= 1) {
#pragma unroll
        for (int j = k >> 1; j > 0; j >>= 1) {
#pragma unroll
            for (int i = 0; i < N; ++i) { const int l = i ^ j; if (l > i) { if ((i & k) == 0) CE_DESC(v[i], v[l]); else CE_DESC(v[l], v[i]); } } } }
}
__device__ __forceinline__ void top16_merge(float (&a)[16], const float (&b)[16]) {
#pragma unroll
    for (int i = 0; i < 16; ++i) a[i] = vmaxf(a[i], b[15 - i]);
    bitonic_merge_desc<16>(a);
}
__device__ __forceinline__ void top16_merge_lane(float (&a)[16], int mask) {
    float p[16]; const int l = lane_now();
#pragma unroll
    for (int i = 0; i < 16; ++i) p[i] = shx(a[i], mask, l);
    top16_merge(a, p);
}
typedef float f32x16 __attribute__((ext_vector_type(16)));
__device__ __forceinline__ void phase8b_block(Frame& F, size_t T0) {
    float* TOPS = F.TOPS;
    LAS float* scr = (LAS float*)F.lds;
    for (int k4 = 0; k4 < 4; ++k4) {
        const size_t gid = T0 * 8 + (size_t)k4 * 512 + F.tid;
        const GAS f32x4* t1 = (const GAS f32x4*)(TOPS + gid * 32);
        float L1[16], L2[16];
#pragma unroll
        for (int i = 0; i < 4; ++i) { const f32x4 x = t1[i], y = t1[4 + i];
            L1[4 * i] = x.x; L1[4 * i + 1] = x.y; L1[4 * i + 2] = x.z; L1[4 * i + 3] = x.w; L2[4 * i] = y.x; L2[4 * i + 1] = y.y; L2[4 * i + 2] = y.z; L2[4 * i + 3] = y.w; }
#pragma unroll
        for (int i = 0; i < 16; ++i) { scr[i * 512 + F.tid] = L1[i]; scr[(16 + i) * 512 + F.tid] = L2[i]; }
#define P8_CAND(a, b) __uint_as_float((__float_as_uint(L1[a] + L2[b]) & ~0xFFu) | (unsigned)(255 - ((a) * 16 + (b))))
        float top[16], g1[16], g2[16], g3[16];
#pragma unroll
        for (int b = 0; b < 16; ++b) top[b] = P8_CAND(0, b);
        {
            int n = 0;
#pragma unroll
            for (int i = 0; i < 16; ++i) { g1[i] = -__builtin_inff(); g2[i] = -__builtin_inff(); g3[i] = -__builtin_inff(); }
#pragma unroll
            for (int a = 1; a < 16; ++a)
#pragma unroll
                for (int b = 0; b < 16; ++b) if ((a + 1) * (b + 1) <= 16) { const float cv = P8_CAND(a, b);
                    if (n < 16) g1[n] = cv; else if (n < 32) g2[n - 16] = cv; else g3[n - 32] = cv; ++n; }
        }
#undef P8_CAND
        bitonic_sort_desc<16>(g1); bitonic_sort_desc<16>(g2); CE_DESC(g3[0], g3[1]);
        top16_merge(top, g1); top16_merge(top, g2); top16_merge(top, g3);
        float sv[16]; unsigned ex[16]; float mx = -__builtin_inff();
#pragma unroll
        for (int k = 0; k < 16; ++k) { const unsigned code = 255u - (__float_as_uint(top[k]) & 0xFFu); const float f1 = scr[(code >> 4) * 512 + F.tid], f2 = scr[(16 + (code & 15)) * 512 + F.tid];
            const unsigned i1 = 127u - (__float_as_uint(f1) & 0x7Fu), i2 = 127u - (__float_as_uint(f2) & 0x7Fu);
            sv[k] = f1 + f2; ex[k] = i1 * 128u + i2; mx = fmaxf(mx, sv[k]); }
        float den = 0.f;
#pragma unroll
        for (int k = 0; k < 16; ++k) { sv[k] = __builtin_amdgcn_exp2f((sv[k] - mx) * 1.4426950408889634f); den += sv[k]; }
        const float inv = 1.0f / den;
        GAS v4u* sp = (GAS v4u*)(F.sel + gid * 16);
#pragma unroll
        for (int i = 0; i < 4; ++i) { v4u o;
            o.x = (ex[4 * i + 0] << 18) | (__float_as_uint(sv[4 * i + 0] * inv) >> 13); o.y = (ex[4 * i + 1] << 18) | (__float_as_uint(sv[4 * i + 1] * inv) >> 13);
            o.z = (ex[4 * i + 2] << 18) | (__float_as_uint(sv[4 * i + 2] * inv) >> 13); o.w = (ex[4 * i + 3] << 18) | (__float_as_uint(sv[4 * i + 3] * inv) >> 13);
            sp[i] = o; }
    }
}

__device__ __forceinline__ void phase8_panel(Frame& F, const int blk) {
    const int lane = F.lane, c32 = lane & 31, hh = lane >> 5;
    float* TOPS = F.TOPS;
    {
        const size_t T0 = (size_t)blk * 256;
        for (int h = 0; h < 8; ++h) {
            const bf16* Q = ((h < 4) ? F.B1 : F.B2) + (h & 3) * 256;
            __syncthreads();
            {
                v4u kreg[8];
#pragma unroll
                for (int i = 0; i < 8; ++i) { const int q = F.tid + 512 * i; kreg[i] = *(const GAS v4u*)(F.Keys + (size_t)h * 32768 + (size_t)q * 8); }
#pragma unroll
                for (int i = 0; i < 8; ++i) { const int q = F.tid + 512 * i, pp = q >> 11, key = (q >> 4) & 127, c = q & 15;
                    *(LAS v4u*)(F.lds + pp * 32768 + key * 256 + 16 * (c ^ (key & 15))) = kreg[i]; }
            }
            __syncthreads();
            LAS unsigned char* qimg = F.lds + 65536 + F.wave * 8192;
            v4u qn[8];
            { const int tile0 = F.wave >> 1, p0 = F.wave & 1;
#pragma unroll
              for (int i = 0; i < 8; ++i) qn[i] = *(const GAS v4u*)(Q + (T0 + 32 * tile0 + 4 * i + (lane >> 4)) * D + p0 * 128 + 8 * (lane & 15)); }
#pragma unroll 1
            for (int j = 0; j < 2; ++j) {
                const int task = F.wave + 8 * j, tile = task >> 1, p = task & 1;
                const size_t tok = T0 + 32 * tile + c32;
#pragma unroll
                for (int i = 0; i < 8; ++i) { const int row = 4 * i + (lane >> 4); *(LAS v4u*)(qimg + row * 256 + 16 * ((lane & 15) ^ (row & 15))) = qn[i]; }
                if (j == 0) { const int task1 = F.wave + 8, tile1 = task1 >> 1, p1 = task1 & 1;
#pragma unroll
                    for (int i = 0; i < 8; ++i) qn[i] = *(const GAS v4u*)(Q + (T0 + 32 * tile1 + 4 * i + (lane >> 4)) * D + p1 * 128 + 8 * (lane & 15)); }
                bf16x8 bq[8];
#pragma unroll
                for (int ks = 0; ks < 8; ++ks) bq[ks] = *(const LAS bf16x8*)(qimg + c32 * 256 + 16 * ((2 * ks + hh) ^ (c32 & 15)));
#define P8_CHAIN(dst, kt) do { _Pragma("unroll") for (int r = 0; r < 16; ++r) dst[r] = 0.f; \
        _Pragma("unroll") for (int ks = 0; ks < 8; ++ks) { const int key = 32 * (kt) + c32; \
            const bf16x8 ak = *(const LAS bf16x8*)(F.lds + p * 32768 + key * 256 + 16 * ((2 * ks + hh) ^ (key & 15))); \
            dst = __builtin_amdgcn_mfma_f32_32x32x16_bf16(ak, bq[ks], dst, 0, 0, 0); } } while (0)
                float t[16], g[16];
                f32x16 accC, accN;
                unsigned hh4 = 4u * (unsigned)hh; asm volatile("" : "+v"(hh4));
                P8_CHAIN(accC, 0);
#pragma unroll
                for (int kt = 0; kt < 4; ++kt) {
                    if (kt < 3) P8_CHAIN(accN, kt + 1);
#pragma unroll
                    for (int r = 0; r < 16; ++r) { const int key0 = 32 * kt + (r & 3) + 8 * (r >> 2);
                        const unsigned bits = ((__float_as_uint(accC[r]) & ~0x7Fu) | (unsigned)(127 - key0)) - hh4;
                        if (kt == 0) t[r] = __uint_as_float(bits); else g[r] = __uint_as_float(bits); }
                    if (kt == 0) bitonic_sort_desc<16>(t); else { bitonic_sort_desc<16>(g); top16_merge(t, g); }
                    accC = accN;
                }
#undef P8_CHAIN
                top16_merge_lane(t, 32);
                if (hh == 0) { GAS f32x4* tp = (GAS f32x4*)(TOPS + ((tok * 8 + h) * 2 + p) * 16);
#pragma unroll
                    for (int i = 0; i < 4; ++i) tp[i] = (f32x4){t[4 * i], t[4 * i + 1], t[4 * i + 2], t[4 * i + 3]}; }
            }
        }
        asm volatile("s_waitcnt vmcnt(0)" ::: "memory");
        __syncthreads();
        F.lane = lane_now(); F.tid = F.wave * 64 + F.lane;
        phase8b_block(F, T0);
    }
}
constexpr int P9_NT = 8;
constexpr int P9_SRT = 0, P9_CF = 2048, P9_WB = 4096;
constexpr int P9_CH = 8;
template <class T> __device__ __forceinline__ T reduce8(const T (&p)[8], int lane) {
    const bool b5 = (lane & 32) != 0, b4 = (lane & 16) != 0, b3 = (lane & 8) != 0;
    T q[4], r[2], t;
#pragma unroll
    for (int i = 0; i < 4; ++i) { const T keep = b5 ? p[i + 4] : p[i], send = b5 ? p[i] : p[i + 4]; q[i] = keep + shx(send, 32, lane); }
#pragma unroll
    for (int i = 0; i < 2; ++i) { const T keep = b4 ? q[i + 2] : q[i], send = b4 ? q[i] : q[i + 2]; r[i] = keep + shx(send, 16, lane); }
    { const T keep = b3 ? r[1] : r[0], send = b3 ? r[0] : r[1]; t = keep + shx(send, 8, lane); }
    t += shx(t, 4, lane); t += shx(t, 2, lane); t += shx(t, 1, lane);
    return t;
}
__device__ __forceinline__ void p9_issue(const __amdgpu_buffer_rsrc_t rs, const LAS unsigned* srt, int pos, int lane, v4u (&rows)[P9_CH]) {
    const int ro = (int)((srt[pos + (lane & (P9_CH - 1))] >> 18) * 1024u), l16 = lane * 16;
#pragma unroll
    for (int e = 0; e < P9_CH; ++e) rows[e] = __builtin_amdgcn_raw_buffer_load_b128(rs, l16, __builtin_amdgcn_readlane(ro, e), 0);
}
__device__ __forceinline__ void p9_issue_sc(Frame& F, const LAS unsigned* srt, int pos, int lane, unsigned& wg, f32x2& scv) {
    wg = srt[pos + (lane >> 3)];
    scv = *(const GAS f32x2*)(F.SC + 2 * (size_t)(wg >> 18));
}
__device__ __forceinline__ void fp8x16_to_f32(const v4u w, f32x2 (&f)[8]) {
    f[0] = __builtin_amdgcn_cvt_pk_f32_fp8((int)w.x, false); f[1] = __builtin_amdgcn_cvt_pk_f32_fp8((int)w.x, true);
    f[2] = __builtin_amdgcn_cvt_pk_f32_fp8((int)w.y, false); f[3] = __builtin_amdgcn_cvt_pk_f32_fp8((int)w.y, true);
    f[4] = __builtin_amdgcn_cvt_pk_f32_fp8((int)w.z, false); f[5] = __builtin_amdgcn_cvt_pk_f32_fp8((int)w.z, true);
    f[6] = __builtin_amdgcn_cvt_pk_f32_fp8((int)w.w, false); f[7] = __builtin_amdgcn_cvt_pk_f32_fp8((int)w.w, true);
}
__device__ __forceinline__ void p9_compute_u(const v4u (&rows)[P9_CH], const unsigned wg, const f32x2 scv, const v4u xq, const float sx, LAS float* cf, int pos, int lane) {
    int p[P9_CH];
#pragma unroll
    for (int e = 0; e < P9_CH; ++e) { int a = __builtin_amdgcn_sdot4((int)rows[e].x, (int)xq.x, 0, false); a = __builtin_amdgcn_sdot4((int)rows[e].y, (int)xq.y, a, false);
        a = __builtin_amdgcn_sdot4((int)rows[e].z, (int)xq.z, a, false); p[e] = __builtin_amdgcn_sdot4((int)rows[e].w, (int)xq.w, a, false); }
    const float tot = (float)reduce8<int>(p, lane) * (scv.x * sx);
    const float coef = __uint_as_float((wg & 0x3FFFFu) << 13) * gelu_tanh(tot) * scv.y;
    if ((lane & 7) == 0) cf[pos + (lane >> 3)] = coef;
}
__device__ __forceinline__ void p9_compute_v(const v4u (&rows)[P9_CH], f32x2 (&acc)[8], const LAS float* cf, int pos, int lane) {
    const float cl = cf[pos + (lane & (P9_CH - 1))];
#pragma unroll
    for (int e = 0; e < P9_CH; ++e) {
        const float c = __uint_as_float((unsigned)__builtin_amdgcn_readlane((int)__float_as_uint(cl), e));
        f32x2 f[8]; fp8x16_to_f32(rows[e], f);
#pragma unroll
        for (int q = 0; q < 8; ++q) acc[q] += f[q] * c; }
}
#ifdef PROBE_PHASE
#define P9P_START(k) unsigned long long p9t_##k = 0; if ((k) == PROBE_PHASE) p9t_##k = __builtin_amdgcn_s_memrealtime();
#define P9P_END(k) if ((k) == PROBE_PHASE) { const unsigned long long t1 = __builtin_amdgcn_s_memrealtime(), dt = (t1 - p9t_##k) * PROBE_MULT; while (__builtin_amdgcn_s_memrealtime() - t1 < dt) __builtin_amdgcn_s_sleep(8); }
#else
#define P9P_START(k)
#define P9P_END(k)
#endif
constexpr int P9_TU = 16;
__device__ __forceinline__ void phase9(Frame& F, const XcdBarrier& bar) {
    LAS unsigned* srt = (LAS unsigned*)(F.lds + F.wave * 16384);
    LAS float* cf = (LAS float*)(F.lds + F.wave * 16384 + 8192);
    LAS float* sxl = (LAS float*)(F.lds + 131072 + F.wave * 64);
    const __amdgpu_buffer_rsrc_t rsU = __builtin_amdgcn_make_buffer_rsrc((void*)F.EU8, 0, NE * D, 0x00020000);
    const __amdgpu_buffer_rsrc_t rsV = __builtin_amdgcn_make_buffer_rsrc((void*)F.EV8, 0, NE * D, 0x00020000);
    constexpr int NJ = 128 / P9_CH;
    for (int blk = blockIdx.x; blk < M / 128; blk += F.G) {
#ifdef P9_ROUND_BARRIER
        if (MK_N_LAUNCHES == 1 && blk != (int)blockIdx.x && (M / 128) % F.G == 0) xcd_barrier(bar);
#endif
        P9P_START(90)
        int lane; asm volatile("v_mbcnt_lo_u32_b32 %0, -1, 0\n\tv_mbcnt_hi_u32_b32 %0, -1, %0" : "=v"(lane));
        const unsigned long long lt_mask = (1ull << lane) - 1ull;
        const size_t tb = (size_t)blk * 128 + F.wave * P9_TU;
        for (int t = 0; t < P9_TU; ++t) {
            const unsigned w0 = F.sel[(tb + t) * 128 + lane], w1 = F.sel[(tb + t) * 128 + 64 + lane];
            const unsigned b0 = w0 >> 28, b1 = w1 >> 28;
            unsigned base = 0, pos0 = 0, pos1 = 0;
#pragma unroll
            for (unsigned b = 0; b < 16u; ++b) {
                const unsigned long long m0 = __ballot(b0 == b), m1 = __ballot(b1 == b);
                const unsigned c0 = (unsigned)__popcll(m0), c1 = (unsigned)__popcll(m1);
                if (b0 == b) pos0 = base + (unsigned)__popcll(m0 & lt_mask);
                if (b1 == b) pos1 = base + c0 + (unsigned)__popcll(m1 & lt_mask);
                base += c0 + c1;
            }
            srt[t * 128 + pos0] = w0; srt[t * 128 + pos1] = w1;
        }
        v4u xq[P9_TU];
#pragma unroll
        for (int t = 0; t < P9_TU; ++t) xq[t] = *((const GAS v4u*)(F.H2q + (tb + t) * D) + lane);
        if (lane < P9_TU) sxl[lane] = F.SH[M + tb + lane];
        P9P_END(90)
        P9P_START(91)
        {
            v4u r0[P9_CH], r1[P9_CH]; unsigned w0_, w1_; f32x2 s0, s1;
            p9_issue_sc(F, srt, 0, lane, w0_, s0); p9_issue(rsU, srt, 0, lane, r0);
            for (int j = 0; j < NJ; ++j) {
                __builtin_amdgcn_s_barrier();
                const int pj = P9_CH * j, pn = P9_CH * ((j < NJ - 1) ? j + 1 : NJ - 1);
#define P9_USTEP(t, RI, WI, SI, RC, WC, SC_) { const int ti = (t) + 1; const int ip = (ti < P9_TU) ? (ti * 128 + pj) : ((ti - P9_TU) * 128 + pn); \
                    p9_issue_sc(F, srt, ip, lane, WI, SI); p9_issue(rsU, srt, ip, lane, RI); p9_compute_u(RC, WC, SC_, xq[t], sxl[t], cf, (t) * 128 + pj, lane); }
                P9_USTEP(0, r1, w1_, s1, r0, w0_, s0)  P9_USTEP(1, r0, w0_, s0, r1, w1_, s1)  P9_USTEP(2, r1, w1_, s1, r0, w0_, s0)  P9_USTEP(3, r0, w0_, s0, r1, w1_, s1)
                P9_USTEP(4, r1, w1_, s1, r0, w0_, s0)  P9_USTEP(5, r0, w0_, s0, r1, w1_, s1)  P9_USTEP(6, r1, w1_, s1, r0, w0_, s0)  P9_USTEP(7, r0, w0_, s0, r1, w1_, s1)
                P9_USTEP(8, r1, w1_, s1, r0, w0_, s0)  P9_USTEP(9, r0, w0_, s0, r1, w1_, s1)  P9_USTEP(10, r1, w1_, s1, r0, w0_, s0) P9_USTEP(11, r0, w0_, s0, r1, w1_, s1)
                P9_USTEP(12, r1, w1_, s1, r0, w0_, s0) P9_USTEP(13, r0, w0_, s0, r1, w1_, s1) P9_USTEP(14, r1, w1_, s1, r0, w0_, s0) P9_USTEP(15, r0, w0_, s0, r1, w1_, s1)
#undef P9_USTEP
            }
        }
        P9P_END(91)
        for (int sub = 0; sub < P9_TU / P9_NT; ++sub) {
            P9P_START(92)
            const LAS unsigned* srs = srt + sub * (P9_NT * 128); const LAS float* cfs = cf + sub * (P9_NT * 128);
            f32x2 acc[P9_NT][8];
#pragma unroll
            for (int tt = 0; tt < P9_NT; ++tt)
#pragma unroll
                for (int q = 0; q < 8; ++q) acc[tt][q] = (f32x2){0.f, 0.f};
            {
                v4u r0[P9_CH], r1[P9_CH];
                p9_issue(rsV, srs, 0, lane, r0);
                for (int j = 0; j < NJ; ++j) {
                    __builtin_amdgcn_s_barrier();
                    const int pj = P9_CH * j, pn = P9_CH * ((j < NJ - 1) ? j + 1 : NJ - 1);
                    p9_issue(rsV, srs, 128 + pj, lane, r1); p9_compute_v(r0, acc[0], cfs, pj, lane);
                    p9_issue(rsV, srs, 256 + pj, lane, r0); p9_compute_v(r1, acc[1], cfs, 128 + pj, lane);
                    p9_issue(rsV, srs, 384 + pj, lane, r1); p9_compute_v(r0, acc[2], cfs, 256 + pj, lane);
                    p9_issue(rsV, srs, 512 + pj, lane, r0); p9_compute_v(r1, acc[3], cfs, 384 + pj, lane);
                    p9_issue(rsV, srs, 640 + pj, lane, r1); p9_compute_v(r0, acc[4], cfs, 512 + pj, lane);
                    p9_issue(rsV, srs, 768 + pj, lane, r0); p9_compute_v(r1, acc[5], cfs, 640 + pj, lane);
                    p9_issue(rsV, srs, 896 + pj, lane, r1); p9_compute_v(r0, acc[6], cfs, 768 + pj, lane);
                    p9_issue(rsV, srs, pn, lane, r0);       p9_compute_v(r1, acc[7], cfs, 896 + pj, lane);
                }
            }
            P9P_END(92)
            P9P_START(93)
            {
                const size_t tb4 = tb + (size_t)sub * P9_NT;
                const int b = (int)(tb4 >> 11);
                float g2[16], l2g[16], l2b[16];
                {
                    const GAS f32x4* pg = (const GAS f32x4*)(F.mod + (size_t)b * NMOD + 5120) + 4 * lane; const GAS f32x4* pl = (const GAS f32x4*)F.ln2_g + 4 * lane; const GAS f32x4* pb = (const GAS f32x4*)F.ln2_b + 4 * lane;
#pragma unroll
                    for (int i = 0; i < 4; ++i) { const f32x4 a = pg[i], c = pl[i], e = pb[i];
                        g2[4 * i] = a.x; g2[4 * i + 1] = a.y; g2[4 * i + 2] = a.z; g2[4 * i + 3] = a.w; l2g[4 * i] = c.x; l2g[4 * i + 1] = c.y; l2g[4 * i + 2] = c.z; l2g[4 * i + 3] = c.w;
                        l2b[4 * i] = e.x; l2b[4 * i + 1] = e.y; l2b[4 * i + 2] = e.z; l2b[4 * i + 3] = e.w; }
                }
#pragma unroll
                for (int tt = 0; tt < P9_NT; ++tt) {
                    const size_t tok = tb4 + tt;
                    const GAS v4u* xr = (const GAS v4u*)(F.Rb + tok * D) + 2 * lane;
                    float y[16]; unpack16(xr[0], xr[1], y);
                    ln16(y);
                    {
                        const GAS f32x4* p1g = (const GAS f32x4*)F.ln1_g + 4 * lane; const GAS f32x4* p1b = (const GAS f32x4*)F.ln1_b + 4 * lane;
#pragma unroll
                        for (int i = 0; i < 4; ++i) { const f32x4 gg = p1g[i], bb = p1b[i];
                            y[4 * i] = y[4 * i] * gg.x + bb.x; y[4 * i + 1] = y[4 * i + 1] * gg.y + bb.y; y[4 * i + 2] = y[4 * i + 2] * gg.z + bb.z; y[4 * i + 3] = y[4 * i + 3] * gg.w + bb.w; }
                    }
#pragma unroll
                    for (int e = 0; e < 8; ++e) { y[2 * e] = ALPHA * y[2 * e] + g2[2 * e] * acc[tt][e].x; y[2 * e + 1] = ALPHA * y[2 * e + 1] + g2[2 * e + 1] * acc[tt][e].y; }
                    ln16(y);
#pragma unroll
                    for (int e = 0; e < 16; ++e) y[e] = y[e] * l2g[e] + l2b[e];
                    GAS f32x4* op = (GAS f32x4*)(F.out + tok * D) + 4 * lane;
                    op[0] = (f32x4){y[0], y[1], y[2], y[3]}; op[1] = (f32x4){y[4], y[5], y[6], y[7]}; op[2] = (f32x4){y[8], y[9], y[10], y[11]}; op[3] = (f32x4){y[12], y[13], y[14], y[15]};
                }
            }
            P9P_END(93)
        }
    }
}

struct Args { const float* in[21]; float* out; unsigned char* ws; int ph_lo, ph_hi, li, pad; };
__global__ void __launch_bounds__(512, 2) fwd(Args args) {
    extern __shared__ __attribute__((aligned(16))) unsigned char lds[];
    Frame F;
    F.lds = (LAS unsigned char*)lds;
    volatile LAS unsigned* MISC = (volatile LAS unsigned*)(F.lds + MISC_OFF);
    F.tid = threadIdx.x; F.lane = F.tid & 63; F.wave = __builtin_amdgcn_readfirstlane(F.tid >> 6);
    F.G = gridDim.x; F.gw = blockIdx.x * 8 + F.wave; F.NGW = F.G * 8;
    unsigned char* ws = args.ws;
    gu32* ctl = (gu32*)(ws + WS_CTL);
    F.x = args.in[0]; F.c = args.in[1]; F.w_cond = args.in[2]; F.b_cond = args.in[3]; F.w_in = args.in[4]; F.gln_g = args.in[5]; F.gln_b = args.in[6];
    F.w_sp = args.in[7]; F.b_sp = args.in[8]; F.conv_w = args.in[9]; F.p_a = args.in[10]; F.p_b = args.in[11]; F.w_o = args.in[12]; F.ln1_g = args.in[13]; F.ln1_b = args.in[14];
    F.w_q = args.in[15]; F.keys = args.in[16]; F.eu = args.in[17]; F.ev = args.in[18]; F.ln2_g = args.in[19]; F.ln2_b = args.in[20];
    F.out = args.out; F.mod = (float*)(ws + WS_MOD);
    F.Win_t = (bf16*)(ws + WS_WIN); F.Pa_t = (bf16*)(ws + WS_PA); F.Pb_t = (bf16*)(ws + WS_PB); F.Wo_t = (bf16*)(ws + WS_WO); F.Wq_t = (bf16*)(ws + WS_WQ);
    F.Keys = (bf16*)(ws + WS_KEYS); F.Wsp = (bf16*)(ws + WS_WSP); F.EU = (bf16*)(ws + WS_EU); F.EV = (bf16*)(ws + WS_EV); F.sel = (unsigned*)(ws + WS_SEL); F.zrow = (const bf16*)(ws + WS_CTL + 512 * 1024); F.EU8 = ws + WS_EU; F.EV8 = ws + WS_EV; F.SC = (float*)(ws + 28 * MiB); F.ST = (float*)(ws + 48 * MiB);
    F.CM = (unsigned*)(ws + WS_CM); F.SW = (float*)(ws + WS_SW); F.SH = (float*)(ws + WS_SH);
    F.H = (bf16*)args.out;
    F.TOPS = (float*)args.out; F.M8 = (unsigned char*)args.out + (size_t)64 * MiB;
    F.Rb = (bf16*)(ws + 3 * WS_U); F.H2q = ws + 5 * WS_U;
    F.B1 = (bf16*)(ws + 1 * WS_U); F.B2 = (bf16*)(ws + 2 * WS_U); F.B3 = (bf16*)(ws + 3 * WS_U); F.B4 = (bf16*)(ws + 4 * WS_U); F.B5 = (bf16*)(ws + 5 * WS_U); F.B6 = (bf16*)(ws + 6 * WS_U);
    for (int u = F.tid; u < (LDS_BYTES - LDSCTL_OFF) / 4; u += 512) ((LAS unsigned*)(F.lds + LDSCTL_OFF))[u] = 0u;
    __syncthreads();
    XcdBarrier bar; bar.bar = (unsigned*)(ctl + CW_BAR); bar.x = 0; bar.st = nullptr; bar.wave = F.wave;
    if (MK_N_LAUNCHES == 1) bar = xcd_barrier_post((unsigned*)(ctl + CW_BAR), MISC + 8, F.wave);
    const int lo = args.ph_lo, hi = args.ph_hi;
#define IN(k) (lo <= (k) && (k) < hi)
#ifdef PROBE_PHASE
    unsigned long long pr_t0 = 0;
#define PSTART(k) do { if ((k) == PROBE_PHASE) pr_t0 = __builtin_amdgcn_s_memrealtime(); } while (0)
#define PEND(k) do { if ((k) == PROBE_PHASE) { const unsigned long long t1 = __builtin_amdgcn_s_memrealtime(), dt = (t1 - pr_t0) * PROBE_MULT; while (__builtin_amdgcn_s_memrealtime() - t1 < dt) __builtin_amdgcn_s_sleep(8); } } while (0)
#else
#define PSTART(k) do {} while (0)
#define PEND(k) do {} while (0)
#endif
#define SEAM(k) do { PEND(k); if (IN(k) && IN((k) + 1)) xcd_barrier(bar); PSTART((k) + 1); } while (0)

    PSTART(0);
    if (IN(0)) { phase0(F); SEAM(0); }
    if (IN(1)) { phase1(F); SEAM(1); }
    if (IN(2)) {
        pg8::Gemm g{F.H, F.Win_t, nullptr, nullptr, M, NIN, D}; pg8::StaticOrder S; S.init(M, NIN, F.G, (int)blockIdx.x);
        pg8::EpiProj E{F.B1, F.ST, F.SH, F.SW};
        pg8::gemm_phase<pg8::EpiProj, pg8::StaticOrder, true, true, 2>(F.lds, g, S, E, F.wave);
        SEAM(2);
    }
    if (IN(3)) {
        LAS unsigned* RM = (LAS unsigned*)(F.lds + 131072);
        float* SHm = (float*)((unsigned char*)F.SH + MiB);
#define OPQ() do { F.lane = lane_now(); F.tid = F.wave * 64 + F.lane; } while (0)
        for (int pm = blockIdx.x; pm < M / 256; pm += F.G) {
            OPQ();
            phase3_panel(F, pm);
            asm volatile("s_waitcnt vmcnt(0)" ::: "memory");
            __syncthreads();
            PEND(3); PSTART(4); OPQ();
            if (F.tid < 256) RM[F.tid] = 0u;
            __syncthreads();
            {   pg8::Gemm g{F.B5, F.Pa_t, (const pg8::bf16_t*)((const unsigned char*)F.B5 + (size_t)64 * MiB), F.Pb_t, M, D, D}; pg8::PanelDual S{pm, (int)(blockIdx.x >> 3)};
                pg8::EpiDual E{F.B2, (const unsigned char*)F.B6, (const unsigned char*)F.B6 + (size_t)64 * MiB, F.SH + 2 * M, F.SW + 10240, RM};
                pg8::gemm_phase<pg8::EpiDual, pg8::PanelDual, true, true, 2>(F.lds, g, S, E, F.wave); }
            __syncthreads();
#pragma unroll 4
            for (int r = 0; r < 32; ++r) {
                const int pr = 32 * F.wave + r; const size_t row = (size_t)pm * 256 + pr;
                const float mx = __uint_as_float(RM[pr]), inv = (mx > 0.f) ? 127.0f / mx : 0.f;
                const GAS v4u* mp = (const GAS v4u*)(F.B2 + row * D) + F.lane;
                const v4u a = mp[0], b = mp[64];
                GAS v2u* o8 = (GAS v2u*)(F.M8 + row * D) + F.lane;
                o8[0] = (v2u){pk4_i8(bf_lo(a.x) * inv, bf_hi(a.x) * inv, bf_lo(a.y) * inv, bf_hi(a.y) * inv), pk4_i8(bf_lo(a.z) * inv, bf_hi(a.z) * inv, bf_lo(a.w) * inv, bf_hi(a.w) * inv)};
                o8[64] = (v2u){pk4_i8(bf_lo(b.x) * inv, bf_hi(b.x) * inv, bf_lo(b.y) * inv, bf_hi(b.y) * inv), pk4_i8(bf_lo(b.z) * inv, bf_hi(b.z) * inv, bf_lo(b.w) * inv, bf_hi(b.w) * inv)};
                if (F.lane == 0) SHm[row] = mx * (1.0f / 127.0f);
            }
            asm volatile("s_waitcnt vmcnt(0)" ::: "memory");
            __syncthreads();
            PEND(4); PSTART(5); OPQ();
            {   pg8::Gemm g{(const pg8::bf16_t*)F.M8, F.Wo_t, nullptr, nullptr, M, D, D}; pg8::PanelOrder S{pm, 4, (int)(blockIdx.x >> 3)};
                pg8::EpiRes E{F.Rb, F.x, F.mod, SHm, F.SW + 12288};
                pg8::gemm_phase<pg8::EpiRes, pg8::PanelOrder, true, true, 2>(F.lds, g, S, E, F.wave); }
            __syncthreads();
            PEND(5); PSTART(6); OPQ();
            phase6_panel(F, pm);
            asm volatile("s_waitcnt vmcnt(0)" ::: "memory");
            __syncthreads();
            PEND(6); PSTART(7); OPQ();
            {   pg8::Gemm g{(const pg8::bf16_t*)F.H2q, F.Wq_t, nullptr, nullptr, M, NQ, D}; pg8::PanelOrder S{pm, 8, (int)(blockIdx.x >> 3)};
                pg8::EpiPlainI8 E{F.B1, F.B2, D, F.SH + M, F.SW + 8192};
                pg8::gemm_phase<pg8::EpiPlainI8, pg8::PanelOrder, true, true, 2>(F.lds, g, S, E, F.wave); }
            __syncthreads();
            PEND(7); PSTART(8); OPQ();
            phase8_panel(F, pm);
            __syncthreads();
            PEND(8); PSTART(3);
        }
        if (IN(8) && IN(9)) xcd_barrier(bar);
        PSTART(9);
    }
    if (IN(9)) { OPQ(); phase9(F, bar); PEND(9); }
#undef IN
#undef SEAM
}

extern "C" void kernel_launch(void* const* d_in, const int* in_sizes, int n_in, void* d_out, int out_size, void* d_ws, size_t ws_size, hipStream_t stream) {
    static int grid = 0;
    if (grid == 0) {
        if (n_in != 21 || in_sizes[0] != M * D || out_size != M * D || ws_size < WS_END) { fprintf(stderr, "kernel_launch: unexpected shapes (n_in %d, in0 %d, out %d, ws %zu); nothing launched\n", n_in, n_in > 0 ? in_sizes[0] : -1, out_size, ws_size); grid = -1; return; }
        int dev = 0, cus = 0, per_cu = 0;
        if (hipGetDevice(&dev) != hipSuccess || hipDeviceGetAttribute(&cus, hipDeviceAttributeMultiprocessorCount, dev) != hipSuccess) { grid = -1; return; }
        if (hipFuncSetAttribute((const void*)fwd, hipFuncAttributeMaxDynamicSharedMemorySize, LDS_BYTES) != hipSuccess) { fprintf(stderr, "kernel_launch: hipFuncSetAttribute failed\n"); grid = -1; return; }
        if (hipOccupancyMaxActiveBlocksPerMultiprocessor(&per_cu, (const void*)fwd, 512, LDS_BYTES) != hipSuccess || per_cu < 1) { fprintf(stderr, "kernel_launch: occupancy query reports %d workgroups per CU\n", per_cu); }
        (void)hipGetLastError();
        grid = cus;
    }
    if (grid < 0) return;
    if (hipMemsetAsync((char*)d_ws + WS_CTL, 0, CTL_ZERO_BYTES, stream) != hipSuccess) return;
    Args a{};
    for (int i = 0; i < 21; ++i) a.in[i] = (const float*)d_in[i];
    a.out = (float*)d_out; a.ws = (unsigned char*)d_ws;
    for (int li = 0; li < MK_N_LAUNCHES; ++li) {
        a.ph_lo = (MK_N_LAUNCHES == 1) ? 0 : li; a.ph_hi = (MK_N_LAUNCHES == 1) ? NPHASE : li + 1; a.li = li;
        hipLaunchKernelGGL(fwd, dim3(grid), dim3(512), LDS_BYTES, stream, a);
    }
}
```
